# Optimizing an MI355X kernel written in HIP

```python
import math
import jax, jax.numpy as jnp
from jax import lax
import numpy as np

D_MODEL = 2048
BATCH = 4
SEQ = 2048
DEPTH = 4

CTX_LEN = 256
GRID_W = 64
EPS = 1e-6

MIX_W = D_MODEL
HY_W = D_MODEL // 4
MLA_HEADS = 8
MLA_DN = 128
MLA_DR = 64
MLA_DV = 128
MLA_W = MLA_HEADS * MLA_DV
Q_RANK = D_MODEL // 4
KV_RANK = D_MODEL // 8
POOL_W = D_MODEL // 4
POOL_WINDOWS = (2, 4, 8, 16)
N_POOL_GROUPS = len(POOL_WINDOWS)
POOL_GROUP = POOL_W // N_POOL_GROUPS

SHORT_CONV = 3
FILTER_EMB = 33
FILTER_BANDS = (FILTER_EMB - 1) // 2
FILTER_HIDDEN = 64
DECAY_TARGET = 1e-2
FAST_DECAY = 0.3
SLOW_DECAY = 1.5

ROPE_BASE = 10000.0
Q_BLOCK = 128
ATTN_SCALE = (MLA_DN + MLA_DR) ** -0.5

OFF_HY = 0
OFF_HY_G = OFF_HY + 3 * HY_W
OFF_Q = OFF_HY_G + HY_W
OFF_KV = OFF_Q + Q_RANK
OFF_KR = OFF_KV + KV_RANK
OFF_MLA_G = OFF_KR + MLA_DR
OFF_POOL = OFF_MLA_G + MLA_W
OFF_POOL_G = OFF_POOL + POOL_W
N_IN = OFF_POOL_G + POOL_W

kernel_name = "hybrid_hyena_mla_pool_prefix_dit"


def rmsnorm(x, g):
    xf = x.astype(jnp.float32)
    y = xf * lax.rsqrt(jnp.mean(xf * xf, axis=-1, keepdims=True) + EPS)
    return (y * g.astype(jnp.float32)).astype(x.dtype)


def adaln(cond, w_ada, b_ada):
    mod = jax.nn.silu(cond) @ w_ada + b_ada
    shift, scale, gate = jnp.split(mod[:, None, :], 3, axis=-1)
    return shift, scale, gate


def rope_tables(L):
    n_rows = L // GRID_W
    row = jnp.broadcast_to(jnp.arange(n_rows, dtype=jnp.float32)[:, None], (n_rows, GRID_W)).reshape(L)
    col = jnp.broadcast_to(jnp.arange(GRID_W, dtype=jnp.float32)[None, :], (n_rows, GRID_W)).reshape(L)
    n_freq = MLA_DR // 4
    inv = ROPE_BASE ** (-jnp.arange(n_freq, dtype=jnp.float32) / n_freq)
    ang = jnp.concatenate([row[:, None] * inv, col[:, None] * inv], axis=-1)
    return jnp.cos(ang), jnp.sin(ang)


def apply_rope(x, cos, sin):
    xf = x.astype(jnp.float32).reshape(*x.shape[:-1], -1, 2)
    x0, x1 = xf[..., 0], xf[..., 1]
    out = jnp.stack([x0 * cos - x1 * sin, x0 * sin + x1 * cos], axis=-1)
    return out.reshape(x.shape).astype(x.dtype)


def short_conv(u, w, b):
    L = u.shape[1]
    up = jnp.pad(u, ((0, 0), (1, 1), (0, 0)))
    return up[:, :L] * w[0] + up[:, 1:L + 1] * w[1] + up[:, 2:] * w[2] + b


def hyena_spectrum(L, w1, b1, freq, w2, b2, w3):
    f32 = jnp.float32
    t = jnp.linspace(0.0, 1.0, L, dtype=f32)[:, None]
    wpos = (2.0 * math.pi / L) * jnp.arange(L, dtype=f32)[:, None]
    bands = jnp.linspace(1e-4, FILTER_BANDS - 1, FILTER_BANDS, dtype=f32)[None, :]
    feats = jnp.concatenate([t, jnp.cos(bands * wpos), -jnp.sin(bands * wpos)], axis=-1)
    h = jnp.sin(freq * (feats @ w1 + b1))
    h = jnp.sin(freq * (h @ w2 + b2))
    h = (h @ w3).astype(f32).reshape(L, 2, 2, HY_W)
    deltas = jnp.abs(jnp.linspace(math.log(DECAY_TARGET) / SLOW_DECAY,
                                  math.log(DECAY_TARGET) / FAST_DECAY, HY_W, dtype=f32))
    h = h * jnp.exp(-t[:, :, None, None] * deltas)
    k = jnp.concatenate([h[:, :, 0], jnp.zeros_like(h[:1, :, 0]), h[:0:-1, :, 1]], axis=0)
    k = k * lax.rsqrt(jnp.sum(k * k, axis=0, keepdims=True) + EPS)
    return jnp.fft.rfft(k, axis=0)


def fft_long_conv(z, k_f, bias):
    L = z.shape[1]
    zf = z.astype(jnp.float32)
    y = jnp.fft.irfft(jnp.fft.rfft(zf, n=2 * L, axis=1) * k_f, n=2 * L, axis=1)[:, :L]
    return (y + zf * bias.astype(jnp.float32)).astype(z.dtype)


def hyena_mix(u, lp):
    L = u.shape[1]
    u = short_conv(u, lp["hy_conv_w"], lp["hy_conv_b"])
    v, x1, x2 = jnp.split(u, 3, axis=-1)
    k_f = hyena_spectrum(L, lp["hf_w1"], lp["hf_b1"], lp["hf_freq"], lp["hf_w2"], lp["hf_b2"], lp["hf_w3"])
    z = x1 * fft_long_conv(v, k_f[:, 0], lp["hy_bias"][0])
    return x2 * fft_long_conv(z, k_f[:, 1], lp["hy_bias"][1])


def mla_queries(u_q, q_norm_g, w_uq, rope):
    B, L, _ = u_q.shape
    q = (rmsnorm(u_q, q_norm_g) @ w_uq).reshape(B, L, MLA_HEADS, MLA_DN + MLA_DR)
    q_nope, q_rope = q[..., :MLA_DN], q[..., MLA_DN:]
    if rope is not None:
        q_rope = apply_rope(q_rope, rope[0][:, None, :], rope[1][:, None, :])
    return q_nope, q_rope


def mla_keys(u_kvr, kv_norm_g, w_ukv, rope):
    B, L, _ = u_kvr.shape
    kv = (rmsnorm(u_kvr[..., :KV_RANK], kv_norm_g) @ w_ukv).reshape(B, L, MLA_HEADS, MLA_DN + MLA_DV)
    k_rope = u_kvr[..., KV_RANK:]
    if rope is not None:
        k_rope = apply_rope(k_rope, rope[0], rope[1])
    return kv[..., :MLA_DN], k_rope, kv[..., MLA_DN:]


def attend(q_nope, q_rope, k_nope, k_rope, v):
    s = (jnp.einsum('bqhd,bkhd->bhqk', q_nope, k_nope)
         + jnp.einsum('bqhr,bkr->bhqk', q_rope, k_rope))
    p = jax.nn.softmax(s.astype(jnp.float32) * ATTN_SCALE, axis=-1).astype(v.dtype)
    return jnp.einsum('bhqk,bkhd->bqhd', p, v)


def blocked_attend(q_nope, q_rope, k_nope, k_rope, v):
    B, L, H, _ = q_nope.shape
    nb = L // Q_BLOCK
    qn = q_nope.reshape(B, nb, Q_BLOCK, H, MLA_DN).swapaxes(0, 1)
    qr = q_rope.reshape(B, nb, Q_BLOCK, H, MLA_DR).swapaxes(0, 1)
    o = lax.map(lambda qb: attend(qb[0], qb[1], k_nope, k_rope, v), (qn, qr))
    return o.swapaxes(0, 1).reshape(B, L, H * MLA_DV)


def pool_mix(u, w_pool, pool_scale):
    B, L, _ = u.shape
    uf = u.astype(jnp.float32).reshape(B, L, N_POOL_GROUPS, POOL_GROUP)
    cs = jnp.pad(jnp.cumsum(uf, axis=1), ((0, 0), (1, 0), (0, 0), (0, 0)))
    t = jnp.arange(L)[:, None]
    halves = jnp.asarray(np.array([w // 2 for w in POOL_WINDOWS], dtype=np.int32))[None, :]
    lo = jnp.clip(t - halves, 0, L)
    hi = jnp.clip(t + halves, 0, L)
    gid = jnp.arange(N_POOL_GROUPS)[None, :]
    mean = (cs[:, hi, gid] - cs[:, lo, gid]) / (hi - lo).astype(jnp.float32)[None, :, :, None]
    d = (mean - uf).astype(u.dtype)
    y = jnp.einsum('blgc,gcd->blgd', d, w_pool).reshape(B, L, POOL_W)
    return y * pool_scale


def mixer(u, keys, lp, rope, blocked):
    B, L, _ = u.shape
    hy = hyena_mix(u[..., OFF_HY:OFF_HY_G], lp) * jax.nn.silu(u[..., OFF_HY_G:OFF_Q])
    q_nope, q_rope = mla_queries(u[..., OFF_Q:OFF_KV], lp["q_norm_g"], lp["w_uq"], rope)
    if blocked:
        att = blocked_attend(q_nope, q_rope, *keys)
    else:
        att = attend(q_nope, q_rope, *keys).reshape(B, L, MLA_W)
    mla = att * jax.nn.silu(u[..., OFF_MLA_G:OFF_POOL])
    pool = pool_mix(u[..., OFF_POOL:OFF_POOL_G], lp["w_pool"], lp["pool_scale"]) * jax.nn.silu(u[..., OFF_POOL_G:])
    return jnp.concatenate([hy, mla, pool], axis=-1)


def setup_inputs(seed: int = 0) -> dict:
    key = jax.random.key(seed)
    ks = jax.random.split(key, 25)

    def nrm(k, shape, scale):
        return jax.random.normal(k, shape, jnp.float32) * scale

    return {
        "x": nrm(ks[0], (BATCH, SEQ, D_MODEL), 1.0),
        "c": nrm(ks[1], (BATCH, D_MODEL), 1.0),
        "ctx": nrm(ks[2], (BATCH, CTX_LEN, D_MODEL), 1.0),
        "c_ctx": nrm(ks[3], (D_MODEL,), 1.0),
        "norm_g": 1.0 + nrm(ks[4], (DEPTH, D_MODEL), 0.02),
        "w_ada": nrm(ks[5], (DEPTH, D_MODEL, 3 * D_MODEL), 0.5 * D_MODEL ** -0.5),
        "b_ada": nrm(ks[6], (DEPTH, 3 * D_MODEL), 0.02),
        "w_in": nrm(ks[7], (DEPTH, D_MODEL, N_IN), D_MODEL ** -0.5),
        "hy_conv_w": nrm(ks[8], (DEPTH, SHORT_CONV, 3 * HY_W), SHORT_CONV ** -0.5),
        "hy_conv_b": nrm(ks[9], (DEPTH, 3 * HY_W), 0.02),
        "hf_w1": nrm(ks[10], (DEPTH, FILTER_EMB, FILTER_HIDDEN), FILTER_EMB ** -0.5),
        "hf_b1": nrm(ks[11], (DEPTH, FILTER_HIDDEN), 0.02),
        "hf_freq": 1.0 + nrm(ks[12], (DEPTH, FILTER_HIDDEN), 0.02),
        "hf_w2": nrm(ks[13], (DEPTH, FILTER_HIDDEN, FILTER_HIDDEN), FILTER_HIDDEN ** -0.5),
        "hf_b2": nrm(ks[14], (DEPTH, FILTER_HIDDEN), 0.02),
        "hf_w3": nrm(ks[15], (DEPTH, FILTER_HIDDEN, 4 * HY_W), FILTER_HIDDEN ** -0.5),
        "hy_bias": nrm(ks[16], (DEPTH, 2, HY_W), 0.1),
        "q_norm_g": 1.0 + nrm(ks[17], (DEPTH, Q_RANK), 0.02),
        "w_uq": nrm(ks[18], (DEPTH, Q_RANK, MLA_HEADS * (MLA_DN + MLA_DR)), Q_RANK ** -0.5),
        "kv_norm_g": 1.0 + nrm(ks[19], (DEPTH, KV_RANK), 0.02),
        "w_ukv": nrm(ks[20], (DEPTH, KV_RANK, MLA_HEADS * (MLA_DN + MLA_DV)), KV_RANK ** -0.5),
        "w_pool": nrm(ks[21], (DEPTH, N_POOL_GROUPS, POOL_GROUP, POOL_GROUP), POOL_GROUP ** -0.5),
        "pool_scale": 1.0 + nrm(ks[22], (DEPTH, POOL_W), 0.1),
        "w_out": nrm(ks[23], (DEPTH, MIX_W, D_MODEL), MIX_W ** -0.5),
        "final_norm_g": 1.0 + nrm(ks[24], (D_MODEL,), 0.02),
    }


def reference(x, c, ctx, c_ctx, norm_g, w_ada, b_ada, w_in, hy_conv_w, hy_conv_b,
              hf_w1, hf_b1, hf_freq, hf_w2, hf_b2, hf_w3, hy_bias,
              q_norm_g, w_uq, kv_norm_g, w_ukv, w_pool, pool_scale, w_out, final_norm_g):
    rope = rope_tables(x.shape[1])
    x_l, x_c = x, ctx
    for l in range(DEPTH):
        last = l == DEPTH - 1
        lp = {"hy_conv_w": hy_conv_w[l], "hy_conv_b": hy_conv_b[l],
              "hf_w1": hf_w1[l], "hf_b1": hf_b1[l], "hf_freq": hf_freq[l],
              "hf_w2": hf_w2[l], "hf_b2": hf_b2[l], "hf_w3": hf_w3[l], "hy_bias": hy_bias[l],
              "q_norm_g": q_norm_g[l], "w_uq": w_uq[l],
              "w_pool": w_pool[l], "pool_scale": pool_scale[l]}
        sh, sc, gt = adaln(c, w_ada[l], b_ada[l])
        sh_c, sc_c, gt_c = adaln(c_ctx[None], w_ada[l], b_ada[l])
        h_l = rmsnorm(x_l, norm_g[l]) * (1.0 + sc) + sh
        h_c = rmsnorm(x_c, norm_g[l]) * (1.0 + sc_c) + sh_c
        u_l = h_l @ w_in[l]
        if last:
            u_c = h_c @ w_in[l][:, OFF_KV:OFF_MLA_G]
            u_c_kvr = u_c
        else:
            u_c = h_c @ w_in[l]
            u_c_kvr = u_c[..., OFF_KV:OFF_MLA_G]
        k_c = mla_keys(u_c_kvr, kv_norm_g[l], w_ukv[l], None)
        k_l = mla_keys(u_l[..., OFF_KV:OFF_MLA_G], kv_norm_g[l], w_ukv[l], rope)
        keys_all = (jnp.concatenate([k_l[0], k_c[0]], axis=1),
                    jnp.concatenate([k_l[1], k_c[1]], axis=1),
                    jnp.concatenate([k_l[2], k_c[2]], axis=1))
        out_l = mixer(u_l, keys_all, lp, rope, True)
        if not last:
            out_c = mixer(u_c, k_c, lp, None, False)
            x_c = x_c + gt_c * (out_c @ w_out[l])
        x_l = x_l + gt * (out_l @ w_out[l])
    return rmsnorm(x_l, final_norm_g)
```

```cpp
#include <hip/hip_runtime.h>
#include <hip/hip_cooperative_groups.h>
#include <cstdio>
#include <cstdint>
namespace cg = cooperative_groups;

#ifndef ONE_LAUNCH
#define ONE_LAUNCH 0
#endif

constexpr int DM = 2048, NB = 4, SEQ = 2048, DEPTH = 4, CTXL = 256;
constexpr int HYW = 512, NH = 8, QRANK = 512, KVRANK = 256, POOLW = 512;
constexpr int OFF_HY_G = 1536, OFF_Q = 2048, OFF_KV = 2560, OFF_KR = 2816, OFF_MLA_G = 2880, OFF_POOL = 3904, OFF_POOL_G = 4416, NIN = 4928;
constexpr int ROWS_L = NB * SEQ, ROWS_C = NB * CTXL, ROWS = ROWS_L + ROWS_C;
constexpr int LK = SEQ + CTXL;
constexpr float EPS = 1e-6f;
constexpr float ATTN_SCALE = 0.07216878364870322f;
constexpr int NT = 512;

typedef float act_t;

struct Params {
    const float *x, *c, *ctx, *c_ctx, *norm_g, *w_ada, *b_ada, *w_in, *hy_conv_w, *hy_conv_b, *hf_w1, *hf_b1, *hf_freq, *hf_w2, *hf_b2, *hf_w3, *hy_bias,
        *q_norm_g, *w_uq, *kv_norm_g, *w_ukv, *w_pool, *pool_scale, *w_out, *final_norm_g;
    float* out; unsigned char* ws;
};

constexpr size_t al256(size_t x) { return (x + 255) / 256 * 256; }
constexpr size_t WS_MOD = 0;
constexpr size_t WS_FSCL = WS_MOD + al256((size_t)4 * 5 * 6144 * 4);
constexpr size_t WS_FL = WS_FSCL + al256((size_t)2 * 2 * 512 * 4);
constexpr size_t WS_FC = WS_FL + al256((size_t)2 * 2 * 2048 * 512 * 4);
constexpr size_t WS_HA = WS_FC + al256((size_t)2 * 2 * 256 * 512 * 4);
constexpr size_t WS_KVRAW = WS_HA;
constexpr size_t WS_U = WS_HA + al256((size_t)ROWS * 2048 * sizeof(act_t));
constexpr size_t WS_QN = WS_U + al256((size_t)ROWS * NIN * sizeof(act_t));
constexpr size_t WS_KVN = WS_QN + al256((size_t)ROWS * 512 * sizeof(act_t));
constexpr size_t WS_QRAW = WS_KVN + al256((size_t)ROWS * 256 * sizeof(act_t));
constexpr size_t WS_Q = WS_QRAW + al256((size_t)ROWS * 1536 * sizeof(act_t));
constexpr size_t WS_KB = WS_Q + al256((size_t)NB * NH * LK * 192 * sizeof(act_t));
constexpr size_t WS_VB = WS_KB + al256((size_t)NB * NH * LK * 192 * sizeof(act_t));
constexpr size_t WS_HC = WS_VB + al256((size_t)NB * NH * LK * 128 * sizeof(act_t));
constexpr size_t WS_Z2 = WS_HC + al256((size_t)ROWS * 1536 * sizeof(act_t));
constexpr size_t WS_PD = WS_Z2 + al256((size_t)ROWS * 512 * sizeof(act_t));
constexpr size_t WS_PY = WS_PD + al256((size_t)ROWS * 512 * sizeof(act_t));
constexpr size_t WS_MIX = WS_PY + al256((size_t)ROWS * 512 * sizeof(act_t));
constexpr size_t WS_XW = WS_MIX + al256((size_t)ROWS * 2048 * sizeof(act_t));
constexpr size_t WS_END = WS_XW + al256((size_t)ROWS * 2048 * 4);

constexpr int LDS_BYTES = 8 * LK * 4 + 8 * 192 * 4 + 64;

__device__ __forceinline__ float ldf(const float* p) { return *p; }
__device__ __forceinline__ void stf(float* p, float v) { *p = v; }
__device__ __forceinline__ float silu_f(float x) { return x / (1.f + expf(-x)); }
__device__ __forceinline__ float wave_sum(float v) {
#pragma unroll
    for (int o = 32; o > 0; o >>= 1) v += __shfl_xor(v, o);
    return v;
}
__device__ __forceinline__ float wave_max(float v) {
#pragma unroll
    for (int o = 32; o > 0; o >>= 1) v = fmaxf(v, __shfl_xor(v, o));
    return v;
}
struct RowInfo { int b, t, L, n, mr; };
__device__ __forceinline__ RowInfo rowinfo(int row) {
    RowInfo r;
    if (row < ROWS_L) { r.b = row >> 11; r.t = row & 2047; r.L = SEQ; r.n = r.t; r.mr = r.b; }
    else { const int q = row - ROWS_L; r.b = q >> 8; r.t = q & 255; r.L = CTXL; r.n = SEQ + r.t; r.mr = 4; }
    return r;
}
__device__ __forceinline__ const float* xin_row(const Params& p, int l, int row) {
    if (l == 0) return row < ROWS_L ? p.x + (size_t)row * DM : p.ctx + (size_t)(row - ROWS_L) * DM;
    return (const float*)(p.ws + WS_XW) + (size_t)row * DM;
}
#define WSP(T, off) ((T*)(p.ws + (off)))

__device__ void ph_adaln(const Params& p, int bid, int nb, float* sm) {
    for (int i = threadIdx.x; i < 5 * DM; i += NT) { const int r = i >> 11, k = i & 2047; sm[i] = silu_f(r < 4 ? p.c[r * DM + k] : p.c_ctx[k]); }
    __syncthreads();
    float* MOD = WSP(float, WS_MOD);
    for (int idx = bid * NT + threadIdx.x; idx < DEPTH * 6144; idx += nb * NT) {
        const int l = idx / 6144, n = idx % 6144;
        const float* W = p.w_ada + (size_t)l * DM * 6144 + n;
        float a0 = 0, a1 = 0, a2 = 0, a3 = 0, a4 = 0;
        for (int k = 0; k < DM; ++k) { const float w = W[(size_t)k * 6144]; a0 += sm[k] * w; a1 += sm[2048 + k] * w; a2 += sm[4096 + k] * w; a3 += sm[6144 + k] * w; a4 += sm[8192 + k] * w; }
        const float bb = p.b_ada[l * 6144 + n];
        MOD[(l * 5 + 0) * 6144 + n] = a0 + bb; MOD[(l * 5 + 1) * 6144 + n] = a1 + bb; MOD[(l * 5 + 2) * 6144 + n] = a2 + bb;
        MOD[(l * 5 + 3) * 6144 + n] = a3 + bb; MOD[(l * 5 + 4) * 6144 + n] = a4 + bb;
    }
    __syncthreads();
}

__device__ void ph_filter(const Params& p, int l, int bid, int nb, float* sm) {
    float* feats = sm; float* h1 = sm + 64; float* h2 = sm + 128;
    const int tid = threadIdx.x;
    const float DA = -3.0701134573253944f, DB = -15.350567286626973f;
    for (int u = bid; u < SEQ + CTXL; u += nb) {
        const int Lidx = u < SEQ ? 0 : 1, L = Lidx ? CTXL : SEQ, pos = Lidx ? u - SEQ : u;
        const float t = (float)pos / (float)(L - 1), wpos = (6.283185307179586f / (float)L) * (float)pos;
        if (tid < 33) {
            float f;
            if (tid == 0) f = t;
            else { const int i = (tid - 1) & 15; const float band = 1e-4f + (float)i * ((15.f - 1e-4f) / 15.f); const float a = band * wpos; f = (tid <= 16) ? cosf(a) : -sinf(a); }
            feats[tid] = f;
        }
        __syncthreads();
        if (tid < 64) { float s = p.hf_b1[l * 64 + tid]; for (int e = 0; e < 33; ++e) s += feats[e] * p.hf_w1[(l * 33 + e) * 64 + tid]; h1[tid] = sinf(p.hf_freq[l * 64 + tid] * s); }
        __syncthreads();
        if (tid < 64) { float s = p.hf_b2[l * 64 + tid]; for (int i = 0; i < 64; ++i) s += h1[i] * p.hf_w2[(l * 64 + i) * 64 + tid]; h2[tid] = sinf(p.hf_freq[l * 64 + tid] * s); }
        __syncthreads();
        float* F = Lidx ? WSP(float, WS_FC) : WSP(float, WS_FL);
        for (int n = tid; n < 2048; n += NT) {
            float s = 0; for (int j = 0; j < 64; ++j) s += h2[j] * p.hf_w3[((size_t)l * 64 + j) * 2048 + n];
            const int o = n >> 10, d = (n >> 9) & 1, c = n & 511;
            const float delta = fabsf(DA + (float)c * ((DB - DA) / 511.f));
            s *= expf(-t * delta);
            F[(((size_t)o * 2 + d) * L + pos) * 512 + c] = s;
        }
        __syncthreads();
    }
}
__device__ void ph_fscale(const Params& p, int bid, int nb) {
    float* FS = WSP(float, WS_FSCL);
    for (int idx = bid * NT + threadIdx.x; idx < 2048; idx += nb * NT) {
        const int Lidx = idx >> 10, o = (idx >> 9) & 1, c = idx & 511, L = Lidx ? CTXL : SEQ;
        const float* F = Lidx ? WSP(float, WS_FC) : WSP(float, WS_FL);
        float s = 0;
        for (int pos = 0; pos < L; ++pos) {
            const float a = F[(((size_t)o * 2 + 0) * L + pos) * 512 + c]; s += a * a;
            if (pos >= 1) { const float b2 = F[(((size_t)o * 2 + 1) * L + pos) * 512 + c]; s += b2 * b2; }
        }
        FS[idx] = rsqrtf(s + EPS);
    }
}

__device__ void ph_norm(const Params& p, int l, int bid, int nb) {
    const int lane = threadIdx.x & 63, wid = threadIdx.x >> 6, nw = NT >> 6;
    const float* MOD = WSP(float, WS_MOD); act_t* HA = WSP(act_t, WS_HA);
    for (int row = bid * nw + wid; row < ROWS; row += nb * nw) {
        const RowInfo r = rowinfo(row);
        const float* xr = xin_row(p, l, row);
        float4 v[8]; float ss = 0;
#pragma unroll
        for (int j = 0; j < 8; ++j) { v[j] = *(const float4*)(xr + (j * 64 + lane) * 4); ss += v[j].x * v[j].x + v[j].y * v[j].y + v[j].z * v[j].z + v[j].w * v[j].w; }
        ss = wave_sum(ss);
        const float rstd = rsqrtf(ss * (1.f / DM) + EPS);
        const float* g = p.norm_g + l * DM; const float* sh = MOD + (size_t)(l * 5 + r.mr) * 6144; const float* sc = sh + 2048;
#pragma unroll
        for (int j = 0; j < 8; ++j) {
            const int k = (j * 64 + lane) * 4;
            const float e[4] = {v[j].x, v[j].y, v[j].z, v[j].w};
#pragma unroll
            for (int q = 0; q < 4; ++q) stf(HA + (size_t)row * DM + k + q, e[q] * rstd * g[k + q] * (1.f + sc[k + q]) + sh[k + q]);
        }
    }
}

template <int EPI>
__device__ void gemm_naive(const Params& p, int l, const act_t* A, int lda, const float* B, int ldb, act_t* C, int ldc, int M, int N, int K, int bid, int nb, float* sm) {
    float* As = sm; float* Bs = sm + 16 * 132;
    const int tid = threadIdx.x, tx = tid & 15, ty = tid >> 4;
    const int tilesN = N / 64, tiles = (M / 128) * tilesN;
    for (int tile = bid; tile < tiles; tile += nb) {
        const int m0 = (tile / tilesN) * 128, n0 = (tile % tilesN) * 64;
        float acc[4][4];
#pragma unroll
        for (int i = 0; i < 4; ++i)
#pragma unroll
            for (int j = 0; j < 4; ++j) acc[i][j] = 0.f;
        for (int k0 = 0; k0 < K; k0 += 16) {
            { const int r = tid >> 2, kq = (tid & 3) * 4; const act_t* ap = A + (size_t)(m0 + r) * lda + k0 + kq;
              As[(kq + 0) * 132 + r] = ldf(ap); As[(kq + 1) * 132 + r] = ldf(ap + 1); As[(kq + 2) * 132 + r] = ldf(ap + 2); As[(kq + 3) * 132 + r] = ldf(ap + 3); }
            { const int kk = tid >> 5, nn = (tid & 31) * 2; const float* bp = B + (size_t)(k0 + kk) * ldb + n0 + nn; Bs[kk * 64 + nn] = bp[0]; Bs[kk * 64 + nn + 1] = bp[1]; }
            __syncthreads();
#pragma unroll
            for (int kk = 0; kk < 16; ++kk) {
                const float4 a = *(const float4*)&As[kk * 132 + ty * 4]; const float4 b = *(const float4*)&Bs[kk * 64 + tx * 4];
                const float av[4] = {a.x, a.y, a.z, a.w}, bv[4] = {b.x, b.y, b.z, b.w};
#pragma unroll
                for (int i = 0; i < 4; ++i)
#pragma unroll
                    for (int j = 0; j < 4; ++j) acc[i][j] += av[i] * bv[j];
            }
            __syncthreads();
        }
#pragma unroll
        for (int i = 0; i < 4; ++i) {
            const int m = m0 + ty * 4 + i;
            if (EPI == 0) {
#pragma unroll
                for (int j = 0; j < 4; ++j) stf(C + (size_t)m * ldc + n0 + tx * 4 + j, acc[i][j]);
            } else {
                const RowInfo r = rowinfo(m);
                const float* xr = xin_row(p, l, m);
                const float* gate = WSP(float, WS_MOD) + (size_t)(l * 5 + r.mr) * 6144 + 4096;
                float* XW = WSP(float, WS_XW) + (size_t)m * DM;
#pragma unroll
                for (int j = 0; j < 4; ++j) { const int n = n0 + tx * 4 + j; XW[n] = xr[n] + gate[n] * acc[i][j]; }
            }
        }
    }
}

__device__ void ph_rms_small(const Params& p, int l, int bid, int nb) {
    const int lane = threadIdx.x & 63, wid = threadIdx.x >> 6, nw = NT >> 6;
    const act_t* U = WSP(act_t, WS_U); act_t* QN = WSP(act_t, WS_QN); act_t* KVN = WSP(act_t, WS_KVN);
    for (int row = bid * nw + wid; row < ROWS; row += nb * nw) {
        const act_t* ur = U + (size_t)row * NIN;
        float q[8]; float ss = 0;
#pragma unroll
        for (int j = 0; j < 8; ++j) { q[j] = ldf(ur + OFF_Q + j * 64 + lane); ss += q[j] * q[j]; }
        ss = wave_sum(ss); float rstd = rsqrtf(ss * (1.f / QRANK) + EPS);
#pragma unroll
        for (int j = 0; j < 8; ++j) stf(QN + (size_t)row * 512 + j * 64 + lane, q[j] * rstd * p.q_norm_g[l * 512 + j * 64 + lane]);
        float kv[4]; ss = 0;
#pragma unroll
        for (int j = 0; j < 4; ++j) { kv[j] = ldf(ur + OFF_KV + j * 64 + lane); ss += kv[j] * kv[j]; }
        ss = wave_sum(ss); rstd = rsqrtf(ss * (1.f / KVRANK) + EPS);
#pragma unroll
        for (int j = 0; j < 4; ++j) stf(KVN + (size_t)row * 256 + j * 64 + lane, kv[j] * rstd * p.kv_norm_g[l * 256 + j * 64 + lane]);
    }
}
__device__ void ph_shortconv(const Params& p, int l, int bid, int nb) {
    const act_t* U = WSP(act_t, WS_U); act_t* HC = WSP(act_t, WS_HC);
    const float* w = p.hy_conv_w + (size_t)l * 3 * 1536; const float* bb = p.hy_conv_b + l * 1536;
    for (size_t idx = (size_t)bid * NT + threadIdx.x; idx < (size_t)ROWS * 1536; idx += (size_t)nb * NT) {
        const int row = (int)(idx / 1536), c = (int)(idx % 1536);
        const RowInfo r = rowinfo(row);
        const float cur = ldf(U + (size_t)row * NIN + c);
        const float prev = r.t > 0 ? ldf(U + (size_t)(row - 1) * NIN + c) : 0.f;
        const float next = r.t < r.L - 1 ? ldf(U + (size_t)(row + 1) * NIN + c) : 0.f;
        stf(HC + (size_t)row * 1536 + c, prev * w[c] + cur * w[1536 + c] + next * w[3072 + c] + bb[c]);
    }
}
__device__ void ph_pooldiff(const Params& p, int bid, int nb) {
    const act_t* U = WSP(act_t, WS_U); act_t* PD = WSP(act_t, WS_PD);
    for (size_t idx = (size_t)bid * NT + threadIdx.x; idx < (size_t)ROWS * 512; idx += (size_t)nb * NT) {
        const int row = (int)(idx >> 9), j = (int)(idx & 511);
        const RowInfo r = rowinfo(row);
        const int half = 1 << (j >> 7);
        const int lo = max(r.t - half, 0), hi = min(r.t + half, r.L);
        float s = 0;
        for (int q = lo; q < hi; ++q) s += ldf(U + (size_t)(row - r.t + q) * NIN + OFF_POOL + j);
        stf(PD + idx, s / (float)(hi - lo) - ldf(U + (size_t)row * NIN + OFF_POOL + j));
    }
}
__device__ void ph_poolgate(const Params& p, int l, int bid, int nb) {
    const act_t* U = WSP(act_t, WS_U); const act_t* PY = WSP(act_t, WS_PY); act_t* MIX = WSP(act_t, WS_MIX);
    for (size_t idx = (size_t)bid * NT + threadIdx.x; idx < (size_t)ROWS * 512; idx += (size_t)nb * NT) {
        const int row = (int)(idx >> 9), j = (int)(idx & 511);
        stf(MIX + (size_t)row * DM + 1536 + j, ldf(PY + idx) * p.pool_scale[l * 512 + j] * silu_f(ldf(U + (size_t)row * NIN + OFF_POOL_G + j)));
    }
}
__device__ void ph_pack_qkv(const Params& p, int bid, int nb) {
    const act_t* U = WSP(act_t, WS_U); const act_t* QR = WSP(act_t, WS_QRAW); const act_t* KVR = WSP(act_t, WS_KVRAW);
    act_t* Q = WSP(act_t, WS_Q); act_t* KB = WSP(act_t, WS_KB); act_t* VB = WSP(act_t, WS_VB);
    for (size_t idx = (size_t)bid * NT + threadIdx.x; idx < (size_t)ROWS * NH * 128; idx += (size_t)nb * NT) {
        const int d = (int)(idx & 127), h = (int)((idx >> 7) & 7), row = (int)(idx >> 10);
        const RowInfo r = rowinfo(row);
        const size_t pos = (size_t)(r.b * NH + h) * LK + r.n;
        stf(Q + pos * 192 + d, ldf(QR + (size_t)row * 1536 + h * 192 + d));
        stf(KB + pos * 192 + d, ldf(KVR + (size_t)row * 2048 + h * 256 + d));
        stf(VB + pos * 128 + d, ldf(KVR + (size_t)row * 2048 + h * 256 + 128 + d));
    }
    for (size_t idx = (size_t)bid * NT + threadIdx.x; idx < (size_t)ROWS * NH * 32; idx += (size_t)nb * NT) {
        const int i = (int)(idx & 31), h = (int)((idx >> 5) & 7), row = (int)(idx >> 8);
        const RowInfo r = rowinfo(row);
        const size_t pos = (size_t)(r.b * NH + h) * LK + r.n;
        float cs = 1.f, sn = 0.f;
        if (row < ROWS_L) {
            const float inv = expf(-(float)(i & 15) * (9.210340371976184f / 16.f));
            const float ang = (float)(i < 16 ? (r.t >> 6) : (r.t & 63)) * inv;
            cs = cosf(ang); sn = sinf(ang);
        }
        const float q0 = ldf(QR + (size_t)row * 1536 + h * 192 + 128 + 2 * i), q1 = ldf(QR + (size_t)row * 1536 + h * 192 + 128 + 2 * i + 1);
        stf(Q + pos * 192 + 128 + 2 * i, q0 * cs - q1 * sn); stf(Q + pos * 192 + 128 + 2 * i + 1, q0 * sn + q1 * cs);
        const float k0 = ldf(U + (size_t)row * NIN + OFF_KR + 2 * i), k1 = ldf(U + (size_t)row * NIN + OFF_KR + 2 * i + 1);
        stf(KB + pos * 192 + 128 + 2 * i, k0 * cs - k1 * sn); stf(KB + pos * 192 + 128 + 2 * i + 1, k0 * sn + k1 * cs);
    }
}

__device__ void ph_attn(const Params& p, int l, int bid, int nb, float* sm) {
    float* S = sm; float* qs = sm + 8 * LK; float* linv = qs + 8 * 192;
    const int tid = threadIdx.x, lane = tid & 63, wid = tid >> 6;
    const act_t* Q = WSP(act_t, WS_Q); const act_t* KB = WSP(act_t, WS_KB); const act_t* VB = WSP(act_t, WS_VB); const act_t* U = WSP(act_t, WS_U); act_t* MIX = WSP(act_t, WS_MIX);
    const int nlat = NB * NH * (SEQ / 8), nctx = (l < DEPTH - 1) ? NB * NH * (CTXL / 8) : 0;
    for (int u = bid; u < nlat + nctx; u += nb) {
        int b, h, q0, k0, nk;
        if (u < nlat) { b = u >> 11; h = (u >> 8) & 7; q0 = (u & 255) * 8; k0 = 0; nk = LK; }
        else { const int v = u - nlat; b = v >> 8; h = (v >> 5) & 7; q0 = SEQ + (v & 31) * 8; k0 = SEQ; nk = CTXL; }
        const size_t hb = (size_t)(b * NH + h) * LK;
        const act_t* Qp = Q + (hb + q0) * 192; const act_t* Kp = KB + (hb + k0) * 192; const act_t* Vp = VB + (hb + k0) * 128;
        for (int i = tid; i < 8 * 192; i += NT) qs[i] = ldf(Qp + i);
        __syncthreads();
        for (int kk = tid; kk < nk; kk += NT) {
            float acc[8];
#pragma unroll
            for (int i = 0; i < 8; ++i) acc[i] = 0.f;
            const act_t* kr = Kp + (size_t)kk * 192;
            for (int d = 0; d < 192; ++d) { const float kv = ldf(kr + d);
#pragma unroll
                for (int i = 0; i < 8; ++i) acc[i] += kv * qs[i * 192 + d]; }
#pragma unroll
            for (int i = 0; i < 8; ++i) S[i * LK + kk] = acc[i] * ATTN_SCALE;
        }
        __syncthreads();
        { float* row = S + wid * LK; float m = -INFINITY;
          for (int kk = lane; kk < nk; kk += 64) m = fmaxf(m, row[kk]);
          m = wave_max(m); float s = 0;
          for (int kk = lane; kk < nk; kk += 64) { const float e = expf(row[kk] - m); row[kk] = e; s += e; }
          s = wave_sum(s); if (lane == 0) linv[wid] = 1.f / s; }
        __syncthreads();
        { const int d = tid & 127, qg = tid >> 7; float o0 = 0, o1 = 0; const float* s0 = S + (2 * qg) * LK; const float* s1 = s0 + LK;
          for (int kk = 0; kk < nk; ++kk) { const float v = ldf(Vp + (size_t)kk * 128 + d); o0 += s0[kk] * v; o1 += s1[kk] * v; }
#pragma unroll
          for (int e = 0; e < 2; ++e) { const int qi = 2 * qg + e, n = q0 + qi; const int row = n < SEQ ? b * SEQ + n : ROWS_L + b * CTXL + (n - SEQ);
              const float g = ldf(U + (size_t)row * NIN + OFF_MLA_G + h * 128 + d);
              stf(MIX + (size_t)row * DM + 512 + h * 128 + d, (e ? o1 : o0) * linv[qi] * silu_f(g)); } }
        __syncthreads();
    }
}

__device__ void ph_conv(const Params& p, int l, int order, int bid, int nb, float* sm) {
    float* Zs = sm; float* Ks = sm + 4096;
    const int tid = threadIdx.x, c = tid & 63, tg = tid >> 6;
    const act_t* U = WSP(act_t, WS_U); const act_t* HC = WSP(act_t, WS_HC); act_t* Z2 = WSP(act_t, WS_Z2); act_t* MIX = WSP(act_t, WS_MIX);
    const act_t* zsrc = order == 0 ? HC : Z2; const int zld = order == 0 ? 1536 : 512;
    const int nlat = NB * (SEQ / 64) * 8, nctx = (l < DEPTH - 1) ? NB * (CTXL / 64) * 8 : 0;
    for (int u = bid; u < nlat + nctx; u += nb) {
        int Lidx, b, T0, c0, L, rowbase;
        if (u < nlat) { Lidx = 0; L = SEQ; b = u >> 8; T0 = ((u >> 3) & 31) * 64; c0 = (u & 7) * 64; rowbase = b * SEQ; }
        else { const int v = u - nlat; Lidx = 1; L = CTXL; b = v >> 5; T0 = ((v >> 3) & 3) * 64; c0 = (v & 7) * 64; rowbase = ROWS_L + b * CTXL; }
        const float* F = (Lidx ? WSP(float, WS_FC) : WSP(float, WS_FL)) + (size_t)order * 2 * L * 512;
        float acc[8];
#pragma unroll
        for (int i = 0; i < 8; ++i) acc[i] = 0.f;
        for (int S0 = 0; S0 < L; S0 += 64) {
            for (int i = tid; i < 4096; i += NT) { const int ss = i >> 6, cc = i & 63; Zs[i] = ldf(zsrc + (size_t)(rowbase + S0 + ss) * zld + c0 + cc); }
            for (int i = tid; i < 127 * 64; i += NT) { const int j = i >> 6, cc = i & 63; const int n = T0 - S0 + j - 63;
                Ks[i] = n >= 0 ? F[((size_t)0 * L + n) * 512 + c0 + cc] : F[((size_t)1 * L + (-n)) * 512 + c0 + cc]; }
            __syncthreads();
            for (int ss = 0; ss < 64; ++ss) { const float z = Zs[ss * 64 + c];
#pragma unroll
                for (int i = 0; i < 8; ++i) acc[i] += z * Ks[(tg * 8 + i - ss + 63) * 64 + c]; }
            __syncthreads();
        }
        const float scl = WSP(float, WS_FSCL)[(Lidx * 2 + order) * 512 + c0 + c], bias = p.hy_bias[(l * 2 + order) * 512 + c0 + c];
#pragma unroll
        for (int i = 0; i < 8; ++i) {
            const int row = rowbase + T0 + tg * 8 + i;
            const float zt = ldf(zsrc + (size_t)row * zld + c0 + c);
            const float y = scl * acc[i] + bias * zt;
            if (order == 0) stf(Z2 + (size_t)row * 512 + c0 + c, ldf(HC + (size_t)row * 1536 + 512 + c0 + c) * y);
            else stf(MIX + (size_t)row * DM + c0 + c, ldf(HC + (size_t)row * 1536 + 1024 + c0 + c) * y * silu_f(ldf(U + (size_t)row * NIN + OFF_HY_G + c0 + c)));
        }
    }
}

__device__ void ph_final(const Params& p, int bid, int nb) {
    const int lane = threadIdx.x & 63, wid = threadIdx.x >> 6, nw = NT >> 6;
    for (int row = bid * nw + wid; row < ROWS_L; row += nb * nw) {
        const float* xr = WSP(float, WS_XW) + (size_t)row * DM;
        float4 v[8]; float ss = 0;
#pragma unroll
        for (int j = 0; j < 8; ++j) { v[j] = *(const float4*)(xr + (j * 64 + lane) * 4); ss += v[j].x * v[j].x + v[j].y * v[j].y + v[j].z * v[j].z + v[j].w * v[j].w; }
        ss = wave_sum(ss);
        const float rstd = rsqrtf(ss * (1.f / DM) + EPS);
#pragma unroll
        for (int j = 0; j < 8; ++j) { const int k = (j * 64 + lane) * 4; const float4 g = *(const float4*)(p.final_norm_g + k);
            *(float4*)(p.out + (size_t)row * DM + k) = make_float4(v[j].x * rstd * g.x, v[j].y * rstd * g.y, v[j].z * rstd * g.z, v[j].w * rstd * g.w); }
    }
}

enum { PH_ADALN = 0, PH_1, PH_2, PH_3, PH_4, PH_5, PH_6, PH_7, PH_FINAL };
__device__ __forceinline__ void run_phase(const Params& p, int ph, int l, int bid, int nb, float* sm) {
    switch (ph) {
    case PH_ADALN: ph_adaln(p, bid, nb, sm); break;
    case PH_1: ph_filter(p, l, bid, nb, sm); ph_norm(p, l, bid, nb); break;
    case PH_2: ph_fscale(p, bid, nb);
        gemm_naive<0>(p, l, WSP(act_t, WS_HA), DM, p.w_in + (size_t)l * DM * NIN, NIN, WSP(act_t, WS_U), NIN, ROWS, NIN, DM, bid, nb, sm); break;
    case PH_3: ph_rms_small(p, l, bid, nb); ph_shortconv(p, l, bid, nb); ph_pooldiff(p, bid, nb); break;
    case PH_4:
        gemm_naive<0>(p, l, WSP(act_t, WS_QN), 512, p.w_uq + (size_t)l * 512 * 1536, 1536, WSP(act_t, WS_QRAW), 1536, ROWS, 1536, 512, bid, nb, sm);
        gemm_naive<0>(p, l, WSP(act_t, WS_KVN), 256, p.w_ukv + (size_t)l * 256 * 2048, 2048, WSP(act_t, WS_KVRAW), 2048, ROWS, 2048, 256, bid, nb, sm);
        for (int g = 0; g < 4; ++g)
            gemm_naive<0>(p, l, WSP(act_t, WS_PD) + g * 128, 512, p.w_pool + (size_t)(l * 4 + g) * 128 * 128, 128, WSP(act_t, WS_PY) + g * 128, 512, ROWS, 128, 128, bid, nb, sm);
        ph_conv(p, l, 0, bid, nb, sm); break;
    case PH_5: ph_pack_qkv(p, bid, nb); ph_conv(p, l, 1, bid, nb, sm); ph_poolgate(p, l, bid, nb); break;
    case PH_6: ph_attn(p, l, bid, nb, sm); break;
    case PH_7: gemm_naive<1>(p, l, WSP(act_t, WS_MIX), DM, p.w_out + (size_t)l * DM * DM, DM, nullptr, 0, l == DEPTH - 1 ? ROWS_L : ROWS, DM, DM, bid, nb, sm); break;
    case PH_FINAL: ph_final(p, bid, nb); break;
    }
}

#if ONE_LAUNCH
__global__ void __launch_bounds__(NT) mega_fwd(Params p) {
    extern __shared__ __attribute__((aligned(16))) unsigned char lds[];
    cg::grid_group grid = cg::this_grid();
    float* sm = (float*)lds; const int bid = blockIdx.x, nb = gridDim.x;
    run_phase(p, PH_ADALN, 0, bid, nb, sm);
    for (int l = 0; l < DEPTH; ++l)
        for (int ph = PH_1; ph <= PH_7; ++ph) { grid.sync(); run_phase(p, ph, l, bid, nb, sm); }
    grid.sync();
    run_phase(p, PH_FINAL, 0, bid, nb, sm);
}
#else
__global__ void __launch_bounds__(NT) k_phase(Params p, int ph, int l) {
    extern __shared__ __attribute__((aligned(16))) unsigned char lds[];
    run_phase(p, ph, l, blockIdx.x, gridDim.x, (float*)lds);
}
#endif

extern "C" void kernel_launch(void* const* d_in, const int* in_sizes, int n_in, void* d_out, int out_size, void* d_ws, size_t ws_size, hipStream_t stream) {
    if (n_in != 25 || ws_size < WS_END) { fprintf(stderr, "kernel_launch: bad inputs (n_in %d, ws %zu < %zu)\n", n_in, ws_size, (size_t)WS_END); return; }
    Params p{};
    const float** pp = (const float**)&p;
    for (int i = 0; i < 25; ++i) pp[i] = (const float*)d_in[i];
    p.out = (float*)d_out; p.ws = (unsigned char*)d_ws;
#if ONE_LAUNCH
    static int grid = 0;
    if (!grid) {
        int dev = 0, cus = 0, per_cu = 0;
        hipGetDevice(&dev); hipDeviceGetAttribute(&cus, hipDeviceAttributeMultiprocessorCount, dev);
        hipFuncSetAttribute((const void*)mega_fwd, hipFuncAttributeMaxDynamicSharedMemorySize, LDS_BYTES);
        hipOccupancyMaxActiveBlocksPerMultiprocessor(&per_cu, (const void*)mega_fwd, NT, LDS_BYTES);
        if (per_cu < 1) per_cu = 1;
        grid = cus * 1;
    }
    void* args[] = {&p};
    hipError_t e = hipLaunchCooperativeKernel((const void*)mega_fwd, dim3(grid), dim3(NT), args, LDS_BYTES, stream);
    if (e != hipSuccess) fprintf(stderr, "cooperative launch failed: %s (grid %d)\n", hipGetErrorString(e), grid);
#else
    static int init = 0;
    if (!init) { hipFuncSetAttribute((const void*)k_phase, hipFuncAttributeMaxDynamicSharedMemorySize, LDS_BYTES); init = 1; }
    const int G = 1024;
    k_phase<<<G, NT, LDS_BYTES, stream>>>(p, PH_ADALN, 0);
    for (int l = 0; l < DEPTH; ++l)
        for (int ph = PH_1; ph <= PH_7; ++ph) k_phase<<<G, NT, LDS_BYTES, stream>>>(p, ph, l);
    k_phase<<<G, NT, LDS_BYTES, stream>>>(p, PH_FINAL, 0);
#endif
}
```

```cpp
#include <hip/hip_runtime.h>
#include <hip/hip_cooperative_groups.h>
#include <cstdio>
#include <cstdint>
namespace cg = cooperative_groups;

#ifndef ONE_LAUNCH
#define ONE_LAUNCH 1
#endif

constexpr int DM = 2048, NB = 4, SEQ = 2048, DEPTH = 4, CTXL = 256;
constexpr int HYW = 512, NH = 8, QRANK = 512, KVRANK = 256, POOLW = 512;
constexpr int OFF_HY_G = 1536, OFF_Q = 2048, OFF_KV = 2560, OFF_KR = 2816, OFF_MLA_G = 2880, OFF_POOL = 3904, OFF_POOL_G = 4416, NIN = 4928;
constexpr int ROWS_L = NB * SEQ, ROWS_C = NB * CTXL, ROWS = ROWS_L + ROWS_C;
constexpr int LK = SEQ + CTXL;
constexpr float EPS = 1e-6f;
constexpr float ATTN_SCALE = 0.07216878364870322f;
constexpr int NT = 512;

typedef float act_t;

struct Params {
    const float *x, *c, *ctx, *c_ctx, *norm_g, *w_ada, *b_ada, *w_in, *hy_conv_w, *hy_conv_b, *hf_w1, *hf_b1, *hf_freq, *hf_w2, *hf_b2, *hf_w3, *hy_bias,
        *q_norm_g, *w_uq, *kv_norm_g, *w_ukv, *w_pool, *pool_scale, *w_out, *final_norm_g;
    float* out; unsigned char* ws;
};

constexpr size_t al256(size_t x) { return (x + 255) / 256 * 256; }
constexpr size_t WS_MOD = 0;
constexpr size_t WS_FSCL = WS_MOD + al256((size_t)4 * 5 * 6144 * 4);
constexpr size_t WS_FL = WS_FSCL + al256((size_t)2 * 2 * 512 * 4);
constexpr size_t WS_FC = WS_FL + al256((size_t)2 * 2 * 2048 * 512 * 4);
constexpr size_t WS_HA = WS_FC + al256((size_t)2 * 2 * 256 * 512 * 4);
constexpr size_t WS_KVRAW = WS_HA;
constexpr size_t WS_U = WS_HA + al256((size_t)ROWS * 2048 * sizeof(act_t));
constexpr size_t WS_QN = WS_U + al256((size_t)ROWS * NIN * sizeof(act_t));
constexpr size_t WS_KVN = WS_QN + al256((size_t)ROWS * 512 * sizeof(act_t));
constexpr size_t WS_QRAW = WS_KVN + al256((size_t)ROWS * 256 * sizeof(act_t));
constexpr size_t WS_Q = WS_QRAW + al256((size_t)ROWS * 1536 * sizeof(act_t));
constexpr size_t WS_KB = WS_Q + al256((size_t)NB * NH * LK * 192 * sizeof(act_t));
constexpr size_t WS_VB = WS_KB + al256((size_t)NB * NH * LK * 192 * sizeof(act_t));
constexpr size_t WS_HC = WS_VB + al256((size_t)NB * NH * LK * 128 * sizeof(act_t));
constexpr size_t WS_Z2 = WS_HC + al256((size_t)ROWS * 1536 * sizeof(act_t));
constexpr size_t WS_PD = WS_Z2 + al256((size_t)ROWS * 512 * sizeof(act_t));
constexpr size_t WS_PY = WS_PD + al256((size_t)ROWS * 512 * sizeof(act_t));
constexpr size_t WS_MIX = WS_PY + al256((size_t)ROWS * 512 * sizeof(act_t));
constexpr size_t WS_XW = WS_MIX + al256((size_t)ROWS * 2048 * sizeof(act_t));
constexpr size_t WS_END = WS_XW + al256((size_t)ROWS * 2048 * 4);

constexpr int LDS_BYTES = 8 * LK * 4 + 8 * 192 * 4 + 64;

__device__ __forceinline__ float ldf(const float* p) { return *p; }
__device__ __forceinline__ void stf(float* p, float v) { *p = v; }
__device__ __forceinline__ float fsin(float x) { return __builtin_amdgcn_sinf(x * 0.15915494309189535f); }
__device__ __forceinline__ float fcos(float x) { return __builtin_amdgcn_cosf(x * 0.15915494309189535f); }
__device__ __forceinline__ float silu_f(float x) { return x / (1.f + expf(-x)); }
__device__ __forceinline__ float wave_sum(float v) {
#pragma unroll
    for (int o = 32; o > 0; o >>= 1) v += __shfl_xor(v, o);
    return v;
}
__device__ __forceinline__ float wave_max(float v) {
#pragma unroll
    for (int o = 32; o > 0; o >>= 1) v = fmaxf(v, __shfl_xor(v, o));
    return v;
}
struct RowInfo { int b, t, L, n, mr; };
__device__ __forceinline__ RowInfo rowinfo(int row) {
    RowInfo r;
    if (row < ROWS_L) { r.b = row >> 11; r.t = row & 2047; r.L = SEQ; r.n = r.t; r.mr = r.b; }
    else { const int q = row - ROWS_L; r.b = q >> 8; r.t = q & 255; r.L = CTXL; r.n = SEQ + r.t; r.mr = 4; }
    return r;
}
__device__ __forceinline__ const float* xin_row(const Params& p, int l, int row) {
    if (l == 0) return row < ROWS_L ? p.x + (size_t)row * DM : p.ctx + (size_t)(row - ROWS_L) * DM;
    return (const float*)(p.ws + WS_XW) + (size_t)row * DM;
}
#define WSP(T, off) ((T*)(p.ws + (off)))

__device__ void ph_adaln(const Params& p, int bid, int nb, float* sm) {
    for (int i = threadIdx.x; i < 5 * DM; i += NT) { const int r = i >> 11, k = i & 2047; sm[i] = silu_f(r < 4 ? p.c[r * DM + k] : p.c_ctx[k]); }
    __syncthreads();
    float* MOD = WSP(float, WS_MOD);
    for (int idx = bid * NT + threadIdx.x; idx < DEPTH * 6144; idx += nb * NT) {
        const int l = idx / 6144, n = idx % 6144;
        const float* W = p.w_ada + (size_t)l * DM * 6144 + n;
        float a0 = 0, a1 = 0, a2 = 0, a3 = 0, a4 = 0;
        for (int k = 0; k < DM; ++k) { const float w = W[(size_t)k * 6144]; a0 += sm[k] * w; a1 += sm[2048 + k] * w; a2 += sm[4096 + k] * w; a3 += sm[6144 + k] * w; a4 += sm[8192 + k] * w; }
        const float bb = p.b_ada[l * 6144 + n];
        MOD[(l * 5 + 0) * 6144 + n] = a0 + bb; MOD[(l * 5 + 1) * 6144 + n] = a1 + bb; MOD[(l * 5 + 2) * 6144 + n] = a2 + bb;
        MOD[(l * 5 + 3) * 6144 + n] = a3 + bb; MOD[(l * 5 + 4) * 6144 + n] = a4 + bb;
    }
    __syncthreads();
}

__device__ void ph_filter(const Params& p, int l, int bid, int nb, float* sm) {
    float* feats = sm; float* h1 = sm + 64; float* h2 = sm + 128;
    const int tid = threadIdx.x;
    const float DA = -3.0701134573253944f, DB = -15.350567286626973f;
    for (int u = bid; u < SEQ + CTXL; u += nb) {
        const int Lidx = u < SEQ ? 0 : 1, L = Lidx ? CTXL : SEQ, pos = Lidx ? u - SEQ : u;
        const float t = (float)pos / (float)(L - 1), wpos = (6.283185307179586f / (float)L) * (float)pos;
        if (tid < 33) {
            float f;
            if (tid == 0) f = t;
            else { const int i = (tid - 1) & 15; const float band = 1e-4f + (float)i * ((15.f - 1e-4f) / 15.f); const float a = band * wpos; f = (tid <= 16) ? fcos(a) : -fsin(a); }
            feats[tid] = f;
        }
        __syncthreads();
        if (tid < 64) { float s = p.hf_b1[l * 64 + tid];
_Pragma("unroll 4")
            for (int e = 0; e < 33; ++e) s += feats[e] * p.hf_w1[(l * 33 + e) * 64 + tid]; h1[tid] = fsin(p.hf_freq[l * 64 + tid] * s); }
        __syncthreads();
        if (tid < 64) { float s = p.hf_b2[l * 64 + tid];
_Pragma("unroll 4")
            for (int i = 0; i < 64; ++i) s += h1[i] * p.hf_w2[(l * 64 + i) * 64 + tid]; h2[tid] = fsin(p.hf_freq[l * 64 + tid] * s); }
        __syncthreads();
        float* F = Lidx ? WSP(float, WS_FC) : WSP(float, WS_FL);
        for (int n = tid; n < 2048; n += NT) {
            float s = 0;
_Pragma("unroll 8")
            for (int j = 0; j < 64; ++j) s += h2[j] * p.hf_w3[((size_t)l * 64 + j) * 2048 + n];
            const int o = n >> 10, d = (n >> 9) & 1, c = n & 511;
            const float delta = fabsf(DA + (float)c * ((DB - DA) / 511.f));
            s *= expf(-t * delta);
            F[(((size_t)o * 2 + d) * L + pos) * 512 + c] = s;
        }
        __syncthreads();
    }
}
__device__ void ph_fscale(const Params& p, int bid, int nb) {
    float* FS = WSP(float, WS_FSCL);
    for (int idx = bid * NT + threadIdx.x; idx < 2048; idx += nb * NT) {
        const int Lidx = idx >> 10, o = (idx >> 9) & 1, c = idx & 511, L = Lidx ? CTXL : SEQ;
        const float* F = Lidx ? WSP(float, WS_FC) : WSP(float, WS_FL);
        float s = 0;
        for (int pos = 0; pos < L; ++pos) {
            const float a = F[(((size_t)o * 2 + 0) * L + pos) * 512 + c]; s += a * a;
            if (pos >= 1) { const float b2 = F[(((size_t)o * 2 + 1) * L + pos) * 512 + c]; s += b2 * b2; }
        }
        FS[idx] = rsqrtf(s + EPS);
    }
}

__device__ void ph_norm(const Params& p, int l, int bid, int nb) {
    const int lane = threadIdx.x & 63, wid = threadIdx.x >> 6, nw = NT >> 6;
    const float* MOD = WSP(float, WS_MOD); act_t* HA = WSP(act_t, WS_HA);
    for (int row = bid * nw + wid; row < ROWS; row += nb * nw) {
        const RowInfo r = rowinfo(row);
        const float* xr = xin_row(p, l, row);
        float ss = 0;
#pragma unroll 2
        for (int j = 0; j < 8; ++j) { const float4 v = *(const float4*)(xr + (j * 64 + lane) * 4); ss += v.x * v.x + v.y * v.y + v.z * v.z + v.w * v.w; }
        ss = wave_sum(ss);
        const float rstd = rsqrtf(ss * (1.f / DM) + EPS);
        const float* g = p.norm_g + l * DM; const float* sh = MOD + (size_t)(l * 5 + r.mr) * 6144; const float* sc = sh + 2048;
#pragma unroll 1
        for (int j = 0; j < 8; ++j) {
            const int k = (j * 64 + lane) * 4;
            const float4 v = *(const float4*)(xr + k);
            const float e[4] = {v.x, v.y, v.z, v.w};
#pragma unroll
            for (int q = 0; q < 4; ++q) stf(HA + (size_t)row * DM + k + q, e[q] * rstd * g[k + q] * (1.f + sc[k + q]) + sh[k + q]);
        }
    }
}

template <int EPI>
__device__ void gemm_naive(const Params& p, int l, const act_t* A, int lda, const float* B, int ldb, act_t* C, int ldc, int M, int N, int K, int bid, int nb, float* sm) {
    float* As = sm; float* Bs = sm + 16 * 132;
    const int tid = threadIdx.x, tx = tid & 15, ty = tid >> 4;
    const int tilesN = N / 64, tiles = (M / 128) * tilesN;
    for (int tile = bid; tile < tiles; tile += nb) {
        const int m0 = (tile / tilesN) * 128, n0 = (tile % tilesN) * 64;
        float acc[4][4];
#pragma unroll
        for (int i = 0; i < 4; ++i)
#pragma unroll
            for (int j = 0; j < 4; ++j) acc[i][j] = 0.f;
        for (int k0 = 0; k0 < K; k0 += 16) {
            { const int r = tid >> 2, kq = (tid & 3) * 4; const act_t* ap = A + (size_t)(m0 + r) * lda + k0 + kq;
              As[(kq + 0) * 132 + r] = ldf(ap); As[(kq + 1) * 132 + r] = ldf(ap + 1); As[(kq + 2) * 132 + r] = ldf(ap + 2); As[(kq + 3) * 132 + r] = ldf(ap + 3); }
            { const int kk = tid >> 5, nn = (tid & 31) * 2; const float* bp = B + (size_t)(k0 + kk) * ldb + n0 + nn; Bs[kk * 64 + nn] = bp[0]; Bs[kk * 64 + nn + 1] = bp[1]; }
            __syncthreads();
#pragma unroll
            for (int kk = 0; kk < 16; ++kk) {
                const float4 a = *(const float4*)&As[kk * 132 + ty * 4]; const float4 b = *(const float4*)&Bs[kk * 64 + tx * 4];
                const float av[4] = {a.x, a.y, a.z, a.w}, bv[4] = {b.x, b.y, b.z, b.w};
#pragma unroll
                for (int i = 0; i < 4; ++i)
#pragma unroll
                    for (int j = 0; j < 4; ++j) acc[i][j] += av[i] * bv[j];
            }
            __syncthreads();
        }
#pragma unroll
        for (int i = 0; i < 4; ++i) {
            const int m = m0 + ty * 4 + i;
            if (EPI == 0) {
#pragma unroll
                for (int j = 0; j < 4; ++j) stf(C + (size_t)m * ldc + n0 + tx * 4 + j, acc[i][j]);
            } else {
                const RowInfo r = rowinfo(m);
                const float* xr = xin_row(p, l, m);
                const float* gate = WSP(float, WS_MOD) + (size_t)(l * 5 + r.mr) * 6144 + 4096;
                float* XW = WSP(float, WS_XW) + (size_t)m * DM;
#pragma unroll
                for (int j = 0; j < 4; ++j) { const int n = n0 + tx * 4 + j; XW[n] = xr[n] + gate[n] * acc[i][j]; }
            }
        }
    }
}

__device__ void ph_rms_small(const Params& p, int l, int bid, int nb) {
    const int lane = threadIdx.x & 63, wid = threadIdx.x >> 6, nw = NT >> 6;
    const act_t* U = WSP(act_t, WS_U); act_t* QN = WSP(act_t, WS_QN); act_t* KVN = WSP(act_t, WS_KVN);
    for (int row = bid * nw + wid; row < ROWS; row += nb * nw) {
        const act_t* ur = U + (size_t)row * NIN;
        float q[8]; float ss = 0;
#pragma unroll
        for (int j = 0; j < 8; ++j) { q[j] = ldf(ur + OFF_Q + j * 64 + lane); ss += q[j] * q[j]; }
        ss = wave_sum(ss); float rstd = rsqrtf(ss * (1.f / QRANK) + EPS);
#pragma unroll
        for (int j = 0; j < 8; ++j) stf(QN + (size_t)row * 512 + j * 64 + lane, q[j] * rstd * p.q_norm_g[l * 512 + j * 64 + lane]);
        float kv[4]; ss = 0;
#pragma unroll
        for (int j = 0; j < 4; ++j) { kv[j] = ldf(ur + OFF_KV + j * 64 + lane); ss += kv[j] * kv[j]; }
        ss = wave_sum(ss); rstd = rsqrtf(ss * (1.f / KVRANK) + EPS);
#pragma unroll
        for (int j = 0; j < 4; ++j) stf(KVN + (size_t)row * 256 + j * 64 + lane, kv[j] * rstd * p.kv_norm_g[l * 256 + j * 64 + lane]);
    }
}
__device__ void ph_shortconv(const Params& p, int l, int bid, int nb) {
    const act_t* U = WSP(act_t, WS_U); act_t* HC = WSP(act_t, WS_HC);
    const float* w = p.hy_conv_w + (size_t)l * 3 * 1536; const float* bb = p.hy_conv_b + l * 1536;
    for (size_t idx = (size_t)bid * NT + threadIdx.x; idx < (size_t)ROWS * 1536; idx += (size_t)nb * NT) {
        const int row = (int)(idx / 1536), c = (int)(idx % 1536);
        const RowInfo r = rowinfo(row);
        const float cur = ldf(U + (size_t)row * NIN + c);
        const float prev = r.t > 0 ? ldf(U + (size_t)(row - 1) * NIN + c) : 0.f;
        const float next = r.t < r.L - 1 ? ldf(U + (size_t)(row + 1) * NIN + c) : 0.f;
        stf(HC + (size_t)row * 1536 + c, prev * w[c] + cur * w[1536 + c] + next * w[3072 + c] + bb[c]);
    }
}
__device__ void ph_pooldiff(const Params& p, int bid, int nb) {
    const act_t* U = WSP(act_t, WS_U); act_t* PD = WSP(act_t, WS_PD);
    for (size_t idx = (size_t)bid * NT + threadIdx.x; idx < (size_t)ROWS * 512; idx += (size_t)nb * NT) {
        const int row = (int)(idx >> 9), j = (int)(idx & 511);
        const RowInfo r = rowinfo(row);
        const int half = 1 << (j >> 7);
        const int lo = max(r.t - half, 0), hi = min(r.t + half, r.L);
        float s = 0;
        for (int q = lo; q < hi; ++q) s += ldf(U + (size_t)(row - r.t + q) * NIN + OFF_POOL + j);
        stf(PD + idx, s / (float)(hi - lo) - ldf(U + (size_t)row * NIN + OFF_POOL + j));
    }
}
__device__ void ph_poolgate(const Params& p, int l, int bid, int nb) {
    const act_t* U = WSP(act_t, WS_U); const act_t* PY = WSP(act_t, WS_PY); act_t* MIX = WSP(act_t, WS_MIX);
    for (size_t idx = (size_t)bid * NT + threadIdx.x; idx < (size_t)ROWS * 512; idx += (size_t)nb * NT) {
        const int row = (int)(idx >> 9), j = (int)(idx & 511);
        stf(MIX + (size_t)row * DM + 1536 + j, ldf(PY + idx) * p.pool_scale[l * 512 + j] * silu_f(ldf(U + (size_t)row * NIN + OFF_POOL_G + j)));
    }
}
__device__ void ph_pack_qkv(const Params& p, int bid, int nb) {
    const act_t* U = WSP(act_t, WS_U); const act_t* QR = WSP(act_t, WS_QRAW); const act_t* KVR = WSP(act_t, WS_KVRAW);
    act_t* Q = WSP(act_t, WS_Q); act_t* KB = WSP(act_t, WS_KB); act_t* VB = WSP(act_t, WS_VB);
    for (size_t idx = (size_t)bid * NT + threadIdx.x; idx < (size_t)ROWS * NH * 128; idx += (size_t)nb * NT) {
        const int d = (int)(idx & 127), h = (int)((idx >> 7) & 7), row = (int)(idx >> 10);
        const RowInfo r = rowinfo(row);
        const size_t pos = (size_t)(r.b * NH + h) * LK + r.n;
        stf(Q + pos * 192 + d, ldf(QR + (size_t)row * 1536 + h * 192 + d));
        stf(KB + pos * 192 + d, ldf(KVR + (size_t)row * 2048 + h * 256 + d));
        stf(VB + pos * 128 + d, ldf(KVR + (size_t)row * 2048 + h * 256 + 128 + d));
    }
    for (size_t idx = (size_t)bid * NT + threadIdx.x; idx < (size_t)ROWS * NH * 32; idx += (size_t)nb * NT) {
        const int i = (int)(idx & 31), h = (int)((idx >> 5) & 7), row = (int)(idx >> 8);
        const RowInfo r = rowinfo(row);
        const size_t pos = (size_t)(r.b * NH + h) * LK + r.n;
        float cs = 1.f, sn = 0.f;
        if (row < ROWS_L) {
            const float inv = expf(-(float)(i & 15) * (9.210340371976184f / 16.f));
            const float ang = (float)(i < 16 ? (r.t >> 6) : (r.t & 63)) * inv;
            cs = fcos(ang); sn = fsin(ang);
        }
        const float q0 = ldf(QR + (size_t)row * 1536 + h * 192 + 128 + 2 * i), q1 = ldf(QR + (size_t)row * 1536 + h * 192 + 128 + 2 * i + 1);
        stf(Q + pos * 192 + 128 + 2 * i, q0 * cs - q1 * sn); stf(Q + pos * 192 + 128 + 2 * i + 1, q0 * sn + q1 * cs);
        const float k0 = ldf(U + (size_t)row * NIN + OFF_KR + 2 * i), k1 = ldf(U + (size_t)row * NIN + OFF_KR + 2 * i + 1);
        stf(KB + pos * 192 + 128 + 2 * i, k0 * cs - k1 * sn); stf(KB + pos * 192 + 128 + 2 * i + 1, k0 * sn + k1 * cs);
    }
}

__device__ void ph_attn(const Params& p, int l, int bid, int nb, float* sm) {
    float* S = sm; float* qs = sm + 8 * LK; float* linv = qs + 8 * 192;
    const int tid = threadIdx.x, lane = tid & 63, wid = tid >> 6;
    const act_t* Q = WSP(act_t, WS_Q); const act_t* KB = WSP(act_t, WS_KB); const act_t* VB = WSP(act_t, WS_VB); const act_t* U = WSP(act_t, WS_U); act_t* MIX = WSP(act_t, WS_MIX);
    const int nlat = NB * NH * (SEQ / 8), nctx = (l < DEPTH - 1) ? NB * NH * (CTXL / 8) : 0;
    for (int u = bid; u < nlat + nctx; u += nb) {
        int b, h, q0, k0, nk;
        if (u < nlat) { b = u >> 11; h = (u >> 8) & 7; q0 = (u & 255) * 8; k0 = 0; nk = LK; }
        else { const int v = u - nlat; b = v >> 8; h = (v >> 5) & 7; q0 = SEQ + (v & 31) * 8; k0 = SEQ; nk = CTXL; }
        const size_t hb = (size_t)(b * NH + h) * LK;
        const act_t* Qp = Q + (hb + q0) * 192; const act_t* Kp = KB + (hb + k0) * 192; const act_t* Vp = VB + (hb + k0) * 128;
        for (int i = tid; i < 8 * 192; i += NT) qs[i] = ldf(Qp + i);
        __syncthreads();
        for (int kk = tid; kk < nk; kk += NT) {
            float acc[8];
#pragma unroll
            for (int i = 0; i < 8; ++i) acc[i] = 0.f;
            const act_t* kr = Kp + (size_t)kk * 192;
            for (int d = 0; d < 192; ++d) { const float kv = ldf(kr + d);
#pragma unroll
                for (int i = 0; i < 8; ++i) acc[i] += kv * qs[i * 192 + d]; }
#pragma unroll
            for (int i = 0; i < 8; ++i) S[i * LK + kk] = acc[i] * ATTN_SCALE;
        }
        __syncthreads();
        { float* row = S + wid * LK; float m = -INFINITY;
          for (int kk = lane; kk < nk; kk += 64) m = fmaxf(m, row[kk]);
          m = wave_max(m); float s = 0;
          for (int kk = lane; kk < nk; kk += 64) { const float e = expf(row[kk] - m); row[kk] = e; s += e; }
          s = wave_sum(s); if (lane == 0) linv[wid] = 1.f / s; }
        __syncthreads();
        { const int d = tid & 127, qg = tid >> 7; float o0 = 0, o1 = 0; const float* s0 = S + (2 * qg) * LK; const float* s1 = s0 + LK;
          for (int kk = 0; kk < nk; ++kk) { const float v = ldf(Vp + (size_t)kk * 128 + d); o0 += s0[kk] * v; o1 += s1[kk] * v; }
#pragma unroll
          for (int e = 0; e < 2; ++e) { const int qi = 2 * qg + e, n = q0 + qi; const int row = n < SEQ ? b * SEQ + n : ROWS_L + b * CTXL + (n - SEQ);
              const float g = ldf(U + (size_t)row * NIN + OFF_MLA_G + h * 128 + d);
              stf(MIX + (size_t)row * DM + 512 + h * 128 + d, (e ? o1 : o0) * linv[qi] * silu_f(g)); } }
        __syncthreads();
    }
}

__device__ void ph_conv(const Params& p, int l, int order, int bid, int nb, float* sm) {
    float* Zs = sm; float* Ks = sm + 4096;
    const int tid = threadIdx.x, c = tid & 63, tg = tid >> 6;
    const act_t* U = WSP(act_t, WS_U); const act_t* HC = WSP(act_t, WS_HC); act_t* Z2 = WSP(act_t, WS_Z2); act_t* MIX = WSP(act_t, WS_MIX);
    const act_t* zsrc = order == 0 ? HC : Z2; const int zld = order == 0 ? 1536 : 512;
    const int nlat = NB * (SEQ / 64) * 8, nctx = (l < DEPTH - 1) ? NB * (CTXL / 64) * 8 : 0;
    for (int u = bid; u < nlat + nctx; u += nb) {
        int Lidx, b, T0, c0, L, rowbase;
        if (u < nlat) { Lidx = 0; L = SEQ; b = u >> 8; T0 = ((u >> 3) & 31) * 64; c0 = (u & 7) * 64; rowbase = b * SEQ; }
        else { const int v = u - nlat; Lidx = 1; L = CTXL; b = v >> 5; T0 = ((v >> 3) & 3) * 64; c0 = (v & 7) * 64; rowbase = ROWS_L + b * CTXL; }
        const float* F = (Lidx ? WSP(float, WS_FC) : WSP(float, WS_FL)) + (size_t)order * 2 * L * 512;
        float acc[8];
#pragma unroll
        for (int i = 0; i < 8; ++i) acc[i] = 0.f;
        for (int S0 = 0; S0 < L; S0 += 64) {
            for (int i = tid; i < 4096; i += NT) { const int ss = i >> 6, cc = i & 63; Zs[i] = ldf(zsrc + (size_t)(rowbase + S0 + ss) * zld + c0 + cc); }
            for (int i = tid; i < 127 * 64; i += NT) { const int j = i >> 6, cc = i & 63; const int n = T0 - S0 + j - 63;
                Ks[i] = n >= 0 ? F[((size_t)0 * L + n) * 512 + c0 + cc] : F[((size_t)1 * L + (-n)) * 512 + c0 + cc]; }
            __syncthreads();
            for (int ss = 0; ss < 64; ++ss) { const float z = Zs[ss * 64 + c];
#pragma unroll
                for (int i = 0; i < 8; ++i) acc[i] += z * Ks[(tg * 8 + i - ss + 63) * 64 + c]; }
            __syncthreads();
        }
        const float scl = WSP(float, WS_FSCL)[(Lidx * 2 + order) * 512 + c0 + c], bias = p.hy_bias[(l * 2 + order) * 512 + c0 + c];
#pragma unroll
        for (int i = 0; i < 8; ++i) {
            const int row = rowbase + T0 + tg * 8 + i;
            const float zt = ldf(zsrc + (size_t)row * zld + c0 + c);
            const float y = scl * acc[i] + bias * zt;
            if (order == 0) stf(Z2 + (size_t)row * 512 + c0 + c, ldf(HC + (size_t)row * 1536 + 512 + c0 + c) * y);
            else stf(MIX + (size_t)row * DM + c0 + c, ldf(HC + (size_t)row * 1536 + 1024 + c0 + c) * y * silu_f(ldf(U + (size_t)row * NIN + OFF_HY_G + c0 + c)));
        }
    }
}

__device__ void ph_final(const Params& p, int bid, int nb) {
    const int lane = threadIdx.x & 63, wid = threadIdx.x >> 6, nw = NT >> 6;
    for (int row = bid * nw + wid; row < ROWS_L; row += nb * nw) {
        const float* xr = WSP(float, WS_XW) + (size_t)row * DM;
        float ss = 0;
#pragma unroll 2
        for (int j = 0; j < 8; ++j) { const float4 v = *(const float4*)(xr + (j * 64 + lane) * 4); ss += v.x * v.x + v.y * v.y + v.z * v.z + v.w * v.w; }
        ss = wave_sum(ss);
        const float rstd = rsqrtf(ss * (1.f / DM) + EPS);
#pragma unroll 1
        for (int j = 0; j < 8; ++j) { const int k = (j * 64 + lane) * 4; const float4 v = *(const float4*)(xr + k); const float4 g = *(const float4*)(p.final_norm_g + k);
            *(float4*)(p.out + (size_t)row * DM + k) = make_float4(v.x * rstd * g.x, v.y * rstd * g.y, v.z * rstd * g.z, v.w * rstd * g.w); }
    }
}

enum { PH_ADALN = 0, PH_1, PH_2, PH_3, PH_4, PH_5, PH_6, PH_7, PH_FINAL };
__device__ __forceinline__ void run_phase(const Params& p, int ph, int l, int bid, int nb, float* sm) {
    switch (ph) {
    case PH_ADALN: ph_adaln(p, bid, nb, sm); break;
    case PH_1: ph_filter(p, l, bid, nb, sm); ph_norm(p, l, bid, nb); break;
    case PH_2: ph_fscale(p, bid, nb);
        gemm_naive<0>(p, l, WSP(act_t, WS_HA), DM, p.w_in + (size_t)l * DM * NIN, NIN, WSP(act_t, WS_U), NIN, ROWS, NIN, DM, bid, nb, sm); break;
    case PH_3: ph_rms_small(p, l, bid, nb); ph_shortconv(p, l, bid, nb); ph_pooldiff(p, bid, nb); break;
    case PH_4:
        gemm_naive<0>(p, l, WSP(act_t, WS_QN), 512, p.w_uq + (size_t)l * 512 * 1536, 1536, WSP(act_t, WS_QRAW), 1536, ROWS, 1536, 512, bid, nb, sm);
        gemm_naive<0>(p, l, WSP(act_t, WS_KVN), 256, p.w_ukv + (size_t)l * 256 * 2048, 2048, WSP(act_t, WS_KVRAW), 2048, ROWS, 2048, 256, bid, nb, sm);
        for (int g = 0; g < 4; ++g)
            gemm_naive<0>(p, l, WSP(act_t, WS_PD) + g * 128, 512, p.w_pool + (size_t)(l * 4 + g) * 128 * 128, 128, WSP(act_t, WS_PY) + g * 128, 512, ROWS, 128, 128, bid, nb, sm);
        ph_conv(p, l, 0, bid, nb, sm); break;
    case PH_5: ph_pack_qkv(p, bid, nb); ph_conv(p, l, 1, bid, nb, sm); ph_poolgate(p, l, bid, nb); break;
    case PH_6: ph_attn(p, l, bid, nb, sm); break;
    case PH_7: gemm_naive<1>(p, l, WSP(act_t, WS_MIX), DM, p.w_out + (size_t)l * DM * DM, DM, nullptr, 0, l == DEPTH - 1 ? ROWS_L : ROWS, DM, DM, bid, nb, sm); break;
    case PH_FINAL: ph_final(p, bid, nb); break;
    }
}

#if ONE_LAUNCH
__global__ void __launch_bounds__(NT) mega_fwd(Params p) {
    extern __shared__ __attribute__((aligned(16))) unsigned char lds[];
    cg::grid_group grid = cg::this_grid();
    float* sm = (float*)lds; const int bid = blockIdx.x, nb = gridDim.x;
    run_phase(p, PH_ADALN, 0, bid, nb, sm);
#pragma unroll 1
    for (int it = 0; it < DEPTH * 7 + 1; ++it) {
        grid.sync();
        const int l = it / 7, ph = it == DEPTH * 7 ? (int)PH_FINAL : PH_1 + it % 7;
        run_phase(p, ph, l, bid, nb, sm);
    }
}
#else
__global__ void __launch_bounds__(NT) k_phase(Params p, int ph, int l) {
    extern __shared__ __attribute__((aligned(16))) unsigned char lds[];
    run_phase(p, ph, l, blockIdx.x, gridDim.x, (float*)lds);
}
#endif

extern "C" void kernel_launch(void* const* d_in, const int* in_sizes, int n_in, void* d_out, int out_size, void* d_ws, size_t ws_size, hipStream_t stream) {
    if (n_in != 25 || ws_size < WS_END) { fprintf(stderr, "kernel_launch: bad inputs (n_in %d, ws %zu < %zu)\n", n_in, ws_size, (size_t)WS_END); return; }
    Params p{};
    const float** pp = (const float**)&p;
    for (int i = 0; i < 25; ++i) pp[i] = (const float*)d_in[i];
    p.out = (float*)d_out; p.ws = (unsigned char*)d_ws;
#if ONE_LAUNCH
    static int grid = 0;
    if (!grid) {
        int dev = 0, cus = 0, per_cu = 0;
        hipGetDevice(&dev); hipDeviceGetAttribute(&cus, hipDeviceAttributeMultiprocessorCount, dev);
        hipFuncSetAttribute((const void*)mega_fwd, hipFuncAttributeMaxDynamicSharedMemorySize, LDS_BYTES);
        hipOccupancyMaxActiveBlocksPerMultiprocessor(&per_cu, (const void*)mega_fwd, NT, LDS_BYTES);
        if (per_cu < 1) per_cu = 1;
        grid = cus * 1;
    }
    void* args[] = {&p};
    hipError_t e = hipLaunchCooperativeKernel((const void*)mega_fwd, dim3(grid), dim3(NT), args, LDS_BYTES, stream);
    if (e != hipSuccess) fprintf(stderr, "cooperative launch failed: %s (grid %d)\n", hipGetErrorString(e), grid);
#else
    static int init = 0;
    if (!init) { hipFuncSetAttribute((const void*)k_phase, hipFuncAttributeMaxDynamicSharedMemorySize, LDS_BYTES); init = 1; }
    const int G = 1024;
    k_phase<<<G, NT, LDS_BYTES, stream>>>(p, PH_ADALN, 0);
    for (int l = 0; l < DEPTH; ++l)
        for (int ph = PH_1; ph <= PH_7; ++ph) k_phase<<<G, NT, LDS_BYTES, stream>>>(p, ph, l);
    k_phase<<<G, NT, LDS_BYTES, stream>>>(p, PH_FINAL, 0);
#endif
}
```

```cpp
#include <hip/hip_runtime.h>
#include <hip/hip_cooperative_groups.h>
#include <cstdio>
#include <cstdint>
namespace cg = cooperative_groups;

#ifndef ONE_LAUNCH
#define ONE_LAUNCH 1
#endif

constexpr int DM = 2048, NB = 4, SEQ = 2048, DEPTH = 4, CTXL = 256;
constexpr int HYW = 512, NH = 8, QRANK = 512, KVRANK = 256, POOLW = 512;
constexpr int OFF_HY_G = 1536, OFF_Q = 2048, OFF_KV = 2560, OFF_KR = 2816, OFF_MLA_G = 2880, OFF_POOL = 3904, OFF_POOL_G = 4416, NIN = 4928;
constexpr int ROWS_L = NB * SEQ, ROWS_C = NB * CTXL, ROWS = ROWS_L + ROWS_C;
constexpr int LK = SEQ + CTXL;
constexpr float EPS = 1e-6f;
constexpr float ATTN_SCALE = 0.07216878364870322f;
constexpr int NT = 512;
constexpr int NINP = 5120;

typedef unsigned short bf16_t;
typedef bf16_t act_t;

struct Params {
    const float *x, *c, *ctx, *c_ctx, *norm_g, *w_ada, *b_ada, *w_in, *hy_conv_w, *hy_conv_b, *hf_w1, *hf_b1, *hf_freq, *hf_w2, *hf_b2, *hf_w3, *hy_bias,
        *q_norm_g, *w_uq, *kv_norm_g, *w_ukv, *w_pool, *pool_scale, *w_out, *final_norm_g;
    float* out; unsigned char* ws;
};

constexpr size_t al256(size_t x) { return (x + 255) / 256 * 256; }
constexpr size_t WS_MOD = 0;
constexpr size_t WS_FSCL = WS_MOD + al256((size_t)4 * 5 * 6144 * 4);
constexpr size_t WS_FL = WS_FSCL + al256((size_t)2 * 2 * 512 * 4);
constexpr size_t WS_FC = WS_FL + al256((size_t)2 * 2 * 2048 * 512 * 4);
constexpr size_t WS_HA = WS_FC + al256((size_t)2 * 2 * 256 * 512 * 4);
constexpr size_t WS_KVRAW = WS_HA;
constexpr size_t WS_U = WS_HA + al256((size_t)ROWS * 2048 * sizeof(act_t));
constexpr size_t WS_QN = WS_U + al256((size_t)ROWS * NIN * sizeof(act_t));
constexpr size_t WS_KVN = WS_QN + al256((size_t)ROWS * 512 * sizeof(act_t));
constexpr size_t WS_QRAW = WS_KVN + al256((size_t)ROWS * 256 * sizeof(act_t));
constexpr size_t WS_Q = WS_QRAW + al256((size_t)ROWS * 1536 * sizeof(act_t));
constexpr size_t WS_KB = WS_Q + al256((size_t)NB * NH * LK * 192 * sizeof(act_t));
constexpr size_t WS_VB = WS_KB + al256((size_t)NB * NH * LK * 192 * sizeof(act_t));
constexpr size_t WS_HC = WS_VB + al256((size_t)NB * NH * LK * 128 * sizeof(act_t));
constexpr size_t WS_Z2 = WS_HC + al256((size_t)ROWS * 1536 * sizeof(act_t));
constexpr size_t WS_PD = WS_Z2 + al256((size_t)ROWS * 512 * sizeof(act_t));
constexpr size_t WS_PY = WS_PD + al256((size_t)ROWS * 512 * sizeof(act_t));
constexpr size_t WS_MIX = WS_PY + al256((size_t)ROWS * 512 * sizeof(act_t));
constexpr size_t WS_XW = WS_MIX + al256((size_t)ROWS * 2048 * sizeof(act_t));
constexpr size_t WS_WINT = WS_XW + al256((size_t)ROWS * 2048 * 4);
constexpr size_t WS_WOUTT = WS_WINT + al256((size_t)DEPTH * NINP * DM * 2);
constexpr size_t WS_WUQT = WS_WOUTT + al256((size_t)DEPTH * DM * DM * 2);
constexpr size_t WS_WUKVT = WS_WUQT + al256((size_t)DEPTH * 1536 * 512 * 2);
constexpr size_t WS_WPBD = WS_WUKVT + al256((size_t)DEPTH * 2048 * 256 * 2);
constexpr size_t WS_END = WS_WPBD + al256((size_t)DEPTH * 512 * 512 * 2);

constexpr int LDS_BYTES = 147456;

__device__ __forceinline__ float ldf(const float* p) { return *p; }
__device__ __forceinline__ void stf(float* p, float v) { *p = v; }
__device__ __forceinline__ float bf2f(bf16_t v) { return __uint_as_float((unsigned)v << 16); }
__device__ __forceinline__ bf16_t f2bf(float f) { const unsigned u = __float_as_uint(f); return (bf16_t)((u + 0x7fffu + ((u >> 16) & 1u)) >> 16); }
__device__ __forceinline__ float ldf(const bf16_t* p) { return bf2f(*p); }
__device__ __forceinline__ void stf(bf16_t* p, float v) { *p = f2bf(v); }
__device__ __forceinline__ float fsin(float x) { return __builtin_amdgcn_sinf(x * 0.15915494309189535f); }
__device__ __forceinline__ float fcos(float x) { return __builtin_amdgcn_cosf(x * 0.15915494309189535f); }
__device__ __forceinline__ float silu_f(float x) { return x / (1.f + expf(-x)); }
__device__ __forceinline__ float wave_sum(float v) {
#pragma unroll
    for (int o = 32; o > 0; o >>= 1) v += __shfl_xor(v, o);
    return v;
}
__device__ __forceinline__ float wave_max(float v) {
#pragma unroll
    for (int o = 32; o > 0; o >>= 1) v = fmaxf(v, __shfl_xor(v, o));
    return v;
}
struct RowInfo { int b, t, L, n, mr; };
__device__ __forceinline__ RowInfo rowinfo(int row) {
    RowInfo r;
    if (row < ROWS_L) { r.b = row >> 11; r.t = row & 2047; r.L = SEQ; r.n = r.t; r.mr = r.b; }
    else { const int q = row - ROWS_L; r.b = q >> 8; r.t = q & 255; r.L = CTXL; r.n = SEQ + r.t; r.mr = 4; }
    return r;
}
__device__ __forceinline__ const float* xin_row(const Params& p, int l, int row) {
    if (l == 0) return row < ROWS_L ? p.x + (size_t)row * DM : p.ctx + (size_t)(row - ROWS_L) * DM;
    return (const float*)(p.ws + WS_XW) + (size_t)row * DM;
}
#define WSP(T, off) ((T*)(p.ws + (off)))
__device__ __forceinline__ int otid() { int t = threadIdx.x; asm volatile("" : "+v"(t)); return t; }

__device__ void ph_adaln(const Params& p, int bid, int nb, float* sm) {
    const int TX = otid();
    for (int i = TX; i < 5 * DM; i += NT) { const int r = i >> 11, k = i & 2047; sm[i] = silu_f(r < 4 ? p.c[r * DM + k] : p.c_ctx[k]); }
    __syncthreads();
    float* MOD = WSP(float, WS_MOD);
    for (int idx = bid * NT + TX; idx < DEPTH * 6144; idx += nb * NT) {
        const int l = idx / 6144, n = idx % 6144;
        const float* W = p.w_ada + (size_t)l * DM * 6144 + n;
        float a0 = 0, a1 = 0, a2 = 0, a3 = 0, a4 = 0;
        for (int k = 0; k < DM; ++k) { const float w = W[(size_t)k * 6144]; a0 += sm[k] * w; a1 += sm[2048 + k] * w; a2 += sm[4096 + k] * w; a3 += sm[6144 + k] * w; a4 += sm[8192 + k] * w; }
        const float bb = p.b_ada[l * 6144 + n];
        MOD[(l * 5 + 0) * 6144 + n] = a0 + bb; MOD[(l * 5 + 1) * 6144 + n] = a1 + bb; MOD[(l * 5 + 2) * 6144 + n] = a2 + bb;
        MOD[(l * 5 + 3) * 6144 + n] = a3 + bb; MOD[(l * 5 + 4) * 6144 + n] = a4 + bb;
    }
    __syncthreads();
}

__device__ void ph_filter(const Params& p, int l, int bid, int nb, float* sm) {
    const int TX = otid();
    float* feats = sm; float* h1 = sm + 64; float* h2 = sm + 128;
    const int tid = TX;
    const float DA = -3.0701134573253944f, DB = -15.350567286626973f;
    for (int u = bid; u < SEQ + CTXL; u += nb) {
        const int Lidx = u < SEQ ? 0 : 1, L = Lidx ? CTXL : SEQ, pos = Lidx ? u - SEQ : u;
        const float t = (float)pos / (float)(L - 1), wpos = (6.283185307179586f / (float)L) * (float)pos;
        if (tid < 33) {
            float f;
            if (tid == 0) f = t;
            else { const int i = (tid - 1) & 15; const float band = 1e-4f + (float)i * ((15.f - 1e-4f) / 15.f); const float a = band * wpos; f = (tid <= 16) ? fcos(a) : -fsin(a); }
            feats[tid] = f;
        }
        __syncthreads();
        if (tid < 64) { float s = p.hf_b1[l * 64 + tid];
_Pragma("unroll 4")
            for (int e = 0; e < 33; ++e) s += feats[e] * p.hf_w1[(l * 33 + e) * 64 + tid]; h1[tid] = fsin(p.hf_freq[l * 64 + tid] * s); }
        __syncthreads();
        if (tid < 64) { float s = p.hf_b2[l * 64 + tid];
_Pragma("unroll 4")
            for (int i = 0; i < 64; ++i) s += h1[i] * p.hf_w2[(l * 64 + i) * 64 + tid]; h2[tid] = fsin(p.hf_freq[l * 64 + tid] * s); }
        __syncthreads();
        float* F = Lidx ? WSP(float, WS_FC) : WSP(float, WS_FL);
        for (int n = tid; n < 2048; n += NT) {
            float s = 0;
_Pragma("unroll 8")
            for (int j = 0; j < 64; ++j) s += h2[j] * p.hf_w3[((size_t)l * 64 + j) * 2048 + n];
            const int o = n >> 10, d = (n >> 9) & 1, c = n & 511;
            const float delta = fabsf(DA + (float)c * ((DB - DA) / 511.f));
            s *= expf(-t * delta);
            F[(((size_t)o * 2 + d) * L + pos) * 512 + c] = s;
        }
        __syncthreads();
    }
}
__device__ void ph_fscale(const Params& p, int bid, int nb) {
    const int TX = otid();
    float* FS = WSP(float, WS_FSCL);
    for (int idx = bid * NT + TX; idx < 2048; idx += nb * NT) {
        const int Lidx = idx >> 10, o = (idx >> 9) & 1, c = idx & 511, L = Lidx ? CTXL : SEQ;
        const float* F = Lidx ? WSP(float, WS_FC) : WSP(float, WS_FL);
        float s = 0;
        for (int pos = 0; pos < L; ++pos) {
            const float a = F[(((size_t)o * 2 + 0) * L + pos) * 512 + c]; s += a * a;
            if (pos >= 1) { const float b2 = F[(((size_t)o * 2 + 1) * L + pos) * 512 + c]; s += b2 * b2; }
        }
        FS[idx] = rsqrtf(s + EPS);
    }
}

__device__ void ph_norm(const Params& p, int l, int bid, int nb) {
    const int TX = otid();
    const int lane = TX & 63, wid = TX >> 6, nw = NT >> 6;
    const float* MOD = WSP(float, WS_MOD); act_t* HA = WSP(act_t, WS_HA);
    for (int row = bid * nw + wid; row < ROWS; row += nb * nw) {
        const RowInfo r = rowinfo(row);
        const float* xr = xin_row(p, l, row);
        float ss = 0;
#pragma unroll 2
        for (int j = 0; j < 8; ++j) { const float4 v = *(const float4*)(xr + (j * 64 + lane) * 4); ss += v.x * v.x + v.y * v.y + v.z * v.z + v.w * v.w; }
        ss = wave_sum(ss);
        const float rstd = rsqrtf(ss * (1.f / DM) + EPS);
        const float* g = p.norm_g + l * DM; const float* sh = MOD + (size_t)(l * 5 + r.mr) * 6144; const float* sc = sh + 2048;
#pragma unroll 1
        for (int j = 0; j < 8; ++j) {
            const int k = (j * 64 + lane) * 4;
            const float4 v = *(const float4*)(xr + k);
            const float e[4] = {v.x, v.y, v.z, v.w};
#pragma unroll
            for (int q = 0; q < 4; ++q) stf(HA + (size_t)row * DM + k + q, e[q] * rstd * g[k + q] * (1.f + sc[k + q]) + sh[k + q]);
        }
    }
}

template <int EPI>
__device__ void gemm_naive(const Params& p, int l, const act_t* A, int lda, const float* B, int ldb, act_t* C, int ldc, int M, int N, int K, int bid, int nb, float* sm) {
    const int TX = otid();
    float* As = sm; float* Bs = sm + 16 * 132;
    const int tid = TX, tx = tid & 15, ty = tid >> 4;
    const int tilesN = N / 64, tiles = (M / 128) * tilesN;
    for (int tile = bid; tile < tiles; tile += nb) {
        const int m0 = (tile / tilesN) * 128, n0 = (tile % tilesN) * 64;
        float acc[4][4];
#pragma unroll
        for (int i = 0; i < 4; ++i)
#pragma unroll
            for (int j = 0; j < 4; ++j) acc[i][j] = 0.f;
        for (int k0 = 0; k0 < K; k0 += 16) {
            { const int r = tid >> 2, kq = (tid & 3) * 4; const act_t* ap = A + (size_t)(m0 + r) * lda + k0 + kq;
              As[(kq + 0) * 132 + r] = ldf(ap); As[(kq + 1) * 132 + r] = ldf(ap + 1); As[(kq + 2) * 132 + r] = ldf(ap + 2); As[(kq + 3) * 132 + r] = ldf(ap + 3); }
            { const int kk = tid >> 5, nn = (tid & 31) * 2; const float* bp = B + (size_t)(k0 + kk) * ldb + n0 + nn; Bs[kk * 64 + nn] = bp[0]; Bs[kk * 64 + nn + 1] = bp[1]; }
            __syncthreads();
#pragma unroll
            for (int kk = 0; kk < 16; ++kk) {
                const float4 a = *(const float4*)&As[kk * 132 + ty * 4]; const float4 b = *(const float4*)&Bs[kk * 64 + tx * 4];
                const float av[4] = {a.x, a.y, a.z, a.w}, bv[4] = {b.x, b.y, b.z, b.w};
#pragma unroll
                for (int i = 0; i < 4; ++i)
#pragma unroll
                    for (int j = 0; j < 4; ++j) acc[i][j] += av[i] * bv[j];
            }
            __syncthreads();
        }
#pragma unroll
        for (int i = 0; i < 4; ++i) {
            const int m = m0 + ty * 4 + i;
            if (EPI == 0) {
#pragma unroll
                for (int j = 0; j < 4; ++j) stf(C + (size_t)m * ldc + n0 + tx * 4 + j, acc[i][j]);
            } else {
                const RowInfo r = rowinfo(m);
                const float* xr = xin_row(p, l, m);
                const float* gate = WSP(float, WS_MOD) + (size_t)(l * 5 + r.mr) * 6144 + 4096;
                float* XW = WSP(float, WS_XW) + (size_t)m * DM;
#pragma unroll
                for (int j = 0; j < 4; ++j) { const int n = n0 + tx * 4 + j; XW[n] = xr[n] + gate[n] * acc[i][j]; }
            }
        }
    }
}

__device__ void ph_rms_small(const Params& p, int l, int bid, int nb) {
    const int TX = otid();
    const int lane = TX & 63, wid = TX >> 6, nw = NT >> 6;
    const act_t* U = WSP(act_t, WS_U); act_t* QN = WSP(act_t, WS_QN); act_t* KVN = WSP(act_t, WS_KVN);
    for (int row = bid * nw + wid; row < ROWS; row += nb * nw) {
        const act_t* ur = U + (size_t)row * NIN;
        float q[8]; float ss = 0;
#pragma unroll
        for (int j = 0; j < 8; ++j) { q[j] = ldf(ur + OFF_Q + j * 64 + lane); ss += q[j] * q[j]; }
        ss = wave_sum(ss); float rstd = rsqrtf(ss * (1.f / QRANK) + EPS);
#pragma unroll
        for (int j = 0; j < 8; ++j) stf(QN + (size_t)row * 512 + j * 64 + lane, q[j] * rstd * p.q_norm_g[l * 512 + j * 64 + lane]);
        float kv[4]; ss = 0;
#pragma unroll
        for (int j = 0; j < 4; ++j) { kv[j] = ldf(ur + OFF_KV + j * 64 + lane); ss += kv[j] * kv[j]; }
        ss = wave_sum(ss); rstd = rsqrtf(ss * (1.f / KVRANK) + EPS);
#pragma unroll
        for (int j = 0; j < 4; ++j) stf(KVN + (size_t)row * 256 + j * 64 + lane, kv[j] * rstd * p.kv_norm_g[l * 256 + j * 64 + lane]);
    }
}
__device__ void ph_shortconv(const Params& p, int l, int bid, int nb) {
    const int TX = otid();
    const act_t* U = WSP(act_t, WS_U); act_t* HC = WSP(act_t, WS_HC);
    const float* w = p.hy_conv_w + (size_t)l * 3 * 1536; const float* bb = p.hy_conv_b + l * 1536;
    for (size_t idx = (size_t)bid * NT + TX; idx < (size_t)ROWS * 1536; idx += (size_t)nb * NT) {
        const int row = (int)(idx / 1536), c = (int)(idx % 1536);
        const RowInfo r = rowinfo(row);
        const float cur = ldf(U + (size_t)row * NIN + c);
        const float prev = r.t > 0 ? ldf(U + (size_t)(row - 1) * NIN + c) : 0.f;
        const float next = r.t < r.L - 1 ? ldf(U + (size_t)(row + 1) * NIN + c) : 0.f;
        stf(HC + (size_t)row * 1536 + c, prev * w[c] + cur * w[1536 + c] + next * w[3072 + c] + bb[c]);
    }
}
__device__ void ph_pooldiff(const Params& p, int bid, int nb) {
    const int TX = otid();
    const act_t* U = WSP(act_t, WS_U); act_t* PD = WSP(act_t, WS_PD);
    for (size_t idx = (size_t)bid * NT + TX; idx < (size_t)ROWS * 512; idx += (size_t)nb * NT) {
        const int row = (int)(idx >> 9), j = (int)(idx & 511);
        const RowInfo r = rowinfo(row);
        const int half = 1 << (j >> 7);
        const int lo = max(r.t - half, 0), hi = min(r.t + half, r.L);
        float s = 0;
        for (int q = lo; q < hi; ++q) s += ldf(U + (size_t)(row - r.t + q) * NIN + OFF_POOL + j);
        stf(PD + idx, s / (float)(hi - lo) - ldf(U + (size_t)row * NIN + OFF_POOL + j));
    }
}
__device__ void ph_poolgate(const Params& p, int l, int bid, int nb) {
    const int TX = otid();
    const act_t* U = WSP(act_t, WS_U); const act_t* PY = WSP(act_t, WS_PY); act_t* MIX = WSP(act_t, WS_MIX);
    for (size_t idx = (size_t)bid * NT + TX; idx < (size_t)ROWS * 512; idx += (size_t)nb * NT) {
        const int row = (int)(idx >> 9), j = (int)(idx & 511);
        stf(MIX + (size_t)row * DM + 1536 + j, ldf(PY + idx) * p.pool_scale[l * 512 + j] * silu_f(ldf(U + (size_t)row * NIN + OFF_POOL_G + j)));
    }
}
__device__ void ph_pack_qkv(const Params& p, int bid, int nb) {
    const int TX = otid();
    const act_t* U = WSP(act_t, WS_U); const act_t* QR = WSP(act_t, WS_QRAW); const act_t* KVR = WSP(act_t, WS_KVRAW);
    act_t* Q = WSP(act_t, WS_Q); act_t* KB = WSP(act_t, WS_KB); act_t* VB = WSP(act_t, WS_VB);
    for (size_t idx = (size_t)bid * NT + TX; idx < (size_t)ROWS * NH * 128; idx += (size_t)nb * NT) {
        const int d = (int)(idx & 127), h = (int)((idx >> 7) & 7), row = (int)(idx >> 10);
        const RowInfo r = rowinfo(row);
        const size_t pos = (size_t)(r.b * NH + h) * LK + r.n;
        stf(Q + pos * 192 + d, ldf(QR + (size_t)row * 1536 + h * 192 + d));
        stf(KB + pos * 192 + d, ldf(KVR + (size_t)row * 2048 + h * 256 + d));
        stf(VB + pos * 128 + d, ldf(KVR + (size_t)row * 2048 + h * 256 + 128 + d));
    }
    for (size_t idx = (size_t)bid * NT + TX; idx < (size_t)ROWS * NH * 32; idx += (size_t)nb * NT) {
        const int i = (int)(idx & 31), h = (int)((idx >> 5) & 7), row = (int)(idx >> 8);
        const RowInfo r = rowinfo(row);
        const size_t pos = (size_t)(r.b * NH + h) * LK + r.n;
        float cs = 1.f, sn = 0.f;
        if (row < ROWS_L) {
            const float inv = expf(-(float)(i & 15) * (9.210340371976184f / 16.f));
            const float ang = (float)(i < 16 ? (r.t >> 6) : (r.t & 63)) * inv;
            cs = fcos(ang); sn = fsin(ang);
        }
        const float q0 = ldf(QR + (size_t)row * 1536 + h * 192 + 128 + 2 * i), q1 = ldf(QR + (size_t)row * 1536 + h * 192 + 128 + 2 * i + 1);
        stf(Q + pos * 192 + 128 + 2 * i, q0 * cs - q1 * sn); stf(Q + pos * 192 + 128 + 2 * i + 1, q0 * sn + q1 * cs);
        const float k0 = ldf(U + (size_t)row * NIN + OFF_KR + 2 * i), k1 = ldf(U + (size_t)row * NIN + OFF_KR + 2 * i + 1);
        stf(KB + pos * 192 + 128 + 2 * i, k0 * cs - k1 * sn); stf(KB + pos * 192 + 128 + 2 * i + 1, k0 * sn + k1 * cs);
    }
}

__device__ void ph_attn(const Params& p, int l, int bid, int nb, float* sm) {
    const int TX = otid();
    float* S = sm; float* qs = sm + 8 * LK; float* linv = qs + 8 * 192;
    const int tid = TX, lane = tid & 63, wid = tid >> 6;
    const act_t* Q = WSP(act_t, WS_Q); const act_t* KB = WSP(act_t, WS_KB); const act_t* VB = WSP(act_t, WS_VB); const act_t* U = WSP(act_t, WS_U); act_t* MIX = WSP(act_t, WS_MIX);
    const int nlat = NB * NH * (SEQ / 8), nctx = (l < DEPTH - 1) ? NB * NH * (CTXL / 8) : 0;
    for (int u = bid; u < nlat + nctx; u += nb) {
        int b, h, q0, k0, nk;
        if (u < nlat) { b = u >> 11; h = (u >> 8) & 7; q0 = (u & 255) * 8; k0 = 0; nk = LK; }
        else { const int v = u - nlat; b = v >> 8; h = (v >> 5) & 7; q0 = SEQ + (v & 31) * 8; k0 = SEQ; nk = CTXL; }
        const size_t hb = (size_t)(b * NH + h) * LK;
        const act_t* Qp = Q + (hb + q0) * 192; const act_t* Kp = KB + (hb + k0) * 192; const act_t* Vp = VB + (hb + k0) * 128;
        for (int i = tid; i < 8 * 192; i += NT) qs[i] = ldf(Qp + i);
        __syncthreads();
        for (int kk = tid; kk < nk; kk += NT) {
            float acc[8];
#pragma unroll
            for (int i = 0; i < 8; ++i) acc[i] = 0.f;
            const act_t* kr = Kp + (size_t)kk * 192;
            for (int d = 0; d < 192; ++d) { const float kv = ldf(kr + d);
#pragma unroll
                for (int i = 0; i < 8; ++i) acc[i] += kv * qs[i * 192 + d]; }
#pragma unroll
            for (int i = 0; i < 8; ++i) S[i * LK + kk] = acc[i] * ATTN_SCALE;
        }
        __syncthreads();
        { float* row = S + wid * LK; float m = -INFINITY;
          for (int kk = lane; kk < nk; kk += 64) m = fmaxf(m, row[kk]);
          m = wave_max(m); float s = 0;
          for (int kk = lane; kk < nk; kk += 64) { const float e = expf(row[kk] - m); row[kk] = e; s += e; }
          s = wave_sum(s); if (lane == 0) linv[wid] = 1.f / s; }
        __syncthreads();
        { const int d = tid & 127, qg = tid >> 7; float o0 = 0, o1 = 0; const float* s0 = S + (2 * qg) * LK; const float* s1 = s0 + LK;
          for (int kk = 0; kk < nk; ++kk) { const float v = ldf(Vp + (size_t)kk * 128 + d); o0 += s0[kk] * v; o1 += s1[kk] * v; }
#pragma unroll
          for (int e = 0; e < 2; ++e) { const int qi = 2 * qg + e, n = q0 + qi; const int row = n < SEQ ? b * SEQ + n : ROWS_L + b * CTXL + (n - SEQ);
              const float g = ldf(U + (size_t)row * NIN + OFF_MLA_G + h * 128 + d);
              stf(MIX + (size_t)row * DM + 512 + h * 128 + d, (e ? o1 : o0) * linv[qi] * silu_f(g)); } }
        __syncthreads();
    }
}

__device__ void ph_conv(const Params& p, int l, int order, int bid, int nb, float* sm) {
    const int TX = otid();
    float* Zs = sm; float* Ks = sm + 4096;
    const int tid = TX, c = tid & 63, tg = tid >> 6;
    const act_t* U = WSP(act_t, WS_U); const act_t* HC = WSP(act_t, WS_HC); act_t* Z2 = WSP(act_t, WS_Z2); act_t* MIX = WSP(act_t, WS_MIX);
    const act_t* zsrc = order == 0 ? HC : Z2; const int zld = order == 0 ? 1536 : 512;
    const int nlat = NB * (SEQ / 64) * 8, nctx = (l < DEPTH - 1) ? NB * (CTXL / 64) * 8 : 0;
    for (int u = bid; u < nlat + nctx; u += nb) {
        int Lidx, b, T0, c0, L, rowbase;
        if (u < nlat) { Lidx = 0; L = SEQ; b = u >> 8; T0 = ((u >> 3) & 31) * 64; c0 = (u & 7) * 64; rowbase = b * SEQ; }
        else { const int v = u - nlat; Lidx = 1; L = CTXL; b = v >> 5; T0 = ((v >> 3) & 3) * 64; c0 = (v & 7) * 64; rowbase = ROWS_L + b * CTXL; }
        const float* F = (Lidx ? WSP(float, WS_FC) : WSP(float, WS_FL)) + (size_t)order * 2 * L * 512;
        float acc[8];
#pragma unroll
        for (int i = 0; i < 8; ++i) acc[i] = 0.f;
        for (int S0 = 0; S0 < L; S0 += 64) {
            for (int i = tid; i < 4096; i += NT) { const int ss = i >> 6, cc = i & 63; Zs[i] = ldf(zsrc + (size_t)(rowbase + S0 + ss) * zld + c0 + cc); }
            for (int i = tid; i < 127 * 64; i += NT) { const int j = i >> 6, cc = i & 63; const int n = T0 - S0 + j - 63;
                Ks[i] = n >= 0 ? F[((size_t)0 * L + n) * 512 + c0 + cc] : F[((size_t)1 * L + (-n)) * 512 + c0 + cc]; }
            __syncthreads();
            for (int ss = 0; ss < 64; ++ss) { const float z = Zs[ss * 64 + c];
#pragma unroll
                for (int i = 0; i < 8; ++i) acc[i] += z * Ks[(tg * 8 + i - ss + 63) * 64 + c]; }
            __syncthreads();
        }
        const float scl = WSP(float, WS_FSCL)[(Lidx * 2 + order) * 512 + c0 + c], bias = p.hy_bias[(l * 2 + order) * 512 + c0 + c];
#pragma unroll
        for (int i = 0; i < 8; ++i) {
            const int row = rowbase + T0 + tg * 8 + i;
            const float zt = ldf(zsrc + (size_t)row * zld + c0 + c);
            const float y = scl * acc[i] + bias * zt;
            if (order == 0) stf(Z2 + (size_t)row * 512 + c0 + c, ldf(HC + (size_t)row * 1536 + 512 + c0 + c) * y);
            else stf(MIX + (size_t)row * DM + c0 + c, ldf(HC + (size_t)row * 1536 + 1024 + c0 + c) * y * silu_f(ldf(U + (size_t)row * NIN + OFF_HY_G + c0 + c)));
        }
    }
}

__device__ void ph_final(const Params& p, int bid, int nb) {
    const int TX = otid();
    const int lane = TX & 63, wid = TX >> 6, nw = NT >> 6;
    for (int row = bid * nw + wid; row < ROWS_L; row += nb * nw) {
        const float* xr = WSP(float, WS_XW) + (size_t)row * DM;
        float ss = 0;
#pragma unroll 2
        for (int j = 0; j < 8; ++j) { const float4 v = *(const float4*)(xr + (j * 64 + lane) * 4); ss += v.x * v.x + v.y * v.y + v.z * v.z + v.w * v.w; }
        ss = wave_sum(ss);
        const float rstd = rsqrtf(ss * (1.f / DM) + EPS);
#pragma unroll 1
        for (int j = 0; j < 8; ++j) { const int k = (j * 64 + lane) * 4; const float4 v = *(const float4*)(xr + k); const float4 g = *(const float4*)(p.final_norm_g + k);
            *(float4*)(p.out + (size_t)row * DM + k) = make_float4(v.x * rstd * g.x, v.y * rstd * g.y, v.z * rstd * g.z, v.w * rstd * g.w); }
    }
}

namespace pg8 {
#define PG8_LAS __attribute__((address_space(3)))
typedef unsigned short bf16_t;
typedef short bf16x8 __attribute__((ext_vector_type(8)));
typedef float f32x4 __attribute__((ext_vector_type(4)));
typedef unsigned u32x4 __attribute__((ext_vector_type(4)));
constexpr int BM = 256, BK = 64, HALF = 128, HTB = HALF * BK * 2  , STAGE_BYTES = 8 * HTB, NXCD = 8, WGM = 8;

__host__ __device__ __forceinline__ int lds_byte(int r, int c) { const int st = (r >> 4) * 2 + (c >> 5), rr = r & 15, cc = c & 31, ob = rr * 64 + cc * 2; return st * 1024 + (ob ^ (((ob >> 9) & 1) << 5)); }
__host__ __device__ __forceinline__ void stage_rc(int b, int& R, int& C) { const int st = b / 1024, sb = b % 1024, swz = sb ^ (((sb >> 9) & 1) << 5); R = (st >> 1) * 16 + swz / 64; C = (st & 1) * 32 + (swz % 64) / 2; }
__host__ __device__ __forceinline__ int perm32(int rho) { const int n = rho >> 4, i = rho & 15; return 8 * (i >> 2) + 4 * n + (i & 3); }

struct Unit { int pm, pn; };
struct Gemm { const bf16_t* A; const bf16_t* Bt; int M, N, K; };

struct StaticOrder {
    int nM, nN, nwg, G, c;
    __host__ __device__ void init(int M, int N, int G_, int c_) { nM = M / BM; nN = N / BM; nwg = nM * nN; G = G_; c = c_; }
    __host__ __device__ bool next(int i, Unit& u) const {
        const long L = (long)i * G + c; if (L >= nwg) return false;
        int wgid = (int)L; { const int q = nwg / NXCD, r = nwg % NXCD, xcd = wgid % NXCD, off = wgid / NXCD; wgid = (xcd < r ? xcd * (q + 1) : r * (q + 1) + (xcd - r) * q) + off; }
        const int nig = WGM * nN, gid = wgid / nig, fm = gid * WGM, gsz = (nM - fm) < WGM ? (nM - fm) : WGM;
        u.pm = fm + ((wgid % nig) % gsz); u.pn = (wgid % nig) / gsz; return true;
    }
    __device__ __forceinline__ void a_ready(const Unit&) const {}
    __device__ __forceinline__ void done(const Unit&) const {}
};

__device__ __forceinline__ unsigned cvt_pk_bf16(float lo, float hi) { unsigned r; asm volatile("v_cvt_pk_bf16_f32 %0, %1, %2" : "=v"(r) : "v"(lo), "v"(hi)); return r; }

typedef unsigned u32x4_t __attribute__((ext_vector_type(4)));
struct EpiStoreBf16 {
    static constexpr bool PERM = true, AFTER_DRAIN = false;
    bf16_t* O; int ldc; int ncols;
    __device__ __forceinline__ void operator()(const f32x4 (&acc)[2][2][4][2], const Unit& u, int wr, int wc, int fr, int fq) const {
        const int row0 = u.pm * BM + wr * 64 + fr, col0 = u.pn * BM + wc * 32 + 8 * fq;
#pragma unroll
        for (int ai = 0; ai < 2; ++ai)
#pragma unroll
            for (int m = 0; m < 4; ++m) { bf16_t* rowp = O + (size_t)(row0 + ai * HALF + m * 16) * ldc + col0;
#pragma unroll
                for (int bj = 0; bj < 2; ++bj) { if (col0 + bj * HALF < ncols) { const f32x4 v0 = acc[ai][bj][m][0], v1 = acc[ai][bj][m][1];
                    u32x4_t w; w.x = cvt_pk_bf16(v0[0], v0[1]); w.y = cvt_pk_bf16(v0[2], v0[3]); w.z = cvt_pk_bf16(v1[0], v1[1]); w.w = cvt_pk_bf16(v1[2], v1[3]);
                    *(u32x4_t*)(rowp + bj * HALF) = w; } } }
    }
};
struct EpiResid {
    static constexpr bool PERM = false, AFTER_DRAIN = false;
    const float* xl; const float* xc; float* XW; const float* gate;
    __device__ __forceinline__ void operator()(const f32x4 (&acc)[2][2][4][2], const Unit& u, int wr, int wc, int fr, int fq) const {
        const int col0 = u.pn * BM + wc * 32 + 4 * fq;
#pragma unroll
        for (int ai = 0; ai < 2; ++ai)
#pragma unroll
            for (int m = 0; m < 4; ++m) { const int row = u.pm * BM + ai * HALF + wr * 64 + m * 16 + fr;
                const float* xr = row < 8192 ? xl + (size_t)row * 2048 : xc + (size_t)(row - 8192) * 2048;
                const float* g = gate + (size_t)(row < 8192 ? (row >> 11) : 4) * 6144;
                float* o = XW + (size_t)row * 2048;
#pragma unroll
                for (int bj = 0; bj < 2; ++bj)
#pragma unroll
                    for (int n = 0; n < 2; ++n) { const int c = col0 + bj * HALF + n * 16;
                        const f32x4 xv = *(const f32x4*)(xr + c), gv = *(const f32x4*)(g + c);
                        *(f32x4*)(o + c) = xv + gv * acc[ai][bj][m][n]; } }
    }
};

template <class Epi, class Sched, bool ALIGN_EPI = false, bool SP2 = false>
__device__ __forceinline__ void gemm_phase(PG8_LAS unsigned char* lds, const Gemm g, const Sched& S, const Epi& E) {
    int tid_ = threadIdx.x; asm volatile("" : "+v"(tid_));
    const int tid = tid_, wid = __builtin_amdgcn_readfirstlane(tid >> 6), lane = tid & 63, wr = wid >> 2, wc = wid & 3, fr = lane & 15, fq = lane >> 4;
    const int K = g.K, nt = K / BK;
    unsigned voffA[2], voffB[2];
#pragma unroll
    for (int i = 0; i < 2; ++i) { int R, C; stage_rc(tid * 16 + i * 8192, R, C); const int Rb = Epi::PERM ? ((R & ~31) + perm32(R & 31)) : R;
        voffA[i] = (unsigned)(R * K + C) * 2u; voffB[i] = (unsigned)(Rb * K + C) * 2u; }
    const size_t kstep = (size_t)(BK * 2);
    const size_t hstep = (size_t)HALF * K * 2;
    const size_t tstep = 2 * hstep;
    const unsigned ldsw = (unsigned)wid * 1024u;
    const int aoff = lds_byte(wr * 64 + fr, fq * 8), boff = lds_byte(wc * 32 + fr, fq * 8);
#define PG8_SA(b, h) (((b) * 2 + (h)) * HTB)
#define PG8_SB(b, h) ((4 + (b) * 2 + (h)) * HTB)
#define PG8_STAGE(bufoff, gbase, voff) do { _Pragma("unroll") for (int _i = 0; _i < 2; ++_i) \
        __builtin_amdgcn_global_load_lds((const unsigned*)((const char*)(gbase) + (voff)[_i]), (PG8_LAS unsigned*)(lds + (bufoff) + ldsw + _i * 8192), 16, 0, 0); } while (0)
#define PG8_LDA(dst, b, h) do { _Pragma("unroll") for (int m = 0; m < 4; ++m) _Pragma("unroll") for (int k = 0; k < 2; ++k) dst[m][k] = *(const PG8_LAS bf16x8*)(lds + PG8_SA(b, h) + aoff + m * 2048 + k * 1024); } while (0)
#define PG8_LDB(dst, b, h) do { _Pragma("unroll") for (int n = 0; n < 2; ++n) _Pragma("unroll") for (int k = 0; k < 2; ++k) dst[n][k] = *(const PG8_LAS bf16x8*)(lds + PG8_SB(b, h) + boff + n * 2048 + k * 1024); } while (0)
#define PG8_MMA(ai, bj, At, Bt) do { __builtin_amdgcn_s_setprio(1); _Pragma("unroll") for (int m = 0; m < 4; ++m) _Pragma("unroll") for (int n = 0; n < 2; ++n) _Pragma("unroll") for (int k = 0; k < 2; ++k) \
        acc[ai][bj][m][n] = __builtin_amdgcn_mfma_f32_16x16x32_bf16(Bt[n][k], At[m][k], acc[ai][bj][m][n], 0, 0, 0); __builtin_amdgcn_s_setprio(0); } while (0)
#define PG8_WAIT_V(n) asm volatile("s_waitcnt vmcnt(" #n ")" ::: "memory")
#define PG8_WAIT_L(n) asm volatile("s_waitcnt lgkmcnt(" #n ")" ::: "memory")
#define PG8_BAR __builtin_amdgcn_s_barrier()
#define PG8_SCHED __builtin_amdgcn_sched_barrier(0)
    Unit cur, nxt; int ui = 0;
    if (!S.next(0, cur)) return;
    f32x4 acc[2][2][4][2];
#pragma unroll
    for (int a = 0; a < 2; ++a)
#pragma unroll
        for (int b = 0; b < 2; ++b)
#pragma unroll
            for (int m = 0; m < 4; ++m)
#pragma unroll
                for (int n = 0; n < 2; ++n) acc[a][b][m][n] = (f32x4){0.f, 0.f, 0.f, 0.f};
    bf16x8 At[4][2], B0[2][2], B1[2][2];
    const char* cA = (const char*)g.A + (size_t)cur.pm * tstep; const char* cB = (const char*)g.Bt + (size_t)cur.pn * tstep;
    S.a_ready(cur);
    if constexpr (SP2) {
        PG8_STAGE(PG8_SB(0, 0), cB, voffB); PG8_STAGE(PG8_SB(0, 1), cB + hstep, voffB); PG8_STAGE(PG8_SA(0, 0), cA, voffA); PG8_STAGE(PG8_SA(0, 1), cA + hstep, voffA);
        if (wr == 1) PG8_BAR;
        PG8_WAIT_V(2); PG8_BAR;
        PG8_STAGE(PG8_SB(1, 0), cB + kstep, voffB); PG8_STAGE(PG8_SA(1, 0), cA + kstep, voffA); PG8_STAGE(PG8_SB(1, 1), cB + hstep + kstep, voffB);
        PG8_WAIT_V(6); PG8_BAR;
    } else {
        PG8_STAGE(PG8_SB(0, 0), cB, voffB); PG8_STAGE(PG8_SA(0, 0), cA, voffA); PG8_STAGE(PG8_SB(0, 1), cB + hstep, voffB); PG8_STAGE(PG8_SA(0, 1), cA + hstep, voffA);
        if (wr == 1) PG8_BAR;
        PG8_WAIT_V(4); PG8_BAR;
        PG8_STAGE(PG8_SB(1, 0), cB + kstep, voffB); PG8_STAGE(PG8_SA(1, 0), cA + kstep, voffA); PG8_STAGE(PG8_SB(1, 1), cB + hstep + kstep, voffB);
        PG8_WAIT_V(6); PG8_BAR;
    }
    for (;;) {
        const bool has_next = S.next(ui + 1, nxt);
        const char* nA = has_next ? (const char*)g.A + (size_t)nxt.pm * tstep : cA; const char* nB = has_next ? (const char*)g.Bt + (size_t)nxt.pn * tstep : cB;
        for (int t = 0; t < nt; t += 2) {
            const bool last = (t == nt - 2);
            const char* a1 = cA + (size_t)(t + 1) * kstep;
            const char* a2 = last ? nA : cA + (size_t)(t + 2) * kstep; const char* b2 = last ? nB : cB + (size_t)(t + 2) * kstep;
            const char* a3 = a2 + kstep; const char* b3 = b2 + kstep;
            if (last && has_next) S.a_ready(nxt);
            if constexpr (SP2) {
            PG8_LDB(B0, 0, 0); PG8_LDB(B1, 0, 1); PG8_SCHED; PG8_LDA(At, 0, 0); PG8_STAGE(PG8_SA(1, 1), a1 + hstep, voffA);
            PG8_WAIT_V(8); PG8_WAIT_L(0); PG8_BAR; PG8_MMA(0, 0, At, B0); PG8_MMA(0, 1, At, B1); PG8_BAR; PG8_SCHED;
            PG8_LDA(At, 0, 1); PG8_STAGE(PG8_SB(0, 0), b2, voffB); PG8_STAGE(PG8_SB(0, 1), b2 + hstep, voffB); PG8_STAGE(PG8_SA(0, 0), a2, voffA);
            PG8_WAIT_V(8); PG8_WAIT_L(0); PG8_BAR; PG8_MMA(1, 0, At, B0); PG8_MMA(1, 1, At, B1); PG8_BAR; PG8_SCHED;
            PG8_LDB(B0, 1, 0); PG8_LDB(B1, 1, 1); PG8_SCHED; PG8_LDA(At, 1, 0); PG8_STAGE(PG8_SA(0, 1), a2 + hstep, voffA);
            PG8_WAIT_V(8); PG8_WAIT_L(0); PG8_BAR; PG8_MMA(0, 0, At, B0); PG8_MMA(0, 1, At, B1); PG8_BAR; PG8_SCHED;
            PG8_LDA(At, 1, 1); PG8_STAGE(PG8_SB(1, 0), b3, voffB); PG8_STAGE(PG8_SB(1, 1), b3 + hstep, voffB); PG8_STAGE(PG8_SA(1, 0), a3, voffA);
            PG8_WAIT_V(8); PG8_WAIT_L(0); PG8_BAR; PG8_MMA(1, 0, At, B0); PG8_MMA(1, 1, At, B1); PG8_BAR; PG8_SCHED;
            } else {
            PG8_LDB(B0, 0, 0); PG8_SCHED; PG8_LDA(At, 0, 0); PG8_STAGE(PG8_SA(1, 1), a1 + hstep, voffA);
            PG8_WAIT_L(8); PG8_BAR; PG8_WAIT_L(0); PG8_MMA(0, 0, At, B0); PG8_BAR; PG8_SCHED;
            PG8_LDB(B1, 0, 1); PG8_STAGE(PG8_SB(0, 0), b2, voffB);
            PG8_BAR; PG8_WAIT_L(0); PG8_MMA(0, 1, At, B1); PG8_BAR;
            PG8_LDA(At, 0, 1); PG8_STAGE(PG8_SA(0, 0), a2, voffA);
            PG8_BAR; PG8_WAIT_L(0); PG8_MMA(1, 0, At, B0); PG8_BAR; PG8_SCHED;
            PG8_STAGE(PG8_SB(0, 1), b2 + hstep, voffB);
            PG8_WAIT_V(6); PG8_BAR; PG8_MMA(1, 1, At, B1); PG8_BAR;
            PG8_LDB(B0, 1, 0); PG8_SCHED; PG8_LDA(At, 1, 0); PG8_STAGE(PG8_SA(0, 1), a2 + hstep, voffA);
            PG8_WAIT_L(8); PG8_BAR; PG8_WAIT_L(0); PG8_MMA(0, 0, At, B0); PG8_BAR; PG8_SCHED;
            PG8_LDB(B1, 1, 1); PG8_STAGE(PG8_SB(1, 0), b3, voffB);
            PG8_BAR; PG8_WAIT_L(0); PG8_MMA(0, 1, At, B1); PG8_BAR;
            PG8_LDA(At, 1, 1); PG8_STAGE(PG8_SA(1, 0), a3, voffA);
            PG8_BAR; PG8_WAIT_L(0); PG8_MMA(1, 0, At, B0); PG8_BAR; PG8_SCHED;
            PG8_STAGE(PG8_SB(1, 1), b3 + hstep, voffB);
            PG8_WAIT_V(6); PG8_BAR; PG8_MMA(1, 1, At, B1); PG8_BAR;
            }
        }
        if constexpr (ALIGN_EPI) { if (wr == 0) PG8_BAR; }
        if constexpr (!Epi::AFTER_DRAIN) { E(acc, cur, wr, wc, fr, fq); S.done(cur); }
        if (!has_next) break;
#pragma unroll
        for (int a = 0; a < 2; ++a)
#pragma unroll
            for (int b = 0; b < 2; ++b)
#pragma unroll
                for (int m = 0; m < 4; ++m)
#pragma unroll
                    for (int n = 0; n < 2; ++n) acc[a][b][m][n] = (f32x4){0.f, 0.f, 0.f, 0.f};
        cur = nxt; cA = nA; cB = nB; ++ui;
        if constexpr (ALIGN_EPI) { if (wr == 1) PG8_BAR; }
    }
    PG8_WAIT_V(0);
    if constexpr (!ALIGN_EPI) { if (wr == 0) PG8_BAR; }
    PG8_BAR;
    if constexpr (Epi::AFTER_DRAIN) { E.fused(acc, cur, wr, wc, fr, fq, lds, wid, lane); S.done(cur); }
#undef PG8_SA
#undef PG8_SB
#undef PG8_STAGE
#undef PG8_LDA
#undef PG8_LDB
#undef PG8_MMA
#undef PG8_WAIT_V
#undef PG8_WAIT_L
#undef PG8_BAR
#undef PG8_SCHED
}
}


namespace att {
using bf16x8 = __attribute__((ext_vector_type(8))) short;
using s16x4  = __attribute__((ext_vector_type(4))) short;
using f32x16 = __attribute__((ext_vector_type(16))) float;
using u32x4  = __attribute__((ext_vector_type(4))) unsigned;
constexpr int QBLK = 32, KVBLK = 64, NW = 8;
constexpr float SCALE = 0.07216878364870322f, THR = 8.f;
constexpr int SHM_V = 16384, SHM_KN = 16384, SHM_KR = 8192;
constexpr int OFF_V = 0, OFF_KN = 2 * SHM_V, OFF_KR = OFF_KN + 2 * SHM_KN, OFF_WS = OFF_KR + 2 * SHM_KR, OFF_QR = OFF_WS + NW * 64 * 4, SHM_TOTAL = OFF_QR + NW * 4096;
#define KSWZ(row, colB) ((row) * 256 + ((colB) ^ (((row) & 7) << 4)))
#define RSWZ(row, ch) ((row) * 128 + ((((ch) ^ (((row) >> 1) & 7))) << 4))
#define SBAR() __builtin_amdgcn_sched_barrier(0)
__device__ __forceinline__ int crow(int r, int hi) { return (r & 3) + 8 * (r >> 2) + 4 * hi; }
__device__ __forceinline__ unsigned cvtpk(float lo, float hi) { unsigned r; asm volatile("v_cvt_pk_bf16_f32 %0, %1, %2" : "=v"(r) : "v"(lo), "v"(hi)); return r; }
__device__ __forceinline__ bf16x8 ld8(const bf16_t* p) { return *reinterpret_cast<const bf16x8*>(p); }

__device__ __forceinline__ void partialSM(f32x16& p0, f32x16& p1, float& m_reg, float& mn, float& alpha) {
  constexpr float C = SCALE * 1.4426950408889634f;
  float pmax = p0[0];
#pragma unroll
  for (int r = 1; r < 16; ++r) pmax = fmaxf(pmax, p0[r]);
#pragma unroll
  for (int r = 0; r < 16; ++r) pmax = fmaxf(pmax, p1[r]);
  { auto rr = __builtin_amdgcn_permlane32_swap(__float_as_uint(pmax), __float_as_uint(pmax), false, false);
    pmax = fmaxf(__uint_as_float(rr[0]), __uint_as_float(rr[1])); }
  if (__builtin_expect(__all(pmax - m_reg <= THR / SCALE), 1)) { mn = m_reg; alpha = 1.f; }
  else { mn = fmaxf(m_reg, pmax); alpha = __builtin_amdgcn_exp2f((m_reg - mn) * C); m_reg = mn; }
  const float mnC = -mn * C;
#pragma unroll
  for (int r = 0; r < 16; ++r) p0[r] = fmaf(p0[r], C, mnC);
#pragma unroll
  for (int r = 0; r < 16; ++r) p1[r] = fmaf(p1[r], C, mnC);
#pragma unroll
  for (int r = 0; r < 16; ++r) p0[r] = __builtin_amdgcn_exp2f(p0[r]);
}
__device__ __forceinline__ void finishSM(f32x16& p0, f32x16& p1, float alpha, float& l_reg, bf16x8& pa0, bf16x8& pa1, bf16x8& pa2, bf16x8& pa3) {
#pragma unroll
  for (int r = 0; r < 16; ++r) p1[r] = __builtin_amdgcn_exp2f(p1[r]);
  float ps = 0;
#pragma unroll
  for (int r = 0; r < 16; ++r) ps += p0[r];
#pragma unroll
  for (int r = 0; r < 16; ++r) ps += p1[r];
  { auto rr = __builtin_amdgcn_permlane32_swap(__float_as_uint(ps), __float_as_uint(ps), false, false);
    ps = __uint_as_float(rr[0]) + __uint_as_float(rr[1]); }
  l_reg = l_reg * alpha + ps;
#define PK4(P, BASE, OUT) do { unsigned a0 = cvtpk(P[BASE + 0], P[BASE + 1]), a1 = cvtpk(P[BASE + 2], P[BASE + 3]);   \
    unsigned b0 = cvtpk(P[BASE + 4], P[BASE + 5]), b1 = cvtpk(P[BASE + 6], P[BASE + 7]);                              \
    auto r0 = __builtin_amdgcn_permlane32_swap(a0, b0, false, false); auto r1 = __builtin_amdgcn_permlane32_swap(a1, b1, false, false); \
    u32x4 w = {r0[0], r1[0], r0[1], r1[1]}; OUT = *reinterpret_cast<bf16x8*>(&w); } while (0)
  PK4(p0, 0, pa0); PK4(p0, 8, pa1); PK4(p1, 0, pa2); PK4(p1, 8, pa3);
#undef PK4
}
__device__ __forceinline__ void qkt(f32x16& p0, f32x16& p1, const char* Kn, const char* Kr, const bf16x8* qr, const char* qrl, int r32, int hi) {
  p0 = f32x16{}; p1 = f32x16{};
#pragma unroll
  for (int d0 = 0; d0 < 8; ++d0) { const int cb = (d0 * 16 + hi * 8) * 2;
    const bf16x8 b0 = *reinterpret_cast<const bf16x8*>(Kn + KSWZ(r32, cb));
    const bf16x8 b1 = *reinterpret_cast<const bf16x8*>(Kn + KSWZ(32 + r32, cb));
    p0 = __builtin_amdgcn_mfma_f32_32x32x16_bf16(b0, qr[d0], p0, 0, 0, 0);
    p1 = __builtin_amdgcn_mfma_f32_32x32x16_bf16(b1, qr[d0], p1, 0, 0, 0); }
#pragma unroll
  for (int d0 = 0; d0 < 4; ++d0) { const int ch = d0 * 2 + hi;
    const bf16x8 b0 = *reinterpret_cast<const bf16x8*>(Kr + RSWZ(r32, ch));
    const bf16x8 b1 = *reinterpret_cast<const bf16x8*>(Kr + RSWZ(32 + r32, ch));
    const bf16x8 qv = *reinterpret_cast<const bf16x8*>(qrl + d0 * 1024);
    p0 = __builtin_amdgcn_mfma_f32_32x32x16_bf16(b0, qv, p0, 0, 0, 0);
    p1 = __builtin_amdgcn_mfma_f32_32x32x16_bf16(b1, qv, p1, 0, 0, 0); }
}
__device__ __forceinline__ int v_st(int k, int c) { const int kk = (k & ~0xC) | ((k & 4) << 1) | ((k & 8) >> 1); return ((kk >> 3) * 4 + (c >> 5)) * 512 + ((kk & 7) * 32 + (c & 31)) * 2; }
__device__ __forceinline__ int v_rd_base(int lane) { return ((lane & 3) << 3) | (((lane >> 2) & 3) << 6) | (((lane >> 4) & 1) << 5) | (((lane >> 5) & 1) << 8); }
constexpr int v_rd_off(int d0, int ks, int half) { return d0 * 512 + ks * 4096 + half * 2048; }
template <int OFF> __device__ __forceinline__ s16x4 tr_read(int vb) {
  s16x4 r; asm volatile("ds_read_b64_tr_b16 %0, %1 offset:%2" : "=&v"(r) : "v"(vb), "i"(OFF) : "memory"); return r;
}
template <int D0> __device__ __forceinline__ void pv_one(f32x16& od, int vb, bf16x8 pa0, bf16x8 pa1, bf16x8 pa2, bf16x8 pa3) {
  const s16x4 l0 = tr_read<v_rd_off(D0, 0, 0)>(vb), h0 = tr_read<v_rd_off(D0, 0, 1)>(vb), l1 = tr_read<v_rd_off(D0, 1, 0)>(vb), h1 = tr_read<v_rd_off(D0, 1, 1)>(vb);
  const s16x4 l2 = tr_read<v_rd_off(D0, 2, 0)>(vb), h2 = tr_read<v_rd_off(D0, 2, 1)>(vb), l3 = tr_read<v_rd_off(D0, 3, 0)>(vb), h3 = tr_read<v_rd_off(D0, 3, 1)>(vb);
  asm volatile("s_waitcnt lgkmcnt(0)" ::: "memory"); SBAR();
#define PK(L, H) (bf16x8){L[0], L[1], L[2], L[3], H[0], H[1], H[2], H[3]}
  od = __builtin_amdgcn_mfma_f32_32x32x16_bf16(pa0, PK(l0, h0), od, 0, 0, 0);
  od = __builtin_amdgcn_mfma_f32_32x32x16_bf16(pa1, PK(l1, h1), od, 0, 0, 0);
  od = __builtin_amdgcn_mfma_f32_32x32x16_bf16(pa2, PK(l2, h2), od, 0, 0, 0);
  od = __builtin_amdgcn_mfma_f32_32x32x16_bf16(pa3, PK(l3, h3), od, 0, 0, 0);
#undef PK
}
__device__ __forceinline__ void pv_d0(f32x16* o, int vb, bf16x8 pa0, bf16x8 pa1, bf16x8 pa2, bf16x8 pa3) {
  pv_one<0>(o[0], vb, pa0, pa1, pa2, pa3); pv_one<1>(o[1], vb, pa0, pa1, pa2, pa3); pv_one<2>(o[2], vb, pa0, pa1, pa2, pa3); pv_one<3>(o[3], vb, pa0, pa1, pa2, pa3);
}
__device__ __forceinline__ void attn_unit(const bf16_t* __restrict__ Qb, const bf16_t* __restrict__ Kh, const bf16_t* __restrict__ Vh, int seq,
                                          bf16_t* __restrict__ Mo, const bf16_t* __restrict__ G, char* lds) {
  int tid_ = threadIdx.x; asm volatile("" : "+v"(tid_));
  const int tid = tid_, wid = tid >> 6, lane = tid & 63, r32 = lane & 31, hi = lane >> 5;
  char* V_lds = lds + OFF_V; char* KN_lds = lds + OFF_KN; char* KR_lds = lds + OFF_KR;
  float* ws = (float*)(lds + OFF_WS) + wid * 64; float* li_l = ws; float* al_l = ws + 32;
  float m_reg = -1e30f, l_reg = 0; f32x16 o[4] = {}; bf16x8 qr[8];
  const bf16_t* Qw = Qb + (long)(wid * QBLK + r32) * 192 + hi * 8;
  char* qrl = lds + OFF_QR + wid * 4096 + lane * 16;
#pragma unroll
  for (int d0 = 0; d0 < 8; ++d0) qr[d0] = ld8(Qw + d0 * 16);
#pragma unroll
  for (int d0 = 0; d0 < 4; ++d0) *reinterpret_cast<bf16x8*>(qrl + d0 * 1024) = ld8(Qw + (8 + d0) * 16);
  const int sr = tid >> 4, sc = (tid & 15) * 8, vst0 = v_st(sr, sc), vst1 = v_st(32 + sr, sc);
  const int rr_ = tid >> 3, rch = tid & 7;
  const int vb0 = (int)(uintptr_t)V_lds + v_rd_base(lane);
  bf16x8 vs0, vs1, ks0, ks1, kr0;
  const int vo0 = sr * 128 + sc, ko0 = sr * 192 + sc, kro = rr_ * 192 + 128 + rch * 8;
#define SLOAD(k0) do { const bf16_t* vt_ = Vh + (long)(k0) * 128; const bf16_t* kt_ = Kh + (long)(k0) * 192; \
    vs0 = ld8(vt_ + vo0); vs1 = ld8(vt_ + vo0 + 32 * 128); ks0 = ld8(kt_ + ko0); ks1 = ld8(kt_ + ko0 + 32 * 192); kr0 = ld8(kt_ + kro); } while (0)
#define SWRITE(b) do { *(bf16x8*)(V_lds + (b) * SHM_V + vst0) = vs0; *(bf16x8*)(V_lds + (b) * SHM_V + vst1) = vs1; const int kc = sc * 2; \
    *(bf16x8*)(KN_lds + (b) * SHM_KN + KSWZ(sr, kc)) = ks0; *(bf16x8*)(KN_lds + (b) * SHM_KN + KSWZ(32 + sr, kc)) = ks1; \
    *(bf16x8*)(KR_lds + (b) * SHM_KR + RSWZ(rr_, rch)) = kr0; } while (0)
#define SWAIT() asm volatile("s_waitcnt vmcnt(0)" ::: "memory")
#define RESC(a) do { if (__any((a) < 1.f)) { if (hi == 0) al_l[r32] = (a); asm volatile("s_waitcnt lgkmcnt(0)" ::: "memory"); \
    _Pragma("unroll") for (int d = 0; d < 4; ++d) _Pragma("unroll") for (int r = 0; r < 16; ++r) o[d][r] *= al_l[crow(r, hi)]; } } while (0)
  f32x16 pA0, pA1, pB0, pB1; float mnA, mnB, alA, alB; bf16x8 pa0, pa1, pa2, pa3; const int NTL = seq / KVBLK;
  SLOAD(0); SWAIT(); SWRITE(0); __syncthreads();
  qkt(pA0, pA1, KN_lds, KR_lds, qr, qrl, r32, hi); partialSM(pA0, pA1, m_reg, mnA, alA);
  SLOAD(KVBLK);
  SWAIT(); SWRITE(1); __syncthreads();
  for (int j = 1; j + 1 < NTL; j += 2) {
    SBAR(); qkt(pB0, pB1, KN_lds + SHM_KN, KR_lds + SHM_KR, qr, qrl, r32, hi);
    finishSM(pA0, pA1, alA, l_reg, pa0, pa1, pa2, pa3); SBAR();
    SLOAD((j + 1) * KVBLK); SBAR();
    pv_d0(o, vb0, pa0, pa1, pa2, pa3); partialSM(pB0, pB1, m_reg, mnB, alB);
    __syncthreads(); SWAIT(); SWRITE(0);
    RESC(alB); __syncthreads();
    SBAR(); qkt(pA0, pA1, KN_lds, KR_lds, qr, qrl, r32, hi);
    finishSM(pB0, pB1, alB, l_reg, pa0, pa1, pa2, pa3); SBAR();
    SLOAD((j + 2) * KVBLK); SBAR();
    pv_d0(o, vb0 + SHM_V, pa0, pa1, pa2, pa3); partialSM(pA0, pA1, m_reg, mnA, alA);
    __syncthreads(); SWAIT(); SWRITE(1);
    RESC(alA); __syncthreads();
  }
  SBAR(); qkt(pB0, pB1, KN_lds + SHM_KN, KR_lds + SHM_KR, qr, qrl, r32, hi);
  finishSM(pA0, pA1, alA, l_reg, pa0, pa1, pa2, pa3); SBAR();
  pv_d0(o, vb0, pa0, pa1, pa2, pa3); partialSM(pB0, pB1, m_reg, mnB, alB);
  __syncthreads(); RESC(alB);
  finishSM(pB0, pB1, alB, l_reg, pa0, pa1, pa2, pa3); SBAR();
  pv_d0(o, vb0 + SHM_V, pa0, pa1, pa2, pa3);
  if (hi == 0) li_l[r32] = l_reg; asm volatile("s_waitcnt lgkmcnt(0)" ::: "memory");
  float rli[16];
#pragma unroll
  for (int r = 0; r < 16; ++r) rli[r] = __builtin_amdgcn_rcpf(li_l[crow(r, hi)]);
#pragma unroll
  for (int r = 0; r < 16; ++r) { const int row = wid * QBLK + crow(r, hi);
#pragma unroll
    for (int d0 = 0; d0 < 4; ++d0) { const int col = d0 * 32 + r32; const float g = bf2f(G[(long)row * NIN + col]);
      Mo[(long)row * DM + col] = f2bf(o[d0][r] * rli[r] * (g / (1.f + __expf(-g)))); } }
  __syncthreads();
#undef SLOAD
#undef SWRITE
#undef SWAIT
#undef RESC
}
#undef SBAR
}

__device__ void ph_attn_mfma(const Params& p, int l, int bid, int nb, char* lds) {
    const bf16_t* Q = WSP(bf16_t, WS_Q); const bf16_t* KB = WSP(bf16_t, WS_KB); const bf16_t* VB = WSP(bf16_t, WS_VB); const bf16_t* U = WSP(bf16_t, WS_U); bf16_t* MIX = WSP(bf16_t, WS_MIX);
    const int vcu = (nb % 8 == 0) ? (bid % 8) * (nb / 8) + bid / 8 : bid;
    const int nlat = NB * NH * (SEQ / 256), nctx = (l < DEPTH - 1) ? NB * NH : 0;
    for (int u = vcu; u < nlat + nctx; u += nb) {
        if (u < nlat) { const int bh = u >> 3, qb = u & 7, b = bh >> 3, h = bh & 7; const size_t hb = (size_t)bh * LK; const size_t rowbase = (size_t)b * SEQ + qb * 256;
            att::attn_unit(Q + (hb + qb * 256) * 192, KB + hb * 192, VB + hb * 128, LK, MIX + rowbase * DM + 512 + h * 128, U + rowbase * NIN + OFF_MLA_G + h * 128, lds); }
        else { const int bh = u - nlat, b = bh >> 3, h = bh & 7; const size_t hb = (size_t)bh * LK + SEQ; const size_t rowbase = (size_t)ROWS_L + b * CTXL;
            att::attn_unit(Q + hb * 192, KB + hb * 192, VB + hb * 128, CTXL, MIX + rowbase * DM + 512 + h * 128, U + rowbase * NIN + OFF_MLA_G + h * 128, lds); }
    }
}

#define LAS __attribute__((address_space(3)))
typedef unsigned v4u __attribute__((ext_vector_type(4)));
__device__ __forceinline__ unsigned pk2(float lo, float hi) { return (unsigned)f2bf(lo) | ((unsigned)f2bf(hi) << 16); }
__device__ __forceinline__ void transpose_item(const float* W, int K, int N, bf16_t* WT, float* scr, int item, int lane) {
    const int nblk = N / 32, kb = item / nblk, nb_ = item % nblk, k0 = 64 * kb, n0 = 32 * nb_;
#pragma unroll 8
    for (int i = 0; i < 32; ++i) { const int kk = 2 * i + (lane >> 5); scr[kk * 33 + (lane & 31)] = W[(size_t)(k0 + kk) * N + n0 + (lane & 31)]; }
    asm volatile("s_waitcnt lgkmcnt(0)" ::: "memory");
    const int c = lane & 7;
#pragma unroll
    for (int j = 0; j < 4; ++j) { const int n = (lane >> 3) + 8 * j; const float* sp = scr + (8 * c) * 33 + n;
        v4u o; o.x = pk2(sp[0 * 33], sp[1 * 33]); o.y = pk2(sp[2 * 33], sp[3 * 33]); o.z = pk2(sp[4 * 33], sp[5 * 33]); o.w = pk2(sp[6 * 33], sp[7 * 33]);
        *(v4u*)(WT + (size_t)(n0 + n) * K + k0 + 8 * c) = o; }
    asm volatile("s_waitcnt lgkmcnt(0)" ::: "memory");
}
__device__ void ph_prologue(const Params& p, int bid, int nb, float* sm) {
    const int tid = otid(), lane = tid & 63, wid = tid >> 6;
    if (bid < DEPTH * 24) {
        float* sil = sm; float* part = sm + 5 * DM;
        for (int i = tid; i < 5 * DM; i += NT) { const int r = i >> 11, k = i & 2047; sil[i] = silu_f(r < 4 ? p.c[r * DM + k] : p.c_ctx[k]); }
        __syncthreads();
        for (int u = bid; u < DEPTH * 24; u += nb) {
            const int l = u / 24, n0 = (u % 24) * 256;
            const float* W = p.w_ada + (size_t)l * DM * 6144 + n0 + lane * 4;
            float4 a[5];
#pragma unroll
            for (int r = 0; r < 5; ++r) a[r] = make_float4(0.f, 0.f, 0.f, 0.f);
#pragma unroll 8
            for (int kk = 0; kk < 256; ++kk) { const int k = wid * 256 + kk; const float4 w = *(const float4*)(W + (size_t)k * 6144);
#pragma unroll
                for (int r = 0; r < 5; ++r) { const float sv = sil[r * DM + k]; a[r].x += sv * w.x; a[r].y += sv * w.y; a[r].z += sv * w.z; a[r].w += sv * w.w; } }
#pragma unroll
            for (int r = 0; r < 5; ++r) *(float4*)(part + (wid * 5 + r) * 256 + lane * 4) = a[r];
            __syncthreads();
            for (int i = tid; i < 5 * 256; i += NT) { const int r = i >> 8, c = i & 255; float sacc = p.b_ada[l * 6144 + n0 + c];
#pragma unroll
                for (int w = 0; w < 8; ++w) sacc += part[(w * 5 + r) * 256 + c];
                WSP(float, WS_MOD)[(size_t)(l * 5 + r) * 6144 + n0 + c] = sacc; }
            __syncthreads();
        }
    }
    __syncthreads();
    float* scr = sm + wid * (64 * 33 + 16);
    const int gw = bid * 8 + wid, NGW = nb * 8;
    constexpr int I_IN = (DM / 64) * (NIN / 32), I_OUT = (DM / 64) * (DM / 32), I_UQ = (512 / 64) * (1536 / 32), I_UKV = (256 / 64) * (2048 / 32), I_ALL = I_IN + I_OUT + I_UQ + I_UKV;
    for (int it = gw; it < DEPTH * I_ALL; it += NGW) {
        const int l = it / I_ALL; int r = it % I_ALL;
        if (r < I_IN) { transpose_item(p.w_in + (size_t)l * DM * NIN, DM, NIN, WSP(bf16_t, WS_WINT) + (size_t)l * NINP * DM, scr, r, lane); continue; } r -= I_IN;
        if (r < I_OUT) { transpose_item(p.w_out + (size_t)l * DM * DM, DM, DM, WSP(bf16_t, WS_WOUTT) + (size_t)l * DM * DM, scr, r, lane); continue; } r -= I_OUT;
        if (r < I_UQ) { transpose_item(p.w_uq + (size_t)l * 512 * 1536, 512, 1536, WSP(bf16_t, WS_WUQT) + (size_t)l * 1536 * 512, scr, r, lane); continue; } r -= I_UQ;
        transpose_item(p.w_ukv + (size_t)l * 256 * 2048, 256, 2048, WSP(bf16_t, WS_WUKVT) + (size_t)l * 2048 * 256, scr, r, lane);
    }
    for (int i = bid * NT + tid; i < DEPTH * 512 * 512; i += nb * NT) {
        const int l = i >> 18, n = (i >> 9) & 511, k = i & 511;
        WSP(bf16_t, WS_WPBD)[i] = (n >> 7) == (k >> 7) ? f2bf(p.w_pool[((size_t)(l * 4 + (n >> 7)) * 128 + (k & 127)) * 128 + (n & 127)]) : (bf16_t)0;
    }
    for (size_t i = (size_t)bid * NT + tid; i < (size_t)DEPTH * (NINP - NIN) * DM / 8; i += (size_t)nb * NT) {
        const size_t per = (size_t)(NINP - NIN) * DM / 8; const int l = (int)(i / per); const size_t o = i % per;
        *(v4u*)(WSP(bf16_t, WS_WINT) + ((size_t)l * NINP + NIN) * DM + o * 8) = (v4u){0u, 0u, 0u, 0u};
    }
    __syncthreads();
}

enum { PH_ADALN = 0, PH_1, PH_2, PH_3, PH_4, PH_5, PH_6, PH_7, PH_FINAL };
__device__ __forceinline__ void run_phase(const Params& pin, int ph, int l, int bid, int nb, float* sm) {
#if defined(__HIP_DEVICE_COMPILE__)
    const __attribute__((address_space(4))) Params* pk = (const __attribute__((address_space(4))) Params*)__builtin_amdgcn_kernarg_segment_ptr();
    asm volatile("" : "+s"(pk));
    const Params p = *pk; (void)pin;
#else
    const Params p = pin;
#endif
    switch (ph) {
    case PH_ADALN: ph_prologue(p, bid, nb, sm); break;
    case PH_1: ph_filter(p, l, bid, nb, sm); ph_norm(p, l, bid, nb); break;
    case PH_2: ph_fscale(p, bid, nb);
        { pg8::Gemm g{WSP(bf16_t, WS_HA), WSP(bf16_t, WS_WINT) + (size_t)l * NINP * DM, ROWS, NINP, DM}; pg8::StaticOrder S; S.init(ROWS, NINP, nb, bid);
          pg8::EpiStoreBf16 E{WSP(bf16_t, WS_U), NIN, NIN};
          pg8::gemm_phase<pg8::EpiStoreBf16, pg8::StaticOrder, true, true>((PG8_LAS unsigned char*)sm, g, S, E); } break;
    case PH_3: ph_rms_small(p, l, bid, nb); ph_shortconv(p, l, bid, nb); ph_pooldiff(p, bid, nb); break;
    case PH_4:
        { pg8::Gemm g{WSP(bf16_t, WS_QN), WSP(bf16_t, WS_WUQT) + (size_t)l * 1536 * 512, ROWS, 1536, 512}; pg8::StaticOrder S; S.init(ROWS, 1536, nb, bid);
          pg8::EpiStoreBf16 E{WSP(bf16_t, WS_QRAW), 1536, 1536};
          pg8::gemm_phase<pg8::EpiStoreBf16, pg8::StaticOrder, true, true>((PG8_LAS unsigned char*)sm, g, S, E); }
        { pg8::Gemm g{WSP(bf16_t, WS_KVN), WSP(bf16_t, WS_WUKVT) + (size_t)l * 2048 * 256, ROWS, 2048, 256}; pg8::StaticOrder S; S.init(ROWS, 2048, nb, bid);
          pg8::EpiStoreBf16 E{WSP(bf16_t, WS_KVRAW), 2048, 2048};
          pg8::gemm_phase<pg8::EpiStoreBf16, pg8::StaticOrder, true, true>((PG8_LAS unsigned char*)sm, g, S, E); }
        { pg8::Gemm g{WSP(bf16_t, WS_PD), WSP(bf16_t, WS_WPBD) + (size_t)l * 512 * 512, ROWS, 512, 512}; pg8::StaticOrder S; S.init(ROWS, 512, nb, bid);
          pg8::EpiStoreBf16 E{WSP(bf16_t, WS_PY), 512, 512};
          pg8::gemm_phase<pg8::EpiStoreBf16, pg8::StaticOrder, true, true>((PG8_LAS unsigned char*)sm, g, S, E); }
        __syncthreads();
        ph_conv(p, l, 0, bid, nb, sm); break;
    case PH_5: ph_pack_qkv(p, bid, nb); ph_conv(p, l, 1, bid, nb, sm); ph_poolgate(p, l, bid, nb); break;
    case PH_6: ph_attn_mfma(p, l, bid, nb, (char*)sm); break;
    case PH_7: { const int Mrows = l == DEPTH - 1 ? ROWS_L : ROWS;
          pg8::Gemm g{WSP(bf16_t, WS_MIX), WSP(bf16_t, WS_WOUTT) + (size_t)l * DM * DM, Mrows, DM, DM}; pg8::StaticOrder S; S.init(Mrows, DM, nb, bid);
          pg8::EpiResid E{l == 0 ? p.x : WSP(float, WS_XW), l == 0 ? p.ctx : WSP(float, WS_XW) + (size_t)ROWS_L * DM, WSP(float, WS_XW), WSP(float, WS_MOD) + (size_t)l * 5 * 6144 + 4096};
          pg8::gemm_phase<pg8::EpiResid, pg8::StaticOrder, true, true>((PG8_LAS unsigned char*)sm, g, S, E); } break;
    case PH_FINAL: ph_final(p, bid, nb); break;
    }
}

#if ONE_LAUNCH
__global__ void __launch_bounds__(NT, 2) mega_fwd(Params p) {
    extern __shared__ __attribute__((aligned(16))) unsigned char lds[];
    cg::grid_group grid = cg::this_grid();
    float* sm = (float*)lds; const int bid = blockIdx.x, nb = gridDim.x;
    run_phase(p, PH_ADALN, 0, bid, nb, sm);
#pragma unroll 1
    for (int l = 0; l < DEPTH; ++l) {
        grid.sync(); run_phase(p, PH_1, l, bid, nb, sm);
        grid.sync(); run_phase(p, PH_2, l, bid, nb, sm);
        grid.sync(); run_phase(p, PH_3, l, bid, nb, sm);
        grid.sync(); run_phase(p, PH_4, l, bid, nb, sm);
        grid.sync(); run_phase(p, PH_5, l, bid, nb, sm);
        grid.sync(); run_phase(p, PH_6, l, bid, nb, sm);
        grid.sync(); run_phase(p, PH_7, l, bid, nb, sm);
    }
    grid.sync();
    run_phase(p, PH_FINAL, 0, bid, nb, sm);
}
#else
__global__ void __launch_bounds__(NT) k_phase(Params p, int ph, int l) {
    extern __shared__ __attribute__((aligned(16))) unsigned char lds[];
    run_phase(p, ph, l, blockIdx.x, gridDim.x, (float*)lds);
}
#endif

extern "C" void kernel_launch(void* const* d_in, const int* in_sizes, int n_in, void* d_out, int out_size, void* d_ws, size_t ws_size, hipStream_t stream) {
    if (n_in != 25 || ws_size < WS_END) { fprintf(stderr, "kernel_launch: bad inputs (n_in %d, ws %zu < %zu)\n", n_in, ws_size, (size_t)WS_END); return; }
    Params p{};
    const float** pp = (const float**)&p;
    for (int i = 0; i < 25; ++i) pp[i] = (const float*)d_in[i];
    p.out = (float*)d_out; p.ws = (unsigned char*)d_ws;
#if ONE_LAUNCH
    static int grid = 0;
    if (!grid) {
        int dev = 0, cus = 0, per_cu = 0;
        hipGetDevice(&dev); hipDeviceGetAttribute(&cus, hipDeviceAttributeMultiprocessorCount, dev);
        hipFuncSetAttribute((const void*)mega_fwd, hipFuncAttributeMaxDynamicSharedMemorySize, LDS_BYTES);
        hipOccupancyMaxActiveBlocksPerMultiprocessor(&per_cu, (const void*)mega_fwd, NT, LDS_BYTES);
        if (per_cu < 1) per_cu = 1;
        grid = cus * 1;
    }
    void* args[] = {&p};
    hipError_t e = hipLaunchCooperativeKernel((const void*)mega_fwd, dim3(grid), dim3(NT), args, LDS_BYTES, stream);
    if (e != hipSuccess) fprintf(stderr, "cooperative launch failed: %s (grid %d)\n", hipGetErrorString(e), grid);
#else
    static int init = 0;
    if (!init) { hipFuncSetAttribute((const void*)k_phase, hipFuncAttributeMaxDynamicSharedMemorySize, LDS_BYTES); init = 1; }
    const int G = 1024;
    k_phase<<<G, NT, LDS_BYTES, stream>>>(p, PH_ADALN, 0);
    for (int l = 0; l < DEPTH; ++l)
        for (int ph = PH_1; ph <= PH_7; ++ph) k_phase<<<G, NT, LDS_BYTES, stream>>>(p, ph, l);
    k_phase<<<G, NT, LDS_BYTES, stream>>>(p, PH_FINAL, 0);
#endif
}
```

```cpp
#include <hip/hip_runtime.h>
#include <hip/hip_cooperative_groups.h>
#include <cstdio>
#include <cstdint>
namespace cg = cooperative_groups;

#ifndef ONE_LAUNCH
#define ONE_LAUNCH 1
#endif

constexpr int DM = 2048, NB = 4, SEQ = 2048, DEPTH = 4, CTXL = 256;
constexpr int HYW = 512, NH = 8, QRANK = 512, KVRANK = 256, POOLW = 512;
constexpr int OFF_HY_G = 1536, OFF_Q = 2048, OFF_KV = 2560, OFF_KR = 2816, OFF_MLA_G = 2880, OFF_POOL = 3904, OFF_POOL_G = 4416, NIN = 4928;
constexpr int ROWS_L = NB * SEQ, ROWS_C = NB * CTXL, ROWS = ROWS_L + ROWS_C;
constexpr int LK = SEQ + CTXL;
constexpr float EPS = 1e-6f;
constexpr float ATTN_SCALE = 0.07216878364870322f;
constexpr int NT = 512;
constexpr int NINP = 5120;

typedef unsigned short bf16_t;
typedef bf16_t act_t;

struct Params {
    const float *x, *c, *ctx, *c_ctx, *norm_g, *w_ada, *b_ada, *w_in, *hy_conv_w, *hy_conv_b, *hf_w1, *hf_b1, *hf_freq, *hf_w2, *hf_b2, *hf_w3, *hy_bias,
        *q_norm_g, *w_uq, *kv_norm_g, *w_ukv, *w_pool, *pool_scale, *w_out, *final_norm_g;
    float* out; unsigned char* ws;
};

constexpr size_t al256(size_t x) { return (x + 255) / 256 * 256; }
constexpr size_t WS_MOD = 0;
constexpr size_t WS_FSCL = WS_MOD + al256((size_t)4 * 5 * 6144 * 4);
constexpr size_t WS_FL = WS_FSCL + al256((size_t)2 * 2 * 512 * 4);
constexpr size_t WS_FC = WS_FL + al256((size_t)2 * 2 * 2048 * 512 * 4);
constexpr size_t WS_HA = WS_FC + al256((size_t)2 * 2 * 256 * 512 * 4);
constexpr size_t WS_KVRAW = WS_HA;
constexpr size_t WS_U = WS_HA + al256((size_t)ROWS * 2048 * sizeof(act_t));
constexpr size_t WS_QN = WS_U + al256((size_t)ROWS * NIN * sizeof(act_t));
constexpr size_t WS_KVN = WS_QN + al256((size_t)ROWS * 512 * sizeof(act_t));
constexpr size_t WS_QRAW = WS_KVN + al256((size_t)ROWS * 256 * sizeof(act_t));
constexpr size_t WS_Q = WS_QRAW + al256((size_t)ROWS * 1536 * sizeof(act_t));
constexpr size_t WS_KB = WS_Q + al256((size_t)NB * NH * LK * 192 * sizeof(act_t));
constexpr size_t WS_VB = WS_KB + al256((size_t)NB * NH * LK * 192 * sizeof(act_t));
constexpr size_t WS_HC = WS_VB + al256((size_t)NB * NH * LK * 128 * sizeof(act_t));
constexpr size_t WS_Z2 = WS_HC + al256((size_t)ROWS * 1536 * sizeof(act_t));
constexpr size_t WS_PD = WS_Z2 + al256((size_t)ROWS * 512 * sizeof(act_t));
constexpr size_t WS_PY = WS_PD + al256((size_t)ROWS * 512 * sizeof(act_t));
constexpr size_t WS_MIX = WS_PY + al256((size_t)ROWS * 512 * sizeof(act_t));
constexpr size_t WS_XW = WS_MIX + al256((size_t)ROWS * 2048 * sizeof(act_t));
constexpr size_t WS_WINT = WS_XW + al256((size_t)ROWS * 2048 * 4);
constexpr size_t WS_WOUTT = WS_WINT + al256((size_t)DEPTH * NINP * DM * 2);
constexpr size_t WS_WUQT = WS_WOUTT + al256((size_t)DEPTH * DM * DM * 2);
constexpr size_t WS_WUKVT = WS_WUQT + al256((size_t)DEPTH * 1536 * 512 * 2);
constexpr size_t WS_WPBD = WS_WUKVT + al256((size_t)DEPTH * 2048 * 256 * 2);
constexpr size_t WS_UT = WS_WPBD + al256((size_t)DEPTH * 512 * 512 * 2);
constexpr size_t WS_HT = WS_UT + al256((size_t)2048 * ROWS_L * 2);
constexpr size_t WS_RHO = WS_HT + al256((size_t)512 * ROWS_L * 2);
constexpr size_t WS_END = WS_RHO + al256((size_t)2 * 512 * 4096 * 2);

constexpr int LDS_BYTES = 147456;

__device__ __forceinline__ float ldf(const float* p) { return *p; }
__device__ __forceinline__ void stf(float* p, float v) { *p = v; }
__device__ __forceinline__ float bf2f(bf16_t v) { return __uint_as_float((unsigned)v << 16); }
__device__ __forceinline__ bf16_t f2bf(float f) { const unsigned u = __float_as_uint(f); return (bf16_t)((u + 0x7fffu + ((u >> 16) & 1u)) >> 16); }
__device__ __forceinline__ float ldf(const bf16_t* p) { return bf2f(*p); }
__device__ __forceinline__ void stf(bf16_t* p, float v) { *p = f2bf(v); }
__device__ __forceinline__ float fsin(float x) { return __builtin_amdgcn_sinf(x * 0.15915494309189535f); }
__device__ __forceinline__ float fcos(float x) { return __builtin_amdgcn_cosf(x * 0.15915494309189535f); }
__device__ __forceinline__ float silu_f(float x) { return x / (1.f + expf(-x)); }
__device__ __forceinline__ float wave_sum(float v) {
#pragma unroll
    for (int o = 32; o > 0; o >>= 1) v += __shfl_xor(v, o);
    return v;
}
__device__ __forceinline__ float wave_max(float v) {
#pragma unroll
    for (int o = 32; o > 0; o >>= 1) v = fmaxf(v, __shfl_xor(v, o));
    return v;
}
struct RowInfo { int b, t, L, n, mr; };
__device__ __forceinline__ RowInfo rowinfo(int row) {
    RowInfo r;
    if (row < ROWS_L) { r.b = row >> 11; r.t = row & 2047; r.L = SEQ; r.n = r.t; r.mr = r.b; }
    else { const int q = row - ROWS_L; r.b = q >> 8; r.t = q & 255; r.L = CTXL; r.n = SEQ + r.t; r.mr = 4; }
    return r;
}
__device__ __forceinline__ const float* xin_row(const Params& p, int l, int row) {
    if (l == 0) return row < ROWS_L ? p.x + (size_t)row * DM : p.ctx + (size_t)(row - ROWS_L) * DM;
    return (const float*)(p.ws + WS_XW) + (size_t)row * DM;
}
#define WSP(T, off) ((T*)(p.ws + (off)))
__device__ __forceinline__ int otid() { int t = threadIdx.x; asm volatile("" : "+v"(t)); return t; }

__device__ void ph_adaln(const Params& p, int bid, int nb, float* sm) {
    const int TX = otid();
    for (int i = TX; i < 5 * DM; i += NT) { const int r = i >> 11, k = i & 2047; sm[i] = silu_f(r < 4 ? p.c[r * DM + k] : p.c_ctx[k]); }
    __syncthreads();
    float* MOD = WSP(float, WS_MOD);
    for (int idx = bid * NT + TX; idx < DEPTH * 6144; idx += nb * NT) {
        const int l = idx / 6144, n = idx % 6144;
        const float* W = p.w_ada + (size_t)l * DM * 6144 + n;
        float a0 = 0, a1 = 0, a2 = 0, a3 = 0, a4 = 0;
        for (int k = 0; k < DM; ++k) { const float w = W[(size_t)k * 6144]; a0 += sm[k] * w; a1 += sm[2048 + k] * w; a2 += sm[4096 + k] * w; a3 += sm[6144 + k] * w; a4 += sm[8192 + k] * w; }
        const float bb = p.b_ada[l * 6144 + n];
        MOD[(l * 5 + 0) * 6144 + n] = a0 + bb; MOD[(l * 5 + 1) * 6144 + n] = a1 + bb; MOD[(l * 5 + 2) * 6144 + n] = a2 + bb;
        MOD[(l * 5 + 3) * 6144 + n] = a3 + bb; MOD[(l * 5 + 4) * 6144 + n] = a4 + bb;
    }
    __syncthreads();
}

__device__ void ph_filter(const Params& p, int l, int bid, int nb, float* sm) {
    const int TX = otid();
    float* feats = sm; float* h1 = sm + 64; float* h2 = sm + 128;
    const int tid = TX;
    const float DA = -3.0701134573253944f, DB = -15.350567286626973f;
    for (int u = bid; u < SEQ + CTXL; u += nb) {
        const int Lidx = u < SEQ ? 0 : 1, L = Lidx ? CTXL : SEQ, pos = Lidx ? u - SEQ : u;
        const float t = (float)pos / (float)(L - 1), wpos = (6.283185307179586f / (float)L) * (float)pos;
        if (tid < 33) {
            float f;
            if (tid == 0) f = t;
            else { const int i = (tid - 1) & 15; const float band = 1e-4f + (float)i * ((15.f - 1e-4f) / 15.f); const float a = band * wpos; f = (tid <= 16) ? fcos(a) : -fsin(a); }
            feats[tid] = f;
        }
        __syncthreads();
        if (tid < 64) { float s = p.hf_b1[l * 64 + tid];
_Pragma("unroll 4")
            for (int e = 0; e < 33; ++e) s += feats[e] * p.hf_w1[(l * 33 + e) * 64 + tid]; h1[tid] = fsin(p.hf_freq[l * 64 + tid] * s); }
        __syncthreads();
        if (tid < 64) { float s = p.hf_b2[l * 64 + tid];
_Pragma("unroll 4")
            for (int i = 0; i < 64; ++i) s += h1[i] * p.hf_w2[(l * 64 + i) * 64 + tid]; h2[tid] = fsin(p.hf_freq[l * 64 + tid] * s); }
        __syncthreads();
        float* F = Lidx ? WSP(float, WS_FC) : WSP(float, WS_FL);
        for (int n = tid; n < 2048; n += NT) {
            float s = 0;
_Pragma("unroll 8")
            for (int j = 0; j < 64; ++j) s += h2[j] * p.hf_w3[((size_t)l * 64 + j) * 2048 + n];
            const int o = n >> 10, d = (n >> 9) & 1, c = n & 511;
            const float delta = fabsf(DA + (float)c * ((DB - DA) / 511.f));
            s *= expf(-t * delta);
            F[(((size_t)o * 2 + d) * L + pos) * 512 + c] = s;
        }
        __syncthreads();
    }
}
__device__ void ph_fscale(const Params& p, int bid, int nb) {
    const int TX = otid();
    float* FS = WSP(float, WS_FSCL);
    for (int idx = bid * NT + TX; idx < 2048; idx += nb * NT) {
        const int Lidx = idx >> 10, o = (idx >> 9) & 1, c = idx & 511, L = Lidx ? CTXL : SEQ;
        const float* F = Lidx ? WSP(float, WS_FC) : WSP(float, WS_FL);
        float s = 0;
        for (int pos = 0; pos < L; ++pos) {
            const float a = F[(((size_t)o * 2 + 0) * L + pos) * 512 + c]; s += a * a;
            if (pos >= 1) { const float b2 = F[(((size_t)o * 2 + 1) * L + pos) * 512 + c]; s += b2 * b2; }
        }
        FS[idx] = rsqrtf(s + EPS);
    }
}

__device__ void ph_norm(const Params& p, int l, int bid, int nb) {
    const int TX = otid();
    const int lane = TX & 63, wid = TX >> 6, nw = NT >> 6;
    const float* MOD = WSP(float, WS_MOD); act_t* HA = WSP(act_t, WS_HA);
    for (int row = bid * nw + wid; row < ROWS; row += nb * nw) {
        const RowInfo r = rowinfo(row);
        const float* xr = xin_row(p, l, row);
        float ss = 0;
#pragma unroll 2
        for (int j = 0; j < 8; ++j) { const float4 v = *(const float4*)(xr + (j * 64 + lane) * 4); ss += v.x * v.x + v.y * v.y + v.z * v.z + v.w * v.w; }
        ss = wave_sum(ss);
        const float rstd = rsqrtf(ss * (1.f / DM) + EPS);
        const float* g = p.norm_g + l * DM; const float* sh = MOD + (size_t)(l * 5 + r.mr) * 6144; const float* sc = sh + 2048;
#pragma unroll 1
        for (int j = 0; j < 8; ++j) {
            const int k = (j * 64 + lane) * 4;
            const float4 v = *(const float4*)(xr + k);
            const float e[4] = {v.x, v.y, v.z, v.w};
#pragma unroll
            for (int q = 0; q < 4; ++q) stf(HA + (size_t)row * DM + k + q, e[q] * rstd * g[k + q] * (1.f + sc[k + q]) + sh[k + q]);
        }
    }
}

template <int EPI>
__device__ void gemm_naive(const Params& p, int l, const act_t* A, int lda, const float* B, int ldb, act_t* C, int ldc, int M, int N, int K, int bid, int nb, float* sm) {
    const int TX = otid();
    float* As = sm; float* Bs = sm + 16 * 132;
    const int tid = TX, tx = tid & 15, ty = tid >> 4;
    const int tilesN = N / 64, tiles = (M / 128) * tilesN;
    for (int tile = bid; tile < tiles; tile += nb) {
        const int m0 = (tile / tilesN) * 128, n0 = (tile % tilesN) * 64;
        float acc[4][4];
#pragma unroll
        for (int i = 0; i < 4; ++i)
#pragma unroll
            for (int j = 0; j < 4; ++j) acc[i][j] = 0.f;
        for (int k0 = 0; k0 < K; k0 += 16) {
            { const int r = tid >> 2, kq = (tid & 3) * 4; const act_t* ap = A + (size_t)(m0 + r) * lda + k0 + kq;
              As[(kq + 0) * 132 + r] = ldf(ap); As[(kq + 1) * 132 + r] = ldf(ap + 1); As[(kq + 2) * 132 + r] = ldf(ap + 2); As[(kq + 3) * 132 + r] = ldf(ap + 3); }
            { const int kk = tid >> 5, nn = (tid & 31) * 2; const float* bp = B + (size_t)(k0 + kk) * ldb + n0 + nn; Bs[kk * 64 + nn] = bp[0]; Bs[kk * 64 + nn + 1] = bp[1]; }
            __syncthreads();
#pragma unroll
            for (int kk = 0; kk < 16; ++kk) {
                const float4 a = *(const float4*)&As[kk * 132 + ty * 4]; const float4 b = *(const float4*)&Bs[kk * 64 + tx * 4];
                const float av[4] = {a.x, a.y, a.z, a.w}, bv[4] = {b.x, b.y, b.z, b.w};
#pragma unroll
                for (int i = 0; i < 4; ++i)
#pragma unroll
                    for (int j = 0; j < 4; ++j) acc[i][j] += av[i] * bv[j];
            }
            __syncthreads();
        }
#pragma unroll
        for (int i = 0; i < 4; ++i) {
            const int m = m0 + ty * 4 + i;
            if (EPI == 0) {
#pragma unroll
                for (int j = 0; j < 4; ++j) stf(C + (size_t)m * ldc + n0 + tx * 4 + j, acc[i][j]);
            } else {
                const RowInfo r = rowinfo(m);
                const float* xr = xin_row(p, l, m);
                const float* gate = WSP(float, WS_MOD) + (size_t)(l * 5 + r.mr) * 6144 + 4096;
                float* XW = WSP(float, WS_XW) + (size_t)m * DM;
#pragma unroll
                for (int j = 0; j < 4; ++j) { const int n = n0 + tx * 4 + j; XW[n] = xr[n] + gate[n] * acc[i][j]; }
            }
        }
    }
}

__device__ void ph_rms_small(const Params& p, int l, int bid, int nb) {
    const int TX = otid();
    const int lane = TX & 63, wid = TX >> 6, nw = NT >> 6;
    const act_t* U = WSP(act_t, WS_U); act_t* QN = WSP(act_t, WS_QN); act_t* KVN = WSP(act_t, WS_KVN);
    for (int row = bid * nw + wid; row < ROWS; row += nb * nw) {
        const act_t* ur = U + (size_t)row * NIN;
        float q[8]; float ss = 0;
#pragma unroll
        for (int j = 0; j < 8; ++j) { q[j] = ldf(ur + OFF_Q + j * 64 + lane); ss += q[j] * q[j]; }
        ss = wave_sum(ss); float rstd = rsqrtf(ss * (1.f / QRANK) + EPS);
#pragma unroll
        for (int j = 0; j < 8; ++j) stf(QN + (size_t)row * 512 + j * 64 + lane, q[j] * rstd * p.q_norm_g[l * 512 + j * 64 + lane]);
        float kv[4]; ss = 0;
#pragma unroll
        for (int j = 0; j < 4; ++j) { kv[j] = ldf(ur + OFF_KV + j * 64 + lane); ss += kv[j] * kv[j]; }
        ss = wave_sum(ss); rstd = rsqrtf(ss * (1.f / KVRANK) + EPS);
#pragma unroll
        for (int j = 0; j < 4; ++j) stf(KVN + (size_t)row * 256 + j * 64 + lane, kv[j] * rstd * p.kv_norm_g[l * 256 + j * 64 + lane]);
    }
}
__device__ void ph_shortconv(const Params& p, int l, int bid, int nb) {
    const int TX = otid();
    const act_t* U = WSP(act_t, WS_U); act_t* HC = WSP(act_t, WS_HC);
    const float* w = p.hy_conv_w + (size_t)l * 3 * 1536; const float* bb = p.hy_conv_b + l * 1536;
    for (size_t idx = (size_t)bid * NT + TX; idx < (size_t)ROWS_C * 1536; idx += (size_t)nb * NT) {
        const int row = ROWS_L + (int)(idx / 1536), c = (int)(idx % 1536);
        const RowInfo r = rowinfo(row);
        const float cur = ldf(U + (size_t)row * NIN + c);
        const float prev = r.t > 0 ? ldf(U + (size_t)(row - 1) * NIN + c) : 0.f;
        const float next = r.t < r.L - 1 ? ldf(U + (size_t)(row + 1) * NIN + c) : 0.f;
        stf(HC + (size_t)row * 1536 + c, prev * w[c] + cur * w[1536 + c] + next * w[3072 + c] + bb[c]);
    }
}
__device__ void ph_pooldiff(const Params& p, int bid, int nb) {
    const int TX = otid();
    const act_t* U = WSP(act_t, WS_U); act_t* PD = WSP(act_t, WS_PD);
    for (size_t idx = (size_t)bid * NT + TX; idx < (size_t)ROWS * 512; idx += (size_t)nb * NT) {
        const int row = (int)(idx >> 9), j = (int)(idx & 511);
        const RowInfo r = rowinfo(row);
        const int half = 1 << (j >> 7);
        const int lo = max(r.t - half, 0), hi = min(r.t + half, r.L);
        float s = 0;
        for (int q = lo; q < hi; ++q) s += ldf(U + (size_t)(row - r.t + q) * NIN + OFF_POOL + j);
        stf(PD + idx, s / (float)(hi - lo) - ldf(U + (size_t)row * NIN + OFF_POOL + j));
    }
}
__device__ void ph_poolgate(const Params& p, int l, int bid, int nb) {
    const int TX = otid();
    const act_t* U = WSP(act_t, WS_U); const act_t* PY = WSP(act_t, WS_PY); act_t* MIX = WSP(act_t, WS_MIX);
    for (size_t idx = (size_t)bid * NT + TX; idx < (size_t)ROWS * 512; idx += (size_t)nb * NT) {
        const int row = (int)(idx >> 9), j = (int)(idx & 511);
        stf(MIX + (size_t)row * DM + 1536 + j, ldf(PY + idx) * p.pool_scale[l * 512 + j] * silu_f(ldf(U + (size_t)row * NIN + OFF_POOL_G + j)));
    }
}
__device__ void ph_pack_qkv(const Params& p, int bid, int nb) {
    const int TX = otid();
    const act_t* U = WSP(act_t, WS_U); const act_t* QR = WSP(act_t, WS_QRAW); const act_t* KVR = WSP(act_t, WS_KVRAW);
    act_t* Q = WSP(act_t, WS_Q); act_t* KB = WSP(act_t, WS_KB); act_t* VB = WSP(act_t, WS_VB);
    for (size_t idx = (size_t)bid * NT + TX; idx < (size_t)ROWS * NH * 128; idx += (size_t)nb * NT) {
        const int d = (int)(idx & 127), h = (int)((idx >> 7) & 7), row = (int)(idx >> 10);
        const RowInfo r = rowinfo(row);
        const size_t pos = (size_t)(r.b * NH + h) * LK + r.n;
        stf(Q + pos * 192 + d, ldf(QR + (size_t)row * 1536 + h * 192 + d));
        stf(KB + pos * 192 + d, ldf(KVR + (size_t)row * 2048 + h * 256 + d));
        stf(VB + pos * 128 + d, ldf(KVR + (size_t)row * 2048 + h * 256 + 128 + d));
    }
    for (size_t idx = (size_t)bid * NT + TX; idx < (size_t)ROWS * NH * 32; idx += (size_t)nb * NT) {
        const int i = (int)(idx & 31), h = (int)((idx >> 5) & 7), row = (int)(idx >> 8);
        const RowInfo r = rowinfo(row);
        const size_t pos = (size_t)(r.b * NH + h) * LK + r.n;
        float cs = 1.f, sn = 0.f;
        if (row < ROWS_L) {
            const float inv = expf(-(float)(i & 15) * (9.210340371976184f / 16.f));
            const float ang = (float)(i < 16 ? (r.t >> 6) : (r.t & 63)) * inv;
            cs = fcos(ang); sn = fsin(ang);
        }
        const float q0 = ldf(QR + (size_t)row * 1536 + h * 192 + 128 + 2 * i), q1 = ldf(QR + (size_t)row * 1536 + h * 192 + 128 + 2 * i + 1);
        stf(Q + pos * 192 + 128 + 2 * i, q0 * cs - q1 * sn); stf(Q + pos * 192 + 128 + 2 * i + 1, q0 * sn + q1 * cs);
        const float k0 = ldf(U + (size_t)row * NIN + OFF_KR + 2 * i), k1 = ldf(U + (size_t)row * NIN + OFF_KR + 2 * i + 1);
        stf(KB + pos * 192 + 128 + 2 * i, k0 * cs - k1 * sn); stf(KB + pos * 192 + 128 + 2 * i + 1, k0 * sn + k1 * cs);
    }
}

__device__ void ph_attn(const Params& p, int l, int bid, int nb, float* sm) {
    const int TX = otid();
    float* S = sm; float* qs = sm + 8 * LK; float* linv = qs + 8 * 192;
    const int tid = TX, lane = tid & 63, wid = tid >> 6;
    const act_t* Q = WSP(act_t, WS_Q); const act_t* KB = WSP(act_t, WS_KB); const act_t* VB = WSP(act_t, WS_VB); const act_t* U = WSP(act_t, WS_U); act_t* MIX = WSP(act_t, WS_MIX);
    const int nlat = NB * NH * (SEQ / 8), nctx = (l < DEPTH - 1) ? NB * NH * (CTXL / 8) : 0;
    for (int u = bid; u < nlat + nctx; u += nb) {
        int b, h, q0, k0, nk;
        if (u < nlat) { b = u >> 11; h = (u >> 8) & 7; q0 = (u & 255) * 8; k0 = 0; nk = LK; }
        else { const int v = u - nlat; b = v >> 8; h = (v >> 5) & 7; q0 = SEQ + (v & 31) * 8; k0 = SEQ; nk = CTXL; }
        const size_t hb = (size_t)(b * NH + h) * LK;
        const act_t* Qp = Q + (hb + q0) * 192; const act_t* Kp = KB + (hb + k0) * 192; const act_t* Vp = VB + (hb + k0) * 128;
        for (int i = tid; i < 8 * 192; i += NT) qs[i] = ldf(Qp + i);
        __syncthreads();
        for (int kk = tid; kk < nk; kk += NT) {
            float acc[8];
#pragma unroll
            for (int i = 0; i < 8; ++i) acc[i] = 0.f;
            const act_t* kr = Kp + (size_t)kk * 192;
            for (int d = 0; d < 192; ++d) { const float kv = ldf(kr + d);
#pragma unroll
                for (int i = 0; i < 8; ++i) acc[i] += kv * qs[i * 192 + d]; }
#pragma unroll
            for (int i = 0; i < 8; ++i) S[i * LK + kk] = acc[i] * ATTN_SCALE;
        }
        __syncthreads();
        { float* row = S + wid * LK; float m = -INFINITY;
          for (int kk = lane; kk < nk; kk += 64) m = fmaxf(m, row[kk]);
          m = wave_max(m); float s = 0;
          for (int kk = lane; kk < nk; kk += 64) { const float e = expf(row[kk] - m); row[kk] = e; s += e; }
          s = wave_sum(s); if (lane == 0) linv[wid] = 1.f / s; }
        __syncthreads();
        { const int d = tid & 127, qg = tid >> 7; float o0 = 0, o1 = 0; const float* s0 = S + (2 * qg) * LK; const float* s1 = s0 + LK;
          for (int kk = 0; kk < nk; ++kk) { const float v = ldf(Vp + (size_t)kk * 128 + d); o0 += s0[kk] * v; o1 += s1[kk] * v; }
#pragma unroll
          for (int e = 0; e < 2; ++e) { const int qi = 2 * qg + e, n = q0 + qi; const int row = n < SEQ ? b * SEQ + n : ROWS_L + b * CTXL + (n - SEQ);
              const float g = ldf(U + (size_t)row * NIN + OFF_MLA_G + h * 128 + d);
              stf(MIX + (size_t)row * DM + 512 + h * 128 + d, (e ? o1 : o0) * linv[qi] * silu_f(g)); } }
        __syncthreads();
    }
}

__device__ void ph_conv(const Params& p, int l, int order, int bid, int nb, float* sm) {
    const int TX = otid();
    float* Zs = sm; float* Ks = sm + 4096;
    const int tid = TX, c = tid & 63, tg = tid >> 6;
    const act_t* U = WSP(act_t, WS_U); const act_t* HC = WSP(act_t, WS_HC); act_t* Z2 = WSP(act_t, WS_Z2); act_t* MIX = WSP(act_t, WS_MIX);
    const act_t* zsrc = order == 0 ? HC : Z2; const int zld = order == 0 ? 1536 : 512;
    const int nlat = NB * (SEQ / 64) * 8, nctx = (l < DEPTH - 1) ? NB * (CTXL / 64) * 8 : 0;
    for (int u = nlat + bid; u < nlat + nctx; u += nb) {
        int Lidx, b, T0, c0, L, rowbase;
        if (u < nlat) { Lidx = 0; L = SEQ; b = u >> 8; T0 = ((u >> 3) & 31) * 64; c0 = (u & 7) * 64; rowbase = b * SEQ; }
        else { const int v = u - nlat; Lidx = 1; L = CTXL; b = v >> 5; T0 = ((v >> 3) & 3) * 64; c0 = (v & 7) * 64; rowbase = ROWS_L + b * CTXL; }
        const float* F = (Lidx ? WSP(float, WS_FC) : WSP(float, WS_FL)) + (size_t)order * 2 * L * 512;
        float acc[8];
#pragma unroll
        for (int i = 0; i < 8; ++i) acc[i] = 0.f;
        for (int S0 = 0; S0 < L; S0 += 64) {
            for (int i = tid; i < 4096; i += NT) { const int ss = i >> 6, cc = i & 63; Zs[i] = ldf(zsrc + (size_t)(rowbase + S0 + ss) * zld + c0 + cc); }
            for (int i = tid; i < 127 * 64; i += NT) { const int j = i >> 6, cc = i & 63; const int n = T0 - S0 + j - 63;
                Ks[i] = n >= 0 ? F[((size_t)0 * L + n) * 512 + c0 + cc] : F[((size_t)1 * L + (-n)) * 512 + c0 + cc]; }
            __syncthreads();
            for (int ss = 0; ss < 64; ++ss) { const float z = Zs[ss * 64 + c];
#pragma unroll
                for (int i = 0; i < 8; ++i) acc[i] += z * Ks[(tg * 8 + i - ss + 63) * 64 + c]; }
            __syncthreads();
        }
        const float scl = WSP(float, WS_FSCL)[(Lidx * 2 + order) * 512 + c0 + c], bias = p.hy_bias[(l * 2 + order) * 512 + c0 + c];
#pragma unroll
        for (int i = 0; i < 8; ++i) {
            const int row = rowbase + T0 + tg * 8 + i;
            const float zt = ldf(zsrc + (size_t)row * zld + c0 + c);
            const float y = scl * acc[i] + bias * zt;
            if (order == 0) stf(Z2 + (size_t)row * 512 + c0 + c, ldf(HC + (size_t)row * 1536 + 512 + c0 + c) * y);
            else stf(MIX + (size_t)row * DM + c0 + c, ldf(HC + (size_t)row * 1536 + 1024 + c0 + c) * y * silu_f(ldf(U + (size_t)row * NIN + OFF_HY_G + c0 + c)));
        }
    }
}

__device__ void ph_final(const Params& p, int bid, int nb) {
    const int TX = otid();
    const int lane = TX & 63, wid = TX >> 6, nw = NT >> 6;
    for (int row = bid * nw + wid; row < ROWS_L; row += nb * nw) {
        const float* xr = WSP(float, WS_XW) + (size_t)row * DM;
        float ss = 0;
#pragma unroll 2
        for (int j = 0; j < 8; ++j) { const float4 v = *(const float4*)(xr + (j * 64 + lane) * 4); ss += v.x * v.x + v.y * v.y + v.z * v.z + v.w * v.w; }
        ss = wave_sum(ss);
        const float rstd = rsqrtf(ss * (1.f / DM) + EPS);
#pragma unroll 1
        for (int j = 0; j < 8; ++j) { const int k = (j * 64 + lane) * 4; const float4 v = *(const float4*)(xr + k); const float4 g = *(const float4*)(p.final_norm_g + k);
            *(float4*)(p.out + (size_t)row * DM + k) = make_float4(v.x * rstd * g.x, v.y * rstd * g.y, v.z * rstd * g.z, v.w * rstd * g.w); }
    }
}

namespace pg8 {
#define PG8_LAS __attribute__((address_space(3)))
typedef unsigned short bf16_t;
typedef short bf16x8 __attribute__((ext_vector_type(8)));
typedef float f32x4 __attribute__((ext_vector_type(4)));
typedef unsigned u32x4 __attribute__((ext_vector_type(4)));
constexpr int BM = 256, BK = 64, HALF = 128, HTB = HALF * BK * 2  , STAGE_BYTES = 8 * HTB, NXCD = 8, WGM = 8;

__host__ __device__ __forceinline__ int lds_byte(int r, int c) { const int st = (r >> 4) * 2 + (c >> 5), rr = r & 15, cc = c & 31, ob = rr * 64 + cc * 2; return st * 1024 + (ob ^ (((ob >> 9) & 1) << 5)); }
__host__ __device__ __forceinline__ void stage_rc(int b, int& R, int& C) { const int st = b / 1024, sb = b % 1024, swz = sb ^ (((sb >> 9) & 1) << 5); R = (st >> 1) * 16 + swz / 64; C = (st & 1) * 32 + (swz % 64) / 2; }
__host__ __device__ __forceinline__ int perm32(int rho) { const int n = rho >> 4, i = rho & 15; return 8 * (i >> 2) + 4 * n + (i & 3); }

struct Unit { int pm, pn; };
struct Gemm { const bf16_t* A; const bf16_t* Bt; int M, N, K; };

struct StaticOrder {
    int nM, nN, nwg, G, c;
    __host__ __device__ void init(int M, int N, int G_, int c_) { nM = M / BM; nN = N / BM; nwg = nM * nN; G = G_; c = c_; }
    __host__ __device__ bool next(int i, Unit& u) const {
        const long L = (long)i * G + c; if (L >= nwg) return false;
        int wgid = (int)L; { const int q = nwg / NXCD, r = nwg % NXCD, xcd = wgid % NXCD, off = wgid / NXCD; wgid = (xcd < r ? xcd * (q + 1) : r * (q + 1) + (xcd - r) * q) + off; }
        const int nig = WGM * nN, gid = wgid / nig, fm = gid * WGM, gsz = (nM - fm) < WGM ? (nM - fm) : WGM;
        u.pm = fm + ((wgid % nig) % gsz); u.pn = (wgid % nig) / gsz; return true;
    }
    __device__ __forceinline__ void a_ready(const Unit&) const {}
    __device__ __forceinline__ void done(const Unit&) const {}
};

__device__ __forceinline__ unsigned cvt_pk_bf16(float lo, float hi) { unsigned r; asm volatile("v_cvt_pk_bf16_f32 %0, %1, %2" : "=v"(r) : "v"(lo), "v"(hi)); return r; }

typedef unsigned u32x4_t __attribute__((ext_vector_type(4)));
struct EpiStoreBf16 {
    static constexpr bool PERM = true, AFTER_DRAIN = false;
    bf16_t* O; int ldc; int ncols;
    __device__ __forceinline__ void operator()(const f32x4 (&acc)[2][2][4][2], const Unit& u, int wr, int wc, int fr, int fq) const {
        const int row0 = u.pm * BM + wr * 64 + fr, col0 = u.pn * BM + wc * 32 + 8 * fq;
#pragma unroll
        for (int ai = 0; ai < 2; ++ai)
#pragma unroll
            for (int m = 0; m < 4; ++m) { bf16_t* rowp = O + (size_t)(row0 + ai * HALF + m * 16) * ldc + col0;
#pragma unroll
                for (int bj = 0; bj < 2; ++bj) { if (col0 + bj * HALF < ncols) { const f32x4 v0 = acc[ai][bj][m][0], v1 = acc[ai][bj][m][1];
                    u32x4_t w; w.x = cvt_pk_bf16(v0[0], v0[1]); w.y = cvt_pk_bf16(v0[2], v0[3]); w.z = cvt_pk_bf16(v1[0], v1[1]); w.w = cvt_pk_bf16(v1[2], v1[3]);
                    *(u32x4_t*)(rowp + bj * HALF) = w; } } }
    }
};
struct EpiResid {
    static constexpr bool PERM = false, AFTER_DRAIN = false;
    const float* xl; const float* xc; float* XW; const float* gate;
    __device__ __forceinline__ void operator()(const f32x4 (&acc)[2][2][4][2], const Unit& u, int wr, int wc, int fr, int fq) const {
        const int col0 = u.pn * BM + wc * 32 + 4 * fq;
#pragma unroll
        for (int ai = 0; ai < 2; ++ai)
#pragma unroll
            for (int m = 0; m < 4; ++m) { const int row = u.pm * BM + ai * HALF + wr * 64 + m * 16 + fr;
                const float* xr = row < 8192 ? xl + (size_t)row * 2048 : xc + (size_t)(row - 8192) * 2048;
                const float* g = gate + (size_t)(row < 8192 ? (row >> 11) : 4) * 6144;
                float* o = XW + (size_t)row * 2048;
#pragma unroll
                for (int bj = 0; bj < 2; ++bj)
#pragma unroll
                    for (int n = 0; n < 2; ++n) { const int c = col0 + bj * HALF + n * 16;
                        const f32x4 xv = *(const f32x4*)(xr + c), gv = *(const f32x4*)(g + c);
                        *(f32x4*)(o + c) = xv + gv * acc[ai][bj][m][n]; } }
    }
};

template <class Epi, class Sched, bool ALIGN_EPI = false, bool SP2 = false>
__device__ __forceinline__ void gemm_phase(PG8_LAS unsigned char* lds, const Gemm g, const Sched& S, const Epi& E) {
    int tid_ = threadIdx.x; asm volatile("" : "+v"(tid_));
    const int tid = tid_, wid = __builtin_amdgcn_readfirstlane(tid >> 6), lane = tid & 63, wr = wid >> 2, wc = wid & 3, fr = lane & 15, fq = lane >> 4;
    const int K = g.K, nt = K / BK;
    unsigned voffA[2], voffB[2];
#pragma unroll
    for (int i = 0; i < 2; ++i) { int R, C; stage_rc(tid * 16 + i * 8192, R, C); const int Rb = Epi::PERM ? ((R & ~31) + perm32(R & 31)) : R;
        voffA[i] = (unsigned)(R * K + C) * 2u; voffB[i] = (unsigned)(Rb * K + C) * 2u; }
    const size_t kstep = (size_t)(BK * 2);
    const size_t hstep = (size_t)HALF * K * 2;
    const size_t tstep = 2 * hstep;
    const unsigned ldsw = (unsigned)wid * 1024u;
    const int aoff = lds_byte(wr * 64 + fr, fq * 8), boff = lds_byte(wc * 32 + fr, fq * 8);
#define PG8_SA(b, h) (((b) * 2 + (h)) * HTB)
#define PG8_SB(b, h) ((4 + (b) * 2 + (h)) * HTB)
#define PG8_STAGE(bufoff, gbase, voff) do { _Pragma("unroll") for (int _i = 0; _i < 2; ++_i) \
        __builtin_amdgcn_global_load_lds((const unsigned*)((const char*)(gbase) + (voff)[_i]), (PG8_LAS unsigned*)(lds + (bufoff) + ldsw + _i * 8192), 16, 0, 0); } while (0)
#define PG8_LDA(dst, b, h) do { _Pragma("unroll") for (int m = 0; m < 4; ++m) _Pragma("unroll") for (int k = 0; k < 2; ++k) dst[m][k] = *(const PG8_LAS bf16x8*)(lds + PG8_SA(b, h) + aoff + m * 2048 + k * 1024); } while (0)
#define PG8_LDB(dst, b, h) do { _Pragma("unroll") for (int n = 0; n < 2; ++n) _Pragma("unroll") for (int k = 0; k < 2; ++k) dst[n][k] = *(const PG8_LAS bf16x8*)(lds + PG8_SB(b, h) + boff + n * 2048 + k * 1024); } while (0)
#define PG8_MMA(ai, bj, At, Bt) do { __builtin_amdgcn_s_setprio(1); _Pragma("unroll") for (int m = 0; m < 4; ++m) _Pragma("unroll") for (int n = 0; n < 2; ++n) _Pragma("unroll") for (int k = 0; k < 2; ++k) \
        acc[ai][bj][m][n] = __builtin_amdgcn_mfma_f32_16x16x32_bf16(Bt[n][k], At[m][k], acc[ai][bj][m][n], 0, 0, 0); __builtin_amdgcn_s_setprio(0); } while (0)
#define PG8_WAIT_V(n) asm volatile("s_waitcnt vmcnt(" #n ")" ::: "memory")
#define PG8_WAIT_L(n) asm volatile("s_waitcnt lgkmcnt(" #n ")" ::: "memory")
#define PG8_BAR __builtin_amdgcn_s_barrier()
#define PG8_SCHED __builtin_amdgcn_sched_barrier(0)
    Unit cur, nxt; int ui = 0;
    if (!S.next(0, cur)) return;
    f32x4 acc[2][2][4][2];
#pragma unroll
    for (int a = 0; a < 2; ++a)
#pragma unroll
        for (int b = 0; b < 2; ++b)
#pragma unroll
            for (int m = 0; m < 4; ++m)
#pragma unroll
                for (int n = 0; n < 2; ++n) acc[a][b][m][n] = (f32x4){0.f, 0.f, 0.f, 0.f};
    bf16x8 At[4][2], B0[2][2], B1[2][2];
    const char* cA = (const char*)g.A + (size_t)cur.pm * tstep; const char* cB = (const char*)g.Bt + (size_t)cur.pn * tstep;
    S.a_ready(cur);
    if constexpr (SP2) {
        PG8_STAGE(PG8_SB(0, 0), cB, voffB); PG8_STAGE(PG8_SB(0, 1), cB + hstep, voffB); PG8_STAGE(PG8_SA(0, 0), cA, voffA); PG8_STAGE(PG8_SA(0, 1), cA + hstep, voffA);
        if (wr == 1) PG8_BAR;
        PG8_WAIT_V(2); PG8_BAR;
        PG8_STAGE(PG8_SB(1, 0), cB + kstep, voffB); PG8_STAGE(PG8_SA(1, 0), cA + kstep, voffA); PG8_STAGE(PG8_SB(1, 1), cB + hstep + kstep, voffB);
        PG8_WAIT_V(6); PG8_BAR;
    } else {
        PG8_STAGE(PG8_SB(0, 0), cB, voffB); PG8_STAGE(PG8_SA(0, 0), cA, voffA); PG8_STAGE(PG8_SB(0, 1), cB + hstep, voffB); PG8_STAGE(PG8_SA(0, 1), cA + hstep, voffA);
        if (wr == 1) PG8_BAR;
        PG8_WAIT_V(4); PG8_BAR;
        PG8_STAGE(PG8_SB(1, 0), cB + kstep, voffB); PG8_STAGE(PG8_SA(1, 0), cA + kstep, voffA); PG8_STAGE(PG8_SB(1, 1), cB + hstep + kstep, voffB);
        PG8_WAIT_V(6); PG8_BAR;
    }
    for (;;) {
        const bool has_next = S.next(ui + 1, nxt);
        const char* nA = has_next ? (const char*)g.A + (size_t)nxt.pm * tstep : cA; const char* nB = has_next ? (const char*)g.Bt + (size_t)nxt.pn * tstep : cB;
        for (int t = 0; t < nt; t += 2) {
            const bool last = (t == nt - 2);
            const char* a1 = cA + (size_t)(t + 1) * kstep;
            const char* a2 = last ? nA : cA + (size_t)(t + 2) * kstep; const char* b2 = last ? nB : cB + (size_t)(t + 2) * kstep;
            const char* a3 = a2 + kstep; const char* b3 = b2 + kstep;
            if (last && has_next) S.a_ready(nxt);
            if constexpr (SP2) {
            PG8_LDB(B0, 0, 0); PG8_LDB(B1, 0, 1); PG8_SCHED; PG8_LDA(At, 0, 0); PG8_STAGE(PG8_SA(1, 1), a1 + hstep, voffA);
            PG8_WAIT_V(8); PG8_WAIT_L(0); PG8_BAR; PG8_MMA(0, 0, At, B0); PG8_MMA(0, 1, At, B1); PG8_BAR; PG8_SCHED;
            PG8_LDA(At, 0, 1); PG8_STAGE(PG8_SB(0, 0), b2, voffB); PG8_STAGE(PG8_SB(0, 1), b2 + hstep, voffB); PG8_STAGE(PG8_SA(0, 0), a2, voffA);
            PG8_WAIT_V(8); PG8_WAIT_L(0); PG8_BAR; PG8_MMA(1, 0, At, B0); PG8_MMA(1, 1, At, B1); PG8_BAR; PG8_SCHED;
            PG8_LDB(B0, 1, 0); PG8_LDB(B1, 1, 1); PG8_SCHED; PG8_LDA(At, 1, 0); PG8_STAGE(PG8_SA(0, 1), a2 + hstep, voffA);
            PG8_WAIT_V(8); PG8_WAIT_L(0); PG8_BAR; PG8_MMA(0, 0, At, B0); PG8_MMA(0, 1, At, B1); PG8_BAR; PG8_SCHED;
            PG8_LDA(At, 1, 1); PG8_STAGE(PG8_SB(1, 0), b3, voffB); PG8_STAGE(PG8_SB(1, 1), b3 + hstep, voffB); PG8_STAGE(PG8_SA(1, 0), a3, voffA);
            PG8_WAIT_V(8); PG8_WAIT_L(0); PG8_BAR; PG8_MMA(1, 0, At, B0); PG8_MMA(1, 1, At, B1); PG8_BAR; PG8_SCHED;
            } else {
            PG8_LDB(B0, 0, 0); PG8_SCHED; PG8_LDA(At, 0, 0); PG8_STAGE(PG8_SA(1, 1), a1 + hstep, voffA);
            PG8_WAIT_L(8); PG8_BAR; PG8_WAIT_L(0); PG8_MMA(0, 0, At, B0); PG8_BAR; PG8_SCHED;
            PG8_LDB(B1, 0, 1); PG8_STAGE(PG8_SB(0, 0), b2, voffB);
            PG8_BAR; PG8_WAIT_L(0); PG8_MMA(0, 1, At, B1); PG8_BAR;
            PG8_LDA(At, 0, 1); PG8_STAGE(PG8_SA(0, 0), a2, voffA);
            PG8_BAR; PG8_WAIT_L(0); PG8_MMA(1, 0, At, B0); PG8_BAR; PG8_SCHED;
            PG8_STAGE(PG8_SB(0, 1), b2 + hstep, voffB);
            PG8_WAIT_V(6); PG8_BAR; PG8_MMA(1, 1, At, B1); PG8_BAR;
            PG8_LDB(B0, 1, 0); PG8_SCHED; PG8_LDA(At, 1, 0); PG8_STAGE(PG8_SA(0, 1), a2 + hstep, voffA);
            PG8_WAIT_L(8); PG8_BAR; PG8_WAIT_L(0); PG8_MMA(0, 0, At, B0); PG8_BAR; PG8_SCHED;
            PG8_LDB(B1, 1, 1); PG8_STAGE(PG8_SB(1, 0), b3, voffB);
            PG8_BAR; PG8_WAIT_L(0); PG8_MMA(0, 1, At, B1); PG8_BAR;
            PG8_LDA(At, 1, 1); PG8_STAGE(PG8_SA(1, 0), a3, voffA);
            PG8_BAR; PG8_WAIT_L(0); PG8_MMA(1, 0, At, B0); PG8_BAR; PG8_SCHED;
            PG8_STAGE(PG8_SB(1, 1), b3 + hstep, voffB);
            PG8_WAIT_V(6); PG8_BAR; PG8_MMA(1, 1, At, B1); PG8_BAR;
            }
        }
        if constexpr (ALIGN_EPI) { if (wr == 0) PG8_BAR; }
        if constexpr (!Epi::AFTER_DRAIN) { E(acc, cur, wr, wc, fr, fq); S.done(cur); }
        if (!has_next) break;
#pragma unroll
        for (int a = 0; a < 2; ++a)
#pragma unroll
            for (int b = 0; b < 2; ++b)
#pragma unroll
                for (int m = 0; m < 4; ++m)
#pragma unroll
                    for (int n = 0; n < 2; ++n) acc[a][b][m][n] = (f32x4){0.f, 0.f, 0.f, 0.f};
        cur = nxt; cA = nA; cB = nB; ++ui;
        if constexpr (ALIGN_EPI) { if (wr == 1) PG8_BAR; }
    }
    PG8_WAIT_V(0);
    if constexpr (!ALIGN_EPI) { if (wr == 0) PG8_BAR; }
    PG8_BAR;
    if constexpr (Epi::AFTER_DRAIN) { E.fused(acc, cur, wr, wc, fr, fq, lds, wid, lane); S.done(cur); }
#undef PG8_SA
#undef PG8_SB
#undef PG8_STAGE
#undef PG8_LDA
#undef PG8_LDB
#undef PG8_MMA
#undef PG8_WAIT_V
#undef PG8_WAIT_L
#undef PG8_BAR
#undef PG8_SCHED
}
}


namespace att {
using bf16x8 = __attribute__((ext_vector_type(8))) short;
using s16x4  = __attribute__((ext_vector_type(4))) short;
using f32x16 = __attribute__((ext_vector_type(16))) float;
using u32x4  = __attribute__((ext_vector_type(4))) unsigned;
constexpr int QBLK = 32, KVBLK = 64, NW = 8;
constexpr float SCALE = 0.07216878364870322f, THR = 8.f;
constexpr int SHM_V = 16384, SHM_KN = 16384, SHM_KR = 8192;
constexpr int OFF_V = 0, OFF_KN = 2 * SHM_V, OFF_KR = OFF_KN + 2 * SHM_KN, OFF_WS = OFF_KR + 2 * SHM_KR, OFF_QR = OFF_WS + NW * 64 * 4, SHM_TOTAL = OFF_QR + NW * 4096;
#define KSWZ(row, colB) ((row) * 256 + ((colB) ^ (((row) & 7) << 4)))
#define RSWZ(row, ch) ((row) * 128 + ((((ch) ^ (((row) >> 1) & 7))) << 4))
#define SBAR() __builtin_amdgcn_sched_barrier(0)
__device__ __forceinline__ int crow(int r, int hi) { return (r & 3) + 8 * (r >> 2) + 4 * hi; }
__device__ __forceinline__ unsigned cvtpk(float lo, float hi) { unsigned r; asm volatile("v_cvt_pk_bf16_f32 %0, %1, %2" : "=v"(r) : "v"(lo), "v"(hi)); return r; }
__device__ __forceinline__ bf16x8 ld8(const bf16_t* p) { return *reinterpret_cast<const bf16x8*>(p); }

__device__ __forceinline__ void partialSM(f32x16& p0, f32x16& p1, float& m_reg, float& mn, float& alpha) {
  constexpr float C = SCALE * 1.4426950408889634f;
  float pmax = p0[0];
#pragma unroll
  for (int r = 1; r < 16; ++r) pmax = fmaxf(pmax, p0[r]);
#pragma unroll
  for (int r = 0; r < 16; ++r) pmax = fmaxf(pmax, p1[r]);
  { auto rr = __builtin_amdgcn_permlane32_swap(__float_as_uint(pmax), __float_as_uint(pmax), false, false);
    pmax = fmaxf(__uint_as_float(rr[0]), __uint_as_float(rr[1])); }
  if (__builtin_expect(__all(pmax - m_reg <= THR / SCALE), 1)) { mn = m_reg; alpha = 1.f; }
  else { mn = fmaxf(m_reg, pmax); alpha = __builtin_amdgcn_exp2f((m_reg - mn) * C); m_reg = mn; }
  const float mnC = -mn * C;
#pragma unroll
  for (int r = 0; r < 16; ++r) p0[r] = fmaf(p0[r], C, mnC);
#pragma unroll
  for (int r = 0; r < 16; ++r) p1[r] = fmaf(p1[r], C, mnC);
#pragma unroll
  for (int r = 0; r < 16; ++r) p0[r] = __builtin_amdgcn_exp2f(p0[r]);
}
__device__ __forceinline__ void finishSM(f32x16& p0, f32x16& p1, float alpha, float& l_reg, bf16x8& pa0, bf16x8& pa1, bf16x8& pa2, bf16x8& pa3) {
#pragma unroll
  for (int r = 0; r < 16; ++r) p1[r] = __builtin_amdgcn_exp2f(p1[r]);
  float ps = 0;
#pragma unroll
  for (int r = 0; r < 16; ++r) ps += p0[r];
#pragma unroll
  for (int r = 0; r < 16; ++r) ps += p1[r];
  { auto rr = __builtin_amdgcn_permlane32_swap(__float_as_uint(ps), __float_as_uint(ps), false, false);
    ps = __uint_as_float(rr[0]) + __uint_as_float(rr[1]); }
  l_reg = l_reg * alpha + ps;
#define PK4(P, BASE, OUT) do { unsigned a0 = cvtpk(P[BASE + 0], P[BASE + 1]), a1 = cvtpk(P[BASE + 2], P[BASE + 3]);   \
    unsigned b0 = cvtpk(P[BASE + 4], P[BASE + 5]), b1 = cvtpk(P[BASE + 6], P[BASE + 7]);                              \
    auto r0 = __builtin_amdgcn_permlane32_swap(a0, b0, false, false); auto r1 = __builtin_amdgcn_permlane32_swap(a1, b1, false, false); \
    u32x4 w = {r0[0], r1[0], r0[1], r1[1]}; OUT = *reinterpret_cast<bf16x8*>(&w); } while (0)
  PK4(p0, 0, pa0); PK4(p0, 8, pa1); PK4(p1, 0, pa2); PK4(p1, 8, pa3);
#undef PK4
}
__device__ __forceinline__ void qkt(f32x16& p0, f32x16& p1, const char* Kn, const char* Kr, const bf16x8* qr, const char* qrl, int r32, int hi) {
  p0 = f32x16{}; p1 = f32x16{};
#pragma unroll
  for (int d0 = 0; d0 < 8; ++d0) { const int cb = (d0 * 16 + hi * 8) * 2;
    const bf16x8 b0 = *reinterpret_cast<const bf16x8*>(Kn + KSWZ(r32, cb));
    const bf16x8 b1 = *reinterpret_cast<const bf16x8*>(Kn + KSWZ(32 + r32, cb));
    p0 = __builtin_amdgcn_mfma_f32_32x32x16_bf16(b0, qr[d0], p0, 0, 0, 0);
    p1 = __builtin_amdgcn_mfma_f32_32x32x16_bf16(b1, qr[d0], p1, 0, 0, 0); }
#pragma unroll
  for (int d0 = 0; d0 < 4; ++d0) { const int ch = d0 * 2 + hi;
    const bf16x8 b0 = *reinterpret_cast<const bf16x8*>(Kr + RSWZ(r32, ch));
    const bf16x8 b1 = *reinterpret_cast<const bf16x8*>(Kr + RSWZ(32 + r32, ch));
    const bf16x8 qv = *reinterpret_cast<const bf16x8*>(qrl + d0 * 1024);
    p0 = __builtin_amdgcn_mfma_f32_32x32x16_bf16(b0, qv, p0, 0, 0, 0);
    p1 = __builtin_amdgcn_mfma_f32_32x32x16_bf16(b1, qv, p1, 0, 0, 0); }
}
__device__ __forceinline__ int v_st(int k, int c) { const int kk = (k & ~0xC) | ((k & 4) << 1) | ((k & 8) >> 1); return ((kk >> 3) * 4 + (c >> 5)) * 512 + ((kk & 7) * 32 + (c & 31)) * 2; }
__device__ __forceinline__ int v_rd_base(int lane) { return ((lane & 3) << 3) | (((lane >> 2) & 3) << 6) | (((lane >> 4) & 1) << 5) | (((lane >> 5) & 1) << 8); }
constexpr int v_rd_off(int d0, int ks, int half) { return d0 * 512 + ks * 4096 + half * 2048; }
template <int OFF> __device__ __forceinline__ s16x4 tr_read(int vb) {
  s16x4 r; asm volatile("ds_read_b64_tr_b16 %0, %1 offset:%2" : "=&v"(r) : "v"(vb), "i"(OFF) : "memory"); return r;
}
template <int D0> __device__ __forceinline__ void pv_one(f32x16& od, int vb, bf16x8 pa0, bf16x8 pa1, bf16x8 pa2, bf16x8 pa3) {
  const s16x4 l0 = tr_read<v_rd_off(D0, 0, 0)>(vb), h0 = tr_read<v_rd_off(D0, 0, 1)>(vb), l1 = tr_read<v_rd_off(D0, 1, 0)>(vb), h1 = tr_read<v_rd_off(D0, 1, 1)>(vb);
  const s16x4 l2 = tr_read<v_rd_off(D0, 2, 0)>(vb), h2 = tr_read<v_rd_off(D0, 2, 1)>(vb), l3 = tr_read<v_rd_off(D0, 3, 0)>(vb), h3 = tr_read<v_rd_off(D0, 3, 1)>(vb);
  asm volatile("s_waitcnt lgkmcnt(0)" ::: "memory"); SBAR();
#define PK(L, H) (bf16x8){L[0], L[1], L[2], L[3], H[0], H[1], H[2], H[3]}
  od = __builtin_amdgcn_mfma_f32_32x32x16_bf16(pa0, PK(l0, h0), od, 0, 0, 0);
  od = __builtin_amdgcn_mfma_f32_32x32x16_bf16(pa1, PK(l1, h1), od, 0, 0, 0);
  od = __builtin_amdgcn_mfma_f32_32x32x16_bf16(pa2, PK(l2, h2), od, 0, 0, 0);
  od = __builtin_amdgcn_mfma_f32_32x32x16_bf16(pa3, PK(l3, h3), od, 0, 0, 0);
#undef PK
}
__device__ __forceinline__ void pv_d0(f32x16* o, int vb, bf16x8 pa0, bf16x8 pa1, bf16x8 pa2, bf16x8 pa3) {
  pv_one<0>(o[0], vb, pa0, pa1, pa2, pa3); pv_one<1>(o[1], vb, pa0, pa1, pa2, pa3); pv_one<2>(o[2], vb, pa0, pa1, pa2, pa3); pv_one<3>(o[3], vb, pa0, pa1, pa2, pa3);
}
__device__ __forceinline__ void attn_unit(const bf16_t* __restrict__ Qb, const bf16_t* __restrict__ Kh, const bf16_t* __restrict__ Vh, int seq,
                                          bf16_t* __restrict__ Mo, const bf16_t* __restrict__ G, char* lds) {
  int tid_ = threadIdx.x; asm volatile("" : "+v"(tid_));
  const int tid = tid_, wid = tid >> 6, lane = tid & 63, r32 = lane & 31, hi = lane >> 5;
  char* V_lds = lds + OFF_V; char* KN_lds = lds + OFF_KN; char* KR_lds = lds + OFF_KR;
  float* ws = (float*)(lds + OFF_WS) + wid * 64; float* li_l = ws; float* al_l = ws + 32;
  float m_reg = -1e30f, l_reg = 0; f32x16 o[4] = {}; bf16x8 qr[8];
  const bf16_t* Qw = Qb + (long)(wid * QBLK + r32) * 192 + hi * 8;
  char* qrl = lds + OFF_QR + wid * 4096 + lane * 16;
#pragma unroll
  for (int d0 = 0; d0 < 8; ++d0) qr[d0] = ld8(Qw + d0 * 16);
#pragma unroll
  for (int d0 = 0; d0 < 4; ++d0) *reinterpret_cast<bf16x8*>(qrl + d0 * 1024) = ld8(Qw + (8 + d0) * 16);
  const int sr = tid >> 4, sc = (tid & 15) * 8, vst0 = v_st(sr, sc), vst1 = v_st(32 + sr, sc);
  const int rr_ = tid >> 3, rch = tid & 7;
  const int vb0 = (int)(uintptr_t)V_lds + v_rd_base(lane);
  bf16x8 vs0, vs1, ks0, ks1, kr0;
  const int vo0 = sr * 128 + sc, ko0 = sr * 192 + sc, kro = rr_ * 192 + 128 + rch * 8;
#define SLOAD(k0) do { const bf16_t* vt_ = Vh + (long)(k0) * 128; const bf16_t* kt_ = Kh + (long)(k0) * 192; \
    vs0 = ld8(vt_ + vo0); vs1 = ld8(vt_ + vo0 + 32 * 128); ks0 = ld8(kt_ + ko0); ks1 = ld8(kt_ + ko0 + 32 * 192); kr0 = ld8(kt_ + kro); } while (0)
#define SWRITE(b) do { *(bf16x8*)(V_lds + (b) * SHM_V + vst0) = vs0; *(bf16x8*)(V_lds + (b) * SHM_V + vst1) = vs1; const int kc = sc * 2; \
    *(bf16x8*)(KN_lds + (b) * SHM_KN + KSWZ(sr, kc)) = ks0; *(bf16x8*)(KN_lds + (b) * SHM_KN + KSWZ(32 + sr, kc)) = ks1; \
    *(bf16x8*)(KR_lds + (b) * SHM_KR + RSWZ(rr_, rch)) = kr0; } while (0)
#define SWAIT() asm volatile("s_waitcnt vmcnt(0)" ::: "memory")
#define RESC(a) do { if (__any((a) < 1.f)) { if (hi == 0) al_l[r32] = (a); asm volatile("s_waitcnt lgkmcnt(0)" ::: "memory"); \
    _Pragma("unroll") for (int d = 0; d < 4; ++d) _Pragma("unroll") for (int r = 0; r < 16; ++r) o[d][r] *= al_l[crow(r, hi)]; } } while (0)
  f32x16 pA0, pA1, pB0, pB1; float mnA, mnB, alA, alB; bf16x8 pa0, pa1, pa2, pa3; const int NTL = seq / KVBLK;
  SLOAD(0); SWAIT(); SWRITE(0); __syncthreads();
  qkt(pA0, pA1, KN_lds, KR_lds, qr, qrl, r32, hi); partialSM(pA0, pA1, m_reg, mnA, alA);
  SLOAD(KVBLK);
  SWAIT(); SWRITE(1); __syncthreads();
  for (int j = 1; j + 1 < NTL; j += 2) {
    SBAR(); qkt(pB0, pB1, KN_lds + SHM_KN, KR_lds + SHM_KR, qr, qrl, r32, hi);
    finishSM(pA0, pA1, alA, l_reg, pa0, pa1, pa2, pa3); SBAR();
    SLOAD((j + 1) * KVBLK); SBAR();
    pv_d0(o, vb0, pa0, pa1, pa2, pa3); partialSM(pB0, pB1, m_reg, mnB, alB);
    __syncthreads(); SWAIT(); SWRITE(0);
    RESC(alB); __syncthreads();
    SBAR(); qkt(pA0, pA1, KN_lds, KR_lds, qr, qrl, r32, hi);
    finishSM(pB0, pB1, alB, l_reg, pa0, pa1, pa2, pa3); SBAR();
    SLOAD((j + 2) * KVBLK); SBAR();
    pv_d0(o, vb0 + SHM_V, pa0, pa1, pa2, pa3); partialSM(pA0, pA1, m_reg, mnA, alA);
    __syncthreads(); SWAIT(); SWRITE(1);
    RESC(alA); __syncthreads();
  }
  SBAR(); qkt(pB0, pB1, KN_lds + SHM_KN, KR_lds + SHM_KR, qr, qrl, r32, hi);
  finishSM(pA0, pA1, alA, l_reg, pa0, pa1, pa2, pa3); SBAR();
  pv_d0(o, vb0, pa0, pa1, pa2, pa3); partialSM(pB0, pB1, m_reg, mnB, alB);
  __syncthreads(); RESC(alB);
  finishSM(pB0, pB1, alB, l_reg, pa0, pa1, pa2, pa3); SBAR();
  pv_d0(o, vb0 + SHM_V, pa0, pa1, pa2, pa3);
  if (hi == 0) li_l[r32] = l_reg; asm volatile("s_waitcnt lgkmcnt(0)" ::: "memory");
  float rli[16];
#pragma unroll
  for (int r = 0; r < 16; ++r) rli[r] = __builtin_amdgcn_rcpf(li_l[crow(r, hi)]);
#pragma unroll
  for (int r = 0; r < 16; ++r) { const int row = wid * QBLK + crow(r, hi);
#pragma unroll
    for (int d0 = 0; d0 < 4; ++d0) { const int col = d0 * 32 + r32; const float g = bf2f(G[(long)row * NIN + col]);
      Mo[(long)row * DM + col] = f2bf(o[d0][r] * rli[r] * (g / (1.f + __expf(-g)))); } }
  __syncthreads();
#undef SLOAD
#undef SWRITE
#undef SWAIT
#undef RESC
}
#undef SBAR
}

__device__ void ph_attn_mfma(const Params& p, int l, int bid, int nb, char* lds) {
    const bf16_t* Q = WSP(bf16_t, WS_Q); const bf16_t* KB = WSP(bf16_t, WS_KB); const bf16_t* VB = WSP(bf16_t, WS_VB); const bf16_t* U = WSP(bf16_t, WS_U); bf16_t* MIX = WSP(bf16_t, WS_MIX);
    const int vcu = (nb % 8 == 0) ? (bid % 8) * (nb / 8) + bid / 8 : bid;
    const int nlat = NB * NH * (SEQ / 256), nctx = (l < DEPTH - 1) ? NB * NH : 0;
    for (int u = vcu; u < nlat + nctx; u += nb) {
        if (u < nlat) { const int bh = u >> 3, qb = u & 7, b = bh >> 3, h = bh & 7; const size_t hb = (size_t)bh * LK; const size_t rowbase = (size_t)b * SEQ + qb * 256;
            att::attn_unit(Q + (hb + qb * 256) * 192, KB + hb * 192, VB + hb * 128, LK, MIX + rowbase * DM + 512 + h * 128, U + rowbase * NIN + OFF_MLA_G + h * 128, lds); }
        else { const int bh = u - nlat, b = bh >> 3, h = bh & 7; const size_t hb = (size_t)bh * LK + SEQ; const size_t rowbase = (size_t)ROWS_L + b * CTXL;
            att::attn_unit(Q + hb * 192, KB + hb * 192, VB + hb * 128, CTXL, MIX + rowbase * DM + 512 + h * 128, U + rowbase * NIN + OFF_MLA_G + h * 128, lds); }
    }
}


namespace hy {
using bf16x8 = __attribute__((ext_vector_type(8))) short;
using f32x16 = __attribute__((ext_vector_type(16))) float;
using u32x4 = __attribute__((ext_vector_type(4))) unsigned;
using u32x2 = __attribute__((ext_vector_type(2))) unsigned;
constexpr int PADB = 8, ROWB = 80;
constexpr int CPQ = 544, NCH = 520, CH0 = 260;
constexpr int OFF_RHO = 0, OFF_Z = 8 * CPQ * 16, OFF_X1 = OFF_Z + 80 * 4 * ROWB, OFF_X2 = OFF_X1 + 64 * 4 * ROWB, LDS_END = OFF_X2 + 64 * 4 * ROWB;
constexpr unsigned SQ = 0x0F9C9460u;
__device__ __forceinline__ int copy_base(int q) { return q * CPQ + (int)((SQ >> (4 * q)) & 15u); }
__device__ __forceinline__ unsigned pk2bf(float lo, float hi) { unsigned r; asm volatile("v_cvt_pk_bf16_f32 %0, %1, %2" : "=v"(r) : "v"(lo), "v"(hi)); return r; }
__device__ __forceinline__ float blo(unsigned w) { return __uint_as_float(w << 16); }
__device__ __forceinline__ float bhi(unsigned w) { return __uint_as_float(w & 0xffff0000u); }

__device__ __forceinline__ void build_rho(const bf16_t* __restrict__ RHOg, char* lds, int tid) {
    for (int nn = tid; nn < NCH; nn += NT) {
        const int e0 = 8 * nn - 32;
        u32x4 g0 = {0u, 0u, 0u, 0u}, g1 = {0u, 0u, 0u, 0u};
        if (e0 >= 0 && e0 <= 4088) g0 = *reinterpret_cast<const u32x4*>(RHOg + e0);
        if (e0 + 8 >= 0 && e0 + 8 <= 4088) g1 = *reinterpret_cast<const u32x4*>(RHOg + e0 + 8);
        const unsigned w[8] = {g0.x, g0.y, g0.z, g0.w, g1.x, g1.y, g1.z, g1.w};
#pragma unroll
        for (int q = 0; q < 8; ++q) {
            u32x4 o;
            if ((q & 1) == 0) { o.x = w[q / 2]; o.y = w[q / 2 + 1]; o.z = w[q / 2 + 2]; o.w = w[q / 2 + 3]; }
            else { const int a = (q - 1) / 2;
                o.x = __builtin_amdgcn_alignbit(w[a + 1], w[a], 16); o.y = __builtin_amdgcn_alignbit(w[a + 2], w[a + 1], 16);
                o.z = __builtin_amdgcn_alignbit(w[a + 3], w[a + 2], 16); o.w = __builtin_amdgcn_alignbit(w[a + 4], w[a + 3], 16); }
            *reinterpret_cast<u32x4*>(lds + OFF_RHO + (copy_base(q) + nn) * 16) = o;
        }
    }
}
__device__ __forceinline__ f32x16 conv_tile(const char* lds, int I0, int lane) {
    const int i = lane & 31, h = lane >> 5, q = (8 - (i & 7)) & 7;
    const char* pa = lds + OFF_RHO + (copy_base(q) + CH0 + h - (i >> 3) - (q ? 1 : 0) - 4 * (I0 - 63)) * 16;
    const char* pb = lds + OFF_Z + ((63 + PADB) * 4 + i) * ROWB + 16 * h;
    f32x16 acc = {};
#pragma unroll 4
    for (int dd = 0; dd < 72; ++dd) {
        const bf16x8 a0 = *reinterpret_cast<const bf16x8*>(pa - 64 * dd), a1 = *reinterpret_cast<const bf16x8*>(pa - 64 * dd + 32);
        const bf16x8 b0 = *reinterpret_cast<const bf16x8*>(pb - 320 * dd), b1 = *reinterpret_cast<const bf16x8*>(pb - 320 * dd + 32);
        acc = __builtin_amdgcn_mfma_f32_32x32x16_bf16(a0, b0, acc, 0, 0, 0);
        acc = __builtin_amdgcn_mfma_f32_32x32x16_bf16(a1, b1, acc, 0, 0, 0);
    }
    return acc;
}
__device__ __forceinline__ void load_sc16(const bf16_t* __restrict__ row, int t0, float w0, float w1, float w2, float bb, float (&out)[16]) {
    const u32x4 a = *reinterpret_cast<const u32x4*>(row), b = *reinterpret_cast<const u32x4*>(row + 8);
    float in[18];
    in[0] = t0 > 0 ? bf2f(row[-1]) : 0.f; in[17] = t0 + 16 < SEQ ? bf2f(row[16]) : 0.f;
    const unsigned ww[8] = {a.x, a.y, a.z, a.w, b.x, b.y, b.z, b.w};
#pragma unroll
    for (int k = 0; k < 8; ++k) { in[1 + 2 * k] = blo(ww[k]); in[2 + 2 * k] = bhi(ww[k]); }
#pragma unroll
    for (int j = 0; j < 16; ++j) out[j] = w0 * in[j] + w1 * in[j + 1] + w2 * in[j + 2] + bb;
}
__device__ __forceinline__ void st16(char* dst, const float (&v)[16]) {
    u32x4 a, b;
    a.x = pk2bf(v[0], v[1]); a.y = pk2bf(v[2], v[3]); a.z = pk2bf(v[4], v[5]); a.w = pk2bf(v[6], v[7]);
    b.x = pk2bf(v[8], v[9]); b.y = pk2bf(v[10], v[11]); b.z = pk2bf(v[12], v[13]); b.w = pk2bf(v[14], v[15]);
    *reinterpret_cast<u32x4*>(dst) = a; *reinterpret_cast<u32x4*>(dst + 16) = b;
}
__device__ __forceinline__ void hyena_unit(const Params& p, int l, int c, char* lds) {
    int tid_ = threadIdx.x; asm volatile("" : "+v"(tid_));
    const int tid = tid_, lane = tid & 63, wid = __builtin_amdgcn_readfirstlane(tid >> 6);
    const bf16_t* UT = WSP(bf16_t, WS_UT);
    { const int b = tid >> 7, t0 = (tid & 127) * 16; const size_t tok0 = (size_t)b * SEQ + t0;
      const float* cw = p.hy_conv_w + (size_t)l * 3 * 1536; const float* cb = p.hy_conv_b + l * 1536;
      const int J = t0 >> 5, po = (t0 & 31) * 2;
      float v[16];
      load_sc16(UT + (size_t)c * ROWS_L + tok0, t0, cw[c], cw[1536 + c], cw[3072 + c], cb[c], v);
      st16(lds + OFF_Z + ((J + PADB) * 4 + b) * ROWB + po, v);
      load_sc16(UT + (size_t)(512 + c) * ROWS_L + tok0, t0, cw[512 + c], cw[1536 + 512 + c], cw[3072 + 512 + c], cb[512 + c], v);
      st16(lds + OFF_X1 + (J * 4 + b) * ROWB + po, v);
      load_sc16(UT + (size_t)(1024 + c) * ROWS_L + tok0, t0, cw[1024 + c], cw[1536 + 1024 + c], cw[3072 + 1024 + c], cb[1024 + c], v);
      { const bf16_t* gr = UT + (size_t)(1536 + c) * ROWS_L + tok0; const u32x4 ga = *reinterpret_cast<const u32x4*>(gr), gb = *reinterpret_cast<const u32x4*>(gr + 8);
        const unsigned gw[8] = {ga.x, ga.y, ga.z, ga.w, gb.x, gb.y, gb.z, gb.w};
#pragma unroll
        for (int k = 0; k < 8; ++k) { const float g0 = blo(gw[k]), g1 = bhi(gw[k]); v[2 * k] *= g0 / (1.f + __expf(-g0)); v[2 * k + 1] *= g1 / (1.f + __expf(-g1)); } }
      st16(lds + OFF_X2 + (J * 4 + b) * ROWB + po, v);
      if (tid < 320) { const int rz = tid < 160 ? tid : (72 * 4 * 5 - 160) + tid;
          *reinterpret_cast<u32x4*>(lds + OFF_Z + rz * 16) = (u32x4){0u, 0u, 0u, 0u}; } }
    build_rho(WSP(bf16_t, WS_RHO) + ((size_t)0 * 512 + c) * 4096, lds, tid);
    __syncthreads();
    const int I0 = 8 * wid, r = lane & 31, h = lane >> 5;
    f32x16 acc = conv_tile(lds, I0, lane);
    __syncthreads();
#pragma unroll
    for (int g = 0; g < 4; ++g) {
        const int off = (I0 * 4 + r) * ROWB + 16 * g + 8 * h;
        const u32x2 xv = *reinterpret_cast<const u32x2*>(lds + OFF_X1 + off);
        u32x2 o; o.x = pk2bf(acc[4 * g] * blo(xv.x), acc[4 * g + 1] * bhi(xv.x)); o.y = pk2bf(acc[4 * g + 2] * blo(xv.y), acc[4 * g + 3] * bhi(xv.y));
        *reinterpret_cast<u32x2*>(lds + OFF_Z + PADB * 4 * ROWB + off) = o;
    }
    build_rho(WSP(bf16_t, WS_RHO) + ((size_t)1 * 512 + c) * 4096, lds, tid);
    __syncthreads();
    acc = conv_tile(lds, I0, lane);
#pragma unroll
    for (int g = 0; g < 4; ++g) {
        const int off = (I0 * 4 + r) * ROWB + 16 * g + 8 * h;
        const u32x2 xv = *reinterpret_cast<const u32x2*>(lds + OFF_X2 + off);
        u32x2 o; o.x = pk2bf(acc[4 * g] * blo(xv.x), acc[4 * g + 1] * bhi(xv.x)); o.y = pk2bf(acc[4 * g + 2] * blo(xv.y), acc[4 * g + 3] * bhi(xv.y));
        *reinterpret_cast<u32x2*>(lds + OFF_X1 + off) = o;
    }
    __syncthreads();
    bf16_t* HT = WSP(bf16_t, WS_HT) + (size_t)c * ROWS_L;
#pragma unroll
    for (int k = 0; k < 2; ++k) { const int id = tid + k * NT, b = id >> 8, J = (id >> 2) & 63, q4 = id & 3;
        *reinterpret_cast<u32x4*>(HT + (size_t)b * SEQ + 32 * J + 8 * q4) = *reinterpret_cast<const u32x4*>(lds + OFF_X1 + (J * 4 + b) * ROWB + q4 * 16); }
    __syncthreads();
}
}
static_assert(hy::LDS_END <= LDS_BYTES, "hyena LDS map");

__device__ void ph_hyena_mfma(const Params& p, int l, int bid, int nb, char* lds) {
    for (int c = bid; c < HYW; c += nb) hy::hyena_unit(p, l, c, lds);
}
__device__ void ph_rho(const Params& p, int l, int bid, int nb) {
    const int TX = otid();
    const float* F = WSP(float, WS_FL); const float* FS = WSP(float, WS_FSCL); bf16_t* RHO = WSP(bf16_t, WS_RHO);
    for (size_t idx = (size_t)bid * NT + TX; idx < (size_t)2 * 512 * 4096; idx += (size_t)nb * NT) {
        const int e = (int)(idx & 4095), c = (int)((idx >> 12) & 511), o = (int)(idx >> 21), m = e - 2048;
        float v = 0.f;
        if (e != 0) { const float raw = m <= 0 ? F[(((size_t)o * 2 + 0) * SEQ + (-m)) * 512 + c] : F[(((size_t)o * 2 + 1) * SEQ + m) * 512 + c];
            v = FS[(0 * 2 + o) * 512 + c] * raw + (m == 0 ? p.hy_bias[(l * 2 + o) * 512 + c] : 0.f); }
        RHO[idx] = f2bf(v);
    }
}
__device__ void ph_transpose(const bf16_t* __restrict__ src, int spitch, bf16_t* __restrict__ dst, int dpitch, int R, int C, int bid, int nb, bf16_t* tile) {
    const int TX = otid();
    const int tr = R / 64, tc = C / 64;
    for (int t = bid; t < tr * tc; t += nb) {
        const int r0 = (t / tc) * 64, c0 = (t % tc) * 64;
        { const int rr = TX >> 3, cc = (TX & 7) * 8; *(uint4*)(tile + rr * 72 + cc) = *(const uint4*)(src + (size_t)(r0 + rr) * spitch + c0 + cc); }
        __syncthreads();
        { const int dr = TX >> 3, dc = (TX & 7) * 8; unsigned w[4];
#pragma unroll
          for (int k = 0; k < 4; ++k) w[k] = (unsigned)tile[(dc + 2 * k) * 72 + dr] | ((unsigned)tile[(dc + 2 * k + 1) * 72 + dr] << 16);
          *(uint4*)(dst + (size_t)(c0 + dr) * dpitch + r0 + dc) = make_uint4(w[0], w[1], w[2], w[3]); }
        __syncthreads();
    }
}

#define LAS __attribute__((address_space(3)))
typedef unsigned v4u __attribute__((ext_vector_type(4)));
__device__ __forceinline__ unsigned pk2(float lo, float hi) { return (unsigned)f2bf(lo) | ((unsigned)f2bf(hi) << 16); }
__device__ __forceinline__ void transpose_item(const float* W, int K, int N, bf16_t* WT, float* scr, int item, int lane) {
    const int nblk = N / 32, kb = item / nblk, nb_ = item % nblk, k0 = 64 * kb, n0 = 32 * nb_;
#pragma unroll 8
    for (int i = 0; i < 32; ++i) { const int kk = 2 * i + (lane >> 5); scr[kk * 33 + (lane & 31)] = W[(size_t)(k0 + kk) * N + n0 + (lane & 31)]; }
    asm volatile("s_waitcnt lgkmcnt(0)" ::: "memory");
    const int c = lane & 7;
#pragma unroll
    for (int j = 0; j < 4; ++j) { const int n = (lane >> 3) + 8 * j; const float* sp = scr + (8 * c) * 33 + n;
        v4u o; o.x = pk2(sp[0 * 33], sp[1 * 33]); o.y = pk2(sp[2 * 33], sp[3 * 33]); o.z = pk2(sp[4 * 33], sp[5 * 33]); o.w = pk2(sp[6 * 33], sp[7 * 33]);
        *(v4u*)(WT + (size_t)(n0 + n) * K + k0 + 8 * c) = o; }
    asm volatile("s_waitcnt lgkmcnt(0)" ::: "memory");
}
__device__ void ph_prologue(const Params& p, int bid, int nb, float* sm) {
    const int tid = otid(), lane = tid & 63, wid = tid >> 6;
    if (bid < DEPTH * 24) {
        float* sil = sm; float* part = sm + 5 * DM;
        for (int i = tid; i < 5 * DM; i += NT) { const int r = i >> 11, k = i & 2047; sil[i] = silu_f(r < 4 ? p.c[r * DM + k] : p.c_ctx[k]); }
        __syncthreads();
        for (int u = bid; u < DEPTH * 24; u += nb) {
            const int l = u / 24, n0 = (u % 24) * 256;
            const float* W = p.w_ada + (size_t)l * DM * 6144 + n0 + lane * 4;
            float4 a[5];
#pragma unroll
            for (int r = 0; r < 5; ++r) a[r] = make_float4(0.f, 0.f, 0.f, 0.f);
#pragma unroll 8
            for (int kk = 0; kk < 256; ++kk) { const int k = wid * 256 + kk; const float4 w = *(const float4*)(W + (size_t)k * 6144);
#pragma unroll
                for (int r = 0; r < 5; ++r) { const float sv = sil[r * DM + k]; a[r].x += sv * w.x; a[r].y += sv * w.y; a[r].z += sv * w.z; a[r].w += sv * w.w; } }
#pragma unroll
            for (int r = 0; r < 5; ++r) *(float4*)(part + (wid * 5 + r) * 256 + lane * 4) = a[r];
            __syncthreads();
            for (int i = tid; i < 5 * 256; i += NT) { const int r = i >> 8, c = i & 255; float sacc = p.b_ada[l * 6144 + n0 + c];
#pragma unroll
                for (int w = 0; w < 8; ++w) sacc += part[(w * 5 + r) * 256 + c];
                WSP(float, WS_MOD)[(size_t)(l * 5 + r) * 6144 + n0 + c] = sacc; }
            __syncthreads();
        }
    }
    __syncthreads();
    float* scr = sm + wid * (64 * 33 + 16);
    const int gw = bid * 8 + wid, NGW = nb * 8;
    constexpr int I_IN = (DM / 64) * (NIN / 32), I_OUT = (DM / 64) * (DM / 32), I_UQ = (512 / 64) * (1536 / 32), I_UKV = (256 / 64) * (2048 / 32), I_ALL = I_IN + I_OUT + I_UQ + I_UKV;
    for (int it = gw; it < DEPTH * I_ALL; it += NGW) {
        const int l = it / I_ALL; int r = it % I_ALL;
        if (r < I_IN) { transpose_item(p.w_in + (size_t)l * DM * NIN, DM, NIN, WSP(bf16_t, WS_WINT) + (size_t)l * NINP * DM, scr, r, lane); continue; } r -= I_IN;
        if (r < I_OUT) { transpose_item(p.w_out + (size_t)l * DM * DM, DM, DM, WSP(bf16_t, WS_WOUTT) + (size_t)l * DM * DM, scr, r, lane); continue; } r -= I_OUT;
        if (r < I_UQ) { transpose_item(p.w_uq + (size_t)l * 512 * 1536, 512, 1536, WSP(bf16_t, WS_WUQT) + (size_t)l * 1536 * 512, scr, r, lane); continue; } r -= I_UQ;
        transpose_item(p.w_ukv + (size_t)l * 256 * 2048, 256, 2048, WSP(bf16_t, WS_WUKVT) + (size_t)l * 2048 * 256, scr, r, lane);
    }
    for (int i = bid * NT + tid; i < DEPTH * 512 * 512; i += nb * NT) {
        const int l = i >> 18, n = (i >> 9) & 511, k = i & 511;
        WSP(bf16_t, WS_WPBD)[i] = (n >> 7) == (k >> 7) ? f2bf(p.w_pool[((size_t)(l * 4 + (n >> 7)) * 128 + (k & 127)) * 128 + (n & 127)]) : (bf16_t)0;
    }
    for (size_t i = (size_t)bid * NT + tid; i < (size_t)DEPTH * (NINP - NIN) * DM / 8; i += (size_t)nb * NT) {
        const size_t per = (size_t)(NINP - NIN) * DM / 8; const int l = (int)(i / per); const size_t o = i % per;
        *(v4u*)(WSP(bf16_t, WS_WINT) + ((size_t)l * NINP + NIN) * DM + o * 8) = (v4u){0u, 0u, 0u, 0u};
    }
    __syncthreads();
}

enum { PH_ADALN = 0, PH_1, PH_2, PH_3, PH_4, PH_5, PH_6, PH_7, PH_FINAL };
__device__ __forceinline__ void run_phase(const Params& pin, int ph, int l, int bid, int nb, float* sm) {
#if defined(__HIP_DEVICE_COMPILE__)
    const __attribute__((address_space(4))) Params* pk = (const __attribute__((address_space(4))) Params*)__builtin_amdgcn_kernarg_segment_ptr();
    asm volatile("" : "+s"(pk));
    const Params p = *pk; (void)pin;
#else
    const Params p = pin;
#endif
    switch (ph) {
    case PH_ADALN: ph_prologue(p, bid, nb, sm); break;
    case PH_1: ph_filter(p, l, bid, nb, sm); ph_norm(p, l, bid, nb); break;
    case PH_2: ph_fscale(p, bid, nb);
        { pg8::Gemm g{WSP(bf16_t, WS_HA), WSP(bf16_t, WS_WINT) + (size_t)l * NINP * DM, ROWS, NINP, DM}; pg8::StaticOrder S; S.init(ROWS, NINP, nb, bid);
          pg8::EpiStoreBf16 E{WSP(bf16_t, WS_U), NIN, NIN};
          pg8::gemm_phase<pg8::EpiStoreBf16, pg8::StaticOrder, true, true>((PG8_LAS unsigned char*)sm, g, S, E); } break;
    case PH_3: ph_rms_small(p, l, bid, nb); ph_shortconv(p, l, bid, nb); ph_pooldiff(p, bid, nb); ph_rho(p, l, bid, nb);
        ph_transpose(WSP(bf16_t, WS_U), NIN, WSP(bf16_t, WS_UT), ROWS_L, ROWS_L, 2048, bid, nb, (bf16_t*)sm); break;
    case PH_4:
        { pg8::Gemm g{WSP(bf16_t, WS_QN), WSP(bf16_t, WS_WUQT) + (size_t)l * 1536 * 512, ROWS, 1536, 512}; pg8::StaticOrder S; S.init(ROWS, 1536, nb, bid);
          pg8::EpiStoreBf16 E{WSP(bf16_t, WS_QRAW), 1536, 1536};
          pg8::gemm_phase<pg8::EpiStoreBf16, pg8::StaticOrder, true, true>((PG8_LAS unsigned char*)sm, g, S, E); }
        { pg8::Gemm g{WSP(bf16_t, WS_KVN), WSP(bf16_t, WS_WUKVT) + (size_t)l * 2048 * 256, ROWS, 2048, 256}; pg8::StaticOrder S; S.init(ROWS, 2048, nb, bid);
          pg8::EpiStoreBf16 E{WSP(bf16_t, WS_KVRAW), 2048, 2048};
          pg8::gemm_phase<pg8::EpiStoreBf16, pg8::StaticOrder, true, true>((PG8_LAS unsigned char*)sm, g, S, E); }
        { pg8::Gemm g{WSP(bf16_t, WS_PD), WSP(bf16_t, WS_WPBD) + (size_t)l * 512 * 512, ROWS, 512, 512}; pg8::StaticOrder S; S.init(ROWS, 512, nb, bid);
          pg8::EpiStoreBf16 E{WSP(bf16_t, WS_PY), 512, 512};
          pg8::gemm_phase<pg8::EpiStoreBf16, pg8::StaticOrder, true, true>((PG8_LAS unsigned char*)sm, g, S, E); }
        __syncthreads();
        ph_hyena_mfma(p, l, bid, nb, (char*)sm);
        ph_conv(p, l, 0, bid, nb, sm); break;
    case PH_5: ph_pack_qkv(p, bid, nb); ph_conv(p, l, 1, bid, nb, sm); ph_poolgate(p, l, bid, nb);
        ph_transpose(WSP(bf16_t, WS_HT), ROWS_L, WSP(bf16_t, WS_MIX), DM, 512, ROWS_L, bid, nb, (bf16_t*)sm); break;
    case PH_6: ph_attn_mfma(p, l, bid, nb, (char*)sm); break;
    case PH_7: { const int Mrows = l == DEPTH - 1 ? ROWS_L : ROWS;
          pg8::Gemm g{WSP(bf16_t, WS_MIX), WSP(bf16_t, WS_WOUTT) + (size_t)l * DM * DM, Mrows, DM, DM}; pg8::StaticOrder S; S.init(Mrows, DM, nb, bid);
          pg8::EpiResid E{l == 0 ? p.x : WSP(float, WS_XW), l == 0 ? p.ctx : WSP(float, WS_XW) + (size_t)ROWS_L * DM, WSP(float, WS_XW), WSP(float, WS_MOD) + (size_t)l * 5 * 6144 + 4096};
          pg8::gemm_phase<pg8::EpiResid, pg8::StaticOrder, true, true>((PG8_LAS unsigned char*)sm, g, S, E); } break;
    case PH_FINAL: ph_final(p, bid, nb); break;
    }
}

#if ONE_LAUNCH
__global__ void __launch_bounds__(NT, 2) mega_fwd(Params p) {
    extern __shared__ __attribute__((aligned(16))) unsigned char lds[];
    cg::grid_group grid = cg::this_grid();
    float* sm = (float*)lds; const int bid = blockIdx.x, nb = gridDim.x;
    run_phase(p, PH_ADALN, 0, bid, nb, sm);
#pragma unroll 1
    for (int l = 0; l < DEPTH; ++l) {
        grid.sync(); run_phase(p, PH_1, l, bid, nb, sm);
        grid.sync(); run_phase(p, PH_2, l, bid, nb, sm);
        grid.sync(); run_phase(p, PH_3, l, bid, nb, sm);
        grid.sync(); run_phase(p, PH_4, l, bid, nb, sm);
        grid.sync(); run_phase(p, PH_5, l, bid, nb, sm);
        grid.sync(); run_phase(p, PH_6, l, bid, nb, sm);
        grid.sync(); run_phase(p, PH_7, l, bid, nb, sm);
    }
    grid.sync();
    run_phase(p, PH_FINAL, 0, bid, nb, sm);
}
#else
__global__ void __launch_bounds__(NT) k_phase(Params p, int ph, int l) {
    extern __shared__ __attribute__((aligned(16))) unsigned char lds[];
    run_phase(p, ph, l, blockIdx.x, gridDim.x, (float*)lds);
}
#endif

extern "C" void kernel_launch(void* const* d_in, const int* in_sizes, int n_in, void* d_out, int out_size, void* d_ws, size_t ws_size, hipStream_t stream) {
    if (n_in != 25 || ws_size < WS_END) { fprintf(stderr, "kernel_launch: bad inputs (n_in %d, ws %zu < %zu)\n", n_in, ws_size, (size_t)WS_END); return; }
    Params p{};
    const float** pp = (const float**)&p;
    for (int i = 0; i < 25; ++i) pp[i] = (const float*)d_in[i];
    p.out = (float*)d_out; p.ws = (unsigned char*)d_ws;
#if ONE_LAUNCH
    static int grid = 0;
    if (!grid) {
        int dev = 0, cus = 0, per_cu = 0;
        hipGetDevice(&dev); hipDeviceGetAttribute(&cus, hipDeviceAttributeMultiprocessorCount, dev);
        hipFuncSetAttribute((const void*)mega_fwd, hipFuncAttributeMaxDynamicSharedMemorySize, LDS_BYTES);
        hipOccupancyMaxActiveBlocksPerMultiprocessor(&per_cu, (const void*)mega_fwd, NT, LDS_BYTES);
        if (per_cu < 1) per_cu = 1;
        grid = cus * 1;
    }
    void* args[] = {&p};
    hipError_t e = hipLaunchCooperativeKernel((const void*)mega_fwd, dim3(grid), dim3(NT), args, LDS_BYTES, stream);
    if (e != hipSuccess) fprintf(stderr, "cooperative launch failed: %s (grid %d)\n", hipGetErrorString(e), grid);
#else
    static int init = 0;
    if (!init) { hipFuncSetAttribute((const void*)k_phase, hipFuncAttributeMaxDynamicSharedMemorySize, LDS_BYTES); init = 1; }
    const int G = 1024;
    k_phase<<<G, NT, LDS_BYTES, stream>>>(p, PH_ADALN, 0);
    for (int l = 0; l < DEPTH; ++l)
        for (int ph = PH_1; ph <= PH_7; ++ph) k_phase<<<G, NT, LDS_BYTES, stream>>>(p, ph, l);
    k_phase<<<G, NT, LDS_BYTES, stream>>>(p, PH_FINAL, 0);
#endif
}
```

```cpp
#include <hip/hip_runtime.h>
#include <hip/hip_cooperative_groups.h>
#include <cstdio>
#include <cstdint>
namespace cg = cooperative_groups;

#ifndef ONE_LAUNCH
#define ONE_LAUNCH 1
#endif
#ifndef REP_PH
#define REP_PH -1
#endif

constexpr int DM = 2048, NB = 4, SEQ = 2048, DEPTH = 4, CTXL = 256;
constexpr int HYW = 512, NH = 8, QRANK = 512, KVRANK = 256, POOLW = 512;
constexpr int OFF_HY_G = 1536, OFF_Q = 2048, OFF_KV = 2560, OFF_KR = 2816, OFF_MLA_G = 2880, OFF_POOL = 3904, OFF_POOL_G = 4416, NIN = 4928;
constexpr int ROWS_L = NB * SEQ, ROWS_C = NB * CTXL, ROWS = ROWS_L + ROWS_C;
constexpr int LK = SEQ + CTXL;
constexpr float EPS = 1e-6f;
constexpr float ATTN_SCALE = 0.07216878364870322f;
constexpr int NT = 512;
constexpr int NINP = 5120;

typedef unsigned short bf16_t;
typedef bf16_t act_t;

struct Params {
    const float *x, *c, *ctx, *c_ctx, *norm_g, *w_ada, *b_ada, *w_in, *hy_conv_w, *hy_conv_b, *hf_w1, *hf_b1, *hf_freq, *hf_w2, *hf_b2, *hf_w3, *hy_bias,
        *q_norm_g, *w_uq, *kv_norm_g, *w_ukv, *w_pool, *pool_scale, *w_out, *final_norm_g;
    float* out; unsigned char* ws;
};

constexpr size_t al256(size_t x) { return (x + 255) / 256 * 256; }
constexpr size_t WS_MOD = 0;
constexpr size_t WS_FSCL = WS_MOD + al256((size_t)4 * 5 * 6144 * 4);
constexpr size_t WS_H2L = WS_FSCL + al256((size_t)4 * 2 * 512 * 4);
constexpr size_t WS_FC = WS_H2L + al256((size_t)(4 * 2048 + 1) * 64 * 4);
constexpr size_t WS_HA = WS_FC + al256((size_t)4 * 2 * 2 * 256 * 512 * 4);
constexpr size_t WS_KVRAW = WS_HA;
constexpr size_t WS_U = WS_HA + al256((size_t)ROWS * 2048 * sizeof(act_t));
constexpr size_t WS_QN = WS_U + al256((size_t)ROWS * NIN * sizeof(act_t));
constexpr size_t WS_KVN = WS_QN + al256((size_t)ROWS * 512 * sizeof(act_t));
constexpr size_t WS_QRAW = WS_KVN + al256((size_t)ROWS * 256 * sizeof(act_t));
constexpr size_t WS_Q = WS_QRAW + al256((size_t)ROWS * 1536 * sizeof(act_t));
constexpr size_t WS_KB = WS_Q + al256((size_t)NB * NH * LK * 192 * sizeof(act_t));
constexpr size_t WS_VB = WS_KB + al256((size_t)NB * NH * LK * 192 * sizeof(act_t));
constexpr size_t WS_HC = WS_VB + al256((size_t)NB * NH * LK * 128 * sizeof(act_t));
constexpr size_t WS_Z2 = WS_HC + al256((size_t)ROWS * 1536 * sizeof(act_t));
constexpr size_t WS_PD = WS_Z2 + al256((size_t)ROWS * 512 * sizeof(act_t));
constexpr size_t WS_PY = WS_PD + al256((size_t)ROWS * 512 * sizeof(act_t));
constexpr size_t WS_MIX = WS_PY + al256((size_t)ROWS * 512 * sizeof(act_t));
constexpr size_t WS_XW = WS_MIX + al256((size_t)ROWS * 2048 * sizeof(act_t));
constexpr size_t WS_WINT = WS_XW + al256((size_t)ROWS * 2048 * 4);
constexpr size_t WS_WOUTT = WS_WINT + al256((size_t)DEPTH * NINP * DM * 2);
constexpr size_t WS_WUQT = WS_WOUTT + al256((size_t)DEPTH * DM * DM * 2);
constexpr size_t WS_WUKVT = WS_WUQT + al256((size_t)DEPTH * 1536 * 512 * 2);
constexpr size_t WS_WP = WS_WUKVT + al256((size_t)DEPTH * 2048 * 256 * 2);
constexpr size_t WS_UT = WS_WP + al256((size_t)DEPTH * 2048 * 512 * 4);
constexpr size_t WS_HT = WS_UT + al256((size_t)2048 * ROWS * 2);
constexpr size_t WS_RHO = WS_HT + al256((size_t)512 * ROWS * 2);
constexpr size_t WS_RS = WS_RHO + al256((size_t)DEPTH * 2 * 512 * 4096 * 2);
constexpr size_t WS_ROPE = WS_RS + al256((size_t)ROWS * 12 * 4);
constexpr size_t WS_KC = WS_ROPE + al256((size_t)SEQ * 32 * 2 * 4);
constexpr size_t WS_CTL = WS_KC + al256((size_t)DEPTH * 2 * 512 * 512 * 4);
constexpr size_t CTL_BYTES = 16384;
constexpr size_t WS_END = WS_CTL + CTL_BYTES;

constexpr int LDS_BYTES = 147456;

__device__ __forceinline__ float ldf(const float* p) { return *p; }
__device__ __forceinline__ void stf(float* p, float v) { *p = v; }
__device__ __forceinline__ float bf2f(bf16_t v) { return __uint_as_float((unsigned)v << 16); }
__device__ __forceinline__ bf16_t f2bf(float f) { const unsigned u = __float_as_uint(f); return (bf16_t)((u + 0x7fffu + ((u >> 16) & 1u)) >> 16); }
__device__ __forceinline__ float ldf(const bf16_t* p) { return bf2f(*p); }
__device__ __forceinline__ void stf(bf16_t* p, float v) { *p = f2bf(v); }
__device__ __forceinline__ float fsin(float x) { return __builtin_amdgcn_sinf(x * 0.15915494309189535f); }
__device__ __forceinline__ float fcos(float x) { return __builtin_amdgcn_cosf(x * 0.15915494309189535f); }
__device__ __forceinline__ float silu_f(float x) { return x / (1.f + expf(-x)); }
__device__ __forceinline__ float wave_sum(float v) {
    int lane = (int)__builtin_amdgcn_mbcnt_hi(~0u, __builtin_amdgcn_mbcnt_lo(~0u, 0u)); asm volatile("" : "+v"(lane));
#pragma unroll
    for (int o = 32; o > 0; o >>= 1) v += __int_as_float(__builtin_amdgcn_ds_bpermute((lane ^ o) << 2, __float_as_int(v)));
    return v;
}
struct RowInfo { int b, t, L, n, mr; };
__device__ __forceinline__ RowInfo rowinfo(int row) {
    RowInfo r;
    if (row < ROWS_L) { r.b = row >> 11; r.t = row & 2047; r.L = SEQ; r.n = r.t; r.mr = r.b; }
    else { const int q = row - ROWS_L; r.b = q >> 8; r.t = q & 255; r.L = CTXL; r.n = SEQ + r.t; r.mr = 4; }
    return r;
}
__device__ __forceinline__ const float* xin_row(const Params& p, int l, int row) {
    if (l == 0) return row < ROWS_L ? p.x + (size_t)row * DM : p.ctx + (size_t)(row - ROWS_L) * DM;
    return (const float*)(p.ws + WS_XW) + (size_t)row * DM;
}
#define WSP(T, off) ((T*)(p.ws + (off)))
__device__ __forceinline__ int otid() { int t = threadIdx.x; asm volatile("" : "+v"(t)); return t; }

__device__ void ph_adaln(const Params& p, int bid, int nb, float* sm) {
    const int TX = otid();
    for (int i = TX; i < 5 * DM; i += NT) { const int r = i >> 11, k = i & 2047; sm[i] = silu_f(r < 4 ? p.c[r * DM + k] : p.c_ctx[k]); }
    __syncthreads();
    float* MOD = WSP(float, WS_MOD);
    for (int idx = bid * NT + TX; idx < DEPTH * 6144; idx += nb * NT) {
        const int l = idx / 6144, n = idx % 6144;
        const float* W = p.w_ada + (size_t)l * DM * 6144 + n;
        float a0 = 0, a1 = 0, a2 = 0, a3 = 0, a4 = 0;
        for (int k = 0; k < DM; ++k) { const float w = W[(size_t)k * 6144]; a0 += sm[k] * w; a1 += sm[2048 + k] * w; a2 += sm[4096 + k] * w; a3 += sm[6144 + k] * w; a4 += sm[8192 + k] * w; }
        const float bb = p.b_ada[l * 6144 + n];
        MOD[(l * 5 + 0) * 6144 + n] = a0 + bb; MOD[(l * 5 + 1) * 6144 + n] = a1 + bb; MOD[(l * 5 + 2) * 6144 + n] = a2 + bb;
        MOD[(l * 5 + 3) * 6144 + n] = a3 + bb; MOD[(l * 5 + 4) * 6144 + n] = a4 + bb;
    }
    __syncthreads();
}

__device__ __forceinline__ float filt_feat(int idx, float t, float wpos) {
    if (idx == 0) return t;
    const int i = (idx - 1) & 15; const float band = 1e-4f + (float)i * ((15.f - 1e-4f) / 15.f); const float a = band * wpos;
    return (idx <= 16) ? fcos(a) : -fsin(a);
}
constexpr float HY_DA = -3.0701134573253944f, HY_DB = -15.350567286626973f;
__device__ void ph_filter_ctx(const Params& p, int bid, int nb, float* sm) {
    const int TX = otid();
    float* feats = sm; float* h1 = sm + 64; float* h2 = sm + 128;
    const int tid = TX;
    for (int u = bid; u < DEPTH * CTXL; u += nb) {
        const int l = u >> 8, pos = u & 255, L = CTXL;
        const float t = (float)pos / (float)(L - 1), wpos = (6.283185307179586f / (float)L) * (float)pos;
        if (tid < 33) feats[tid] = filt_feat(tid, t, wpos);
        __syncthreads();
        if (tid < 64) { float s = p.hf_b1[l * 64 + tid];
#pragma unroll 4
            for (int e = 0; e < 33; ++e) s += feats[e] * p.hf_w1[(l * 33 + e) * 64 + tid]; h1[tid] = fsin(p.hf_freq[l * 64 + tid] * s); }
        __syncthreads();
        if (tid < 64) { float s = p.hf_b2[l * 64 + tid];
#pragma unroll 4
            for (int i = 0; i < 64; ++i) s += h1[i] * p.hf_w2[(l * 64 + i) * 64 + tid]; h2[tid] = fsin(p.hf_freq[l * 64 + tid] * s); }
        __syncthreads();
        float* F = WSP(float, WS_FC) + (size_t)l * 2 * 2 * CTXL * 512;
        for (int n = tid; n < 2048; n += NT) {
            float s = 0;
#pragma unroll 8
            for (int j = 0; j < 64; ++j) s += h2[j] * p.hf_w3[((size_t)l * 64 + j) * 2048 + n];
            const int o = n >> 10, d = (n >> 9) & 1, c = n & 511;
            const float delta = fabsf(HY_DA + (float)c * ((HY_DB - HY_DA) / 511.f));
            F[(((size_t)o * 2 + d) * L + pos) * 512 + c] = s * expf(-t * delta);
        }
        __syncthreads();
    }
}
__device__ void ph_fscale_ctx(const Params& p, int bid, int nb) {
    const int TX = otid();
    const int lane = TX & 63, wid = TX >> 6;
    float* FS = WSP(float, WS_FSCL);
    for (int idx = bid * 8 + wid; idx < DEPTH * 1024; idx += nb * 8) {
        const int l = idx >> 10, o = (idx >> 9) & 1, c = idx & 511, L = CTXL;
        const float* F = WSP(float, WS_FC) + (size_t)l * 2 * 2 * CTXL * 512;
        float s = 0;
#pragma unroll
        for (int i = 0; i < 4; ++i) { const int pos = lane + 64 * i;
            const float a = F[(((size_t)o * 2 + 0) * L + pos) * 512 + c]; s += a * a;
            if (pos >= 1) { const float b2 = F[(((size_t)o * 2 + 1) * L + pos) * 512 + c]; s += b2 * b2; } }
        s = wave_sum(s);
        if (lane == 0) FS[idx] = rsqrtf(s + EPS);
    }
}
__device__ void ph_h2(const Params& p, int bid, int nb, float* sm) {
    const int TX = otid();
    const int lane = TX & 63, wid = TX >> 6;
    float* fe = sm + wid * 128; float* h1s = fe + 64;
    float* H2L = WSP(float, WS_H2L);
    for (int u = bid * 8 + wid; u < DEPTH * SEQ; u += nb * 8) {
        const int l = u >> 11, pos = u & 2047;
        const float t = (float)pos / (float)(SEQ - 1), wpos = (6.283185307179586f / (float)SEQ) * (float)pos;
        fe[lane] = lane < 33 ? filt_feat(lane, t, wpos) : 0.f;
        const float fq = p.hf_freq[l * 64 + lane];
        float s = p.hf_b1[l * 64 + lane];
#pragma unroll 3
        for (int e = 0; e < 33; ++e) s += fe[e] * p.hf_w1[(l * 33 + e) * 64 + lane];
        h1s[lane] = fsin(fq * s);
        float s2 = p.hf_b2[l * 64 + lane];
#pragma unroll 4
        for (int i = 0; i < 64; ++i) s2 += h1s[i] * p.hf_w2[(l * 64 + i) * 64 + lane];
        H2L[((size_t)l * SEQ + pos) * 64 + lane] = fsin(fq * s2);
    }
}
__device__ __forceinline__ void rho_dots(const float* H2t, const float* w3s, int row0, int rstep, int dir, int ci, float (&acc)[8]) {
#pragma unroll
    for (int k = 0; k < 8; ++k) acc[k] = 0.f;
#pragma unroll 4
    for (int j = 0; j < 64; j += 4) {
        const float w0 = w3s[(j + 0) * 32 + dir * 16 + ci], w1 = w3s[(j + 1) * 32 + dir * 16 + ci], w2 = w3s[(j + 2) * 32 + dir * 16 + ci], w3 = w3s[(j + 3) * 32 + dir * 16 + ci];
#pragma unroll
        for (int k = 0; k < 8; ++k) { const float4 h = *(const float4*)&H2t[(row0 + rstep * k) * 68 + j]; acc[k] += h.x * w0 + h.y * w1 + h.z * w2 + h.w * w3; }
    }
}
__device__ void ph_rho_units(const Params& p, int bid, int nb, float* sm) {
    const int TX = otid();
    const int tid = TX, ci = tid & 15, g = tid >> 4;
    float* w3s = sm; float* red = sm + 2048; float* scl = sm + 2560; float* H2t = sm + 2624;
    for (int u = bid; u < DEPTH * 2 * 32; u += nb) {
        const int l = u >> 6, o = (u >> 5) & 1, c0 = (u & 31) * 16, c = c0 + ci;
        __syncthreads();
        for (int i = tid; i < 64 * 32; i += NT) { const int j = i >> 5, n = i & 31; w3s[i] = p.hf_w3[((size_t)l * 64 + j) * 2048 + o * 1024 + (n >> 4) * 512 + c0 + (n & 15)]; }
        const float delta = fabsf(HY_DA + (float)c * ((HY_DB - HY_DA) / 511.f));
        const float bias = p.hy_bias[(l * 2 + o) * 512 + c];
        float ss = 0.f, sc = 0.f;
#pragma unroll 1
        for (int pass = 0; pass < 2; ++pass) {
#pragma unroll 1
            for (int ch = 0; ch < 16; ++ch) {
                const int E0 = ch * 256, PB = ch < 8 ? 1793 - E0 : E0 - 2048;
                __syncthreads();
                { const float* src = WSP(float, WS_H2L) + ((size_t)l * SEQ + PB) * 64;
#pragma unroll
                  for (int i = 0; i < 8; ++i) { const int idx = tid + NT * i, row = idx >> 4, q4 = idx & 15; *(float4*)&H2t[row * 68 + q4 * 4] = *(const float4*)(src + (size_t)row * 64 + q4 * 4); } }
                __syncthreads();
                float acc[8];
                rho_dots(H2t, w3s, ch < 8 ? 255 - g * 8 : g * 8, ch < 8 ? -1 : 1, ch < 8 ? 0 : 1, ci, acc);
                if (ch == 8 && g == 0) { float a = 0.f;
#pragma unroll 8
                    for (int j = 0; j < 64; ++j) a += H2t[j] * w3s[j * 32 + ci];
                    acc[0] = a; }
#pragma unroll
                for (int k = 0; k < 8; ++k) { const int e = E0 + g * 8 + k, pp = ch < 8 ? 2048 - e : e - 2048;
                    float v = acc[k] * expf(-((float)pp / (float)(SEQ - 1)) * delta); if (e == 0) v = 0.f; acc[k] = v; }
                if (pass == 0) {
#pragma unroll
                    for (int k = 0; k < 8; ++k) ss += acc[k] * acc[k];
                } else {
#pragma unroll
                    for (int k = 0; k < 8; ++k) acc[k] *= sc;
                    if (ch == 8 && g == 0) acc[0] += bias;
                    uint4 w; w.x = (unsigned)f2bf(acc[0]) | ((unsigned)f2bf(acc[1]) << 16); w.y = (unsigned)f2bf(acc[2]) | ((unsigned)f2bf(acc[3]) << 16);
                    w.z = (unsigned)f2bf(acc[4]) | ((unsigned)f2bf(acc[5]) << 16); w.w = (unsigned)f2bf(acc[6]) | ((unsigned)f2bf(acc[7]) << 16);
                    *(uint4*)(WSP(bf16_t, WS_RHO) + (((size_t)l * 2 + o) * 512 + c) * 4096 + E0 + g * 8) = w;
                }
            }
            if (pass == 0) {
                red[tid] = ss; __syncthreads();
                if (tid < 16) { float t2 = 0.f; for (int q = 0; q < 32; ++q) t2 += red[q * 16 + tid]; scl[tid] = rsqrtf(t2 + EPS); }
                __syncthreads(); sc = scl[ci];
            }
        }
    }
    __syncthreads();
}

__device__ void ph_norm(const Params& p, int l, int bid, int nb) {
    const int TX = otid();
    const int lane = TX & 63, wid = TX >> 6, nw = NT >> 6;
    const float* MOD = WSP(float, WS_MOD); act_t* HA = WSP(act_t, WS_HA);
    for (int row = bid * nw + wid; row < ROWS; row += nb * nw) {
        const RowInfo r = rowinfo(row);
        const float* xr = xin_row(p, l, row);
        float ss = 0;
#pragma unroll 2
        for (int j = 0; j < 8; ++j) { const float4 v = *(const float4*)(xr + (j * 64 + lane) * 4); ss += v.x * v.x + v.y * v.y + v.z * v.z + v.w * v.w; }
        ss = wave_sum(ss);
        const float rstd = rsqrtf(ss * (1.f / DM) + EPS);
        const float* g = p.norm_g + l * DM; const float* sh = MOD + (size_t)(l * 5 + r.mr) * 6144; const float* sc = sh + 2048;
#pragma unroll 1
        for (int j = 0; j < 8; ++j) {
            const int k = (j * 64 + lane) * 4;
            const float4 v = *(const float4*)(xr + k);
            const float e[4] = {v.x, v.y, v.z, v.w};
#pragma unroll
            for (int q = 0; q < 4; ++q) stf(HA + (size_t)row * DM + k + q, e[q] * rstd * g[k + q] * (1.f + sc[k + q]) + sh[k + q]);
        }
    }
}

template <int EPI>
__device__ void gemm_naive(const Params& p, int l, const act_t* A, int lda, const float* B, int ldb, act_t* C, int ldc, int M, int N, int K, int bid, int nb, float* sm) {
    const int TX = otid();
    float* As = sm; float* Bs = sm + 16 * 132;
    const int tid = TX, tx = tid & 15, ty = tid >> 4;
    const int tilesN = N / 64, tiles = (M / 128) * tilesN;
    for (int tile = bid; tile < tiles; tile += nb) {
        const int m0 = (tile / tilesN) * 128, n0 = (tile % tilesN) * 64;
        float acc[4][4];
#pragma unroll
        for (int i = 0; i < 4; ++i)
#pragma unroll
            for (int j = 0; j < 4; ++j) acc[i][j] = 0.f;
        for (int k0 = 0; k0 < K; k0 += 16) {
            { const int r = tid >> 2, kq = (tid & 3) * 4; const act_t* ap = A + (size_t)(m0 + r) * lda + k0 + kq;
              As[(kq + 0) * 132 + r] = ldf(ap); As[(kq + 1) * 132 + r] = ldf(ap + 1); As[(kq + 2) * 132 + r] = ldf(ap + 2); As[(kq + 3) * 132 + r] = ldf(ap + 3); }
            { const int kk = tid >> 5, nn = (tid & 31) * 2; const float* bp = B + (size_t)(k0 + kk) * ldb + n0 + nn; Bs[kk * 64 + nn] = bp[0]; Bs[kk * 64 + nn + 1] = bp[1]; }
            __syncthreads();
#pragma unroll
            for (int kk = 0; kk < 16; ++kk) {
                const float4 a = *(const float4*)&As[kk * 132 + ty * 4]; const float4 b = *(const float4*)&Bs[kk * 64 + tx * 4];
                const float av[4] = {a.x, a.y, a.z, a.w}, bv[4] = {b.x, b.y, b.z, b.w};
#pragma unroll
                for (int i = 0; i < 4; ++i)
#pragma unroll
                    for (int j = 0; j < 4; ++j) acc[i][j] += av[i] * bv[j];
            }
            __syncthreads();
        }
#pragma unroll
        for (int i = 0; i < 4; ++i) {
            const int m = m0 + ty * 4 + i;
            if (EPI == 0) {
#pragma unroll
                for (int j = 0; j < 4; ++j) stf(C + (size_t)m * ldc + n0 + tx * 4 + j, acc[i][j]);
            } else {
                const RowInfo r = rowinfo(m);
                const float* xr = xin_row(p, l, m);
                const float* gate = WSP(float, WS_MOD) + (size_t)(l * 5 + r.mr) * 6144 + 4096;
                float* XW = WSP(float, WS_XW) + (size_t)m * DM;
#pragma unroll
                for (int j = 0; j < 4; ++j) { const int n = n0 + tx * 4 + j; XW[n] = xr[n] + gate[n] * acc[i][j]; }
            }
        }
    }
}

__device__ void ph_rstd(const Params& p, int bid, int nb) {
    const int TX = otid();
    const int lane = TX & 63, wid = TX >> 6;
    const bf16_t* U = WSP(bf16_t, WS_U); float* RS = WSP(float, WS_RS);
    for (int row = bid * 8 + wid; row < ROWS; row += nb * 8) {
        const bf16_t* ur = U + (size_t)row * NIN;
        const uint4 a = *(const uint4*)(ur + OFF_Q + lane * 8); const uint2 k = *(const uint2*)(ur + OFF_KV + lane * 4);
        const unsigned w[4] = {a.x, a.y, a.z, a.w}; float sq = 0.f, sk = 0.f;
#pragma unroll
        for (int i = 0; i < 4; ++i) { const float lo = __uint_as_float(w[i] << 16), hi = __uint_as_float(w[i] & 0xffff0000u); sq += lo * lo + hi * hi; }
        { const float lo0 = __uint_as_float(k.x << 16), hi0 = __uint_as_float(k.x & 0xffff0000u), lo1 = __uint_as_float(k.y << 16), hi1 = __uint_as_float(k.y & 0xffff0000u); sk = lo0 * lo0 + hi0 * hi0 + lo1 * lo1 + hi1 * hi1; }
        sq = wave_sum(sq); sk = wave_sum(sk);
        if (lane == 0) { RS[2 * row] = rsqrtf(sq * (1.f / QRANK) + EPS); RS[2 * row + 1] = rsqrtf(sk * (1.f / KVRANK) + EPS); }
    }
}
__device__ void ph_krope(const Params& p, int bid, int nb) {
    const int TX = otid();
    const bf16_t* U = WSP(bf16_t, WS_U); bf16_t* KB = WSP(bf16_t, WS_KB); const float* ROPE = WSP(float, WS_ROPE);
    for (int idx = bid * NT + TX; idx < ROWS * 8; idx += nb * NT) {
        const int row = idx >> 3, ch = idx & 7; const RowInfo r = rowinfo(row);
        const uint4 a = *(const uint4*)(U + (size_t)row * NIN + OFF_KR + ch * 8);
        const unsigned w[4] = {a.x, a.y, a.z, a.w}; unsigned o[4];
#pragma unroll
        for (int i = 0; i < 4; ++i) { float x0 = __uint_as_float(w[i] << 16), x1 = __uint_as_float(w[i] & 0xffff0000u);
            if (row < ROWS_L) { const float cs = ROPE[((size_t)r.t * 32 + ch * 4 + i) * 2], sn = ROPE[((size_t)r.t * 32 + ch * 4 + i) * 2 + 1]; const float y0 = x0 * cs - x1 * sn, y1 = x0 * sn + x1 * cs; x0 = y0; x1 = y1; }
            o[i] = (unsigned)f2bf(x0) | ((unsigned)f2bf(x1) << 16); }
#pragma unroll
        for (int h = 0; h < 8; ++h) *(uint4*)(KB + ((size_t)(r.b * NH + h) * LK + r.n) * 192 + 128 + ch * 8) = make_uint4(o[0], o[1], o[2], o[3]);
    }
}
__device__ void ph_shortconv(const Params& p, int l, int bid, int nb) {
    const int TX = otid();
    const act_t* U = WSP(act_t, WS_U); act_t* HC = WSP(act_t, WS_HC);
    const float* w = p.hy_conv_w + (size_t)l * 3 * 1536; const float* bb = p.hy_conv_b + l * 1536;
    for (size_t idx = (size_t)bid * NT + TX; idx < (size_t)ROWS_C * 1536; idx += (size_t)nb * NT) {
        const int row = ROWS_L + (int)(idx / 1536), c = (int)(idx % 1536);
        const RowInfo r = rowinfo(row);
        const float cur = ldf(U + (size_t)row * NIN + c);
        const float prev = r.t > 0 ? ldf(U + (size_t)(row - 1) * NIN + c) : 0.f;
        const float next = r.t < r.L - 1 ? ldf(U + (size_t)(row + 1) * NIN + c) : 0.f;
        stf(HC + (size_t)row * 1536 + c, prev * w[c] + cur * w[1536 + c] + next * w[3072 + c] + bb[c]);
    }
}
__device__ void ph_pooldiff(const Params& p, int bid, int nb) {
    const int TX = otid();
    const act_t* U = WSP(act_t, WS_U); act_t* PD = WSP(act_t, WS_PD);
    for (size_t idx = (size_t)bid * NT + TX; idx < (size_t)ROWS * 512; idx += (size_t)nb * NT) {
        const int row = (int)(idx >> 9), j = (int)(idx & 511);
        const RowInfo r = rowinfo(row);
        const int half = 1 << (j >> 7);
        const int lo = max(r.t - half, 0), hi = min(r.t + half, r.L);
        float s = 0;
        for (int q = lo; q < hi; ++q) s += ldf(U + (size_t)(row - r.t + q) * NIN + OFF_POOL + j);
        stf(PD + idx, s / (float)(hi - lo) - ldf(U + (size_t)row * NIN + OFF_POOL + j));
    }
}
__device__ void ph_poolgate(const Params& p, int l, int bid, int nb) {
    const int TX = otid();
    const act_t* U = WSP(act_t, WS_U); const act_t* PY = WSP(act_t, WS_PY); act_t* MIX = WSP(act_t, WS_MIX);
    for (size_t idx = (size_t)bid * NT + TX; idx < (size_t)ROWS * 512; idx += (size_t)nb * NT) {
        const int row = (int)(idx >> 9), j = (int)(idx & 511);
        stf(MIX + (size_t)row * DM + 1536 + j, ldf(PY + idx) * p.pool_scale[l * 512 + j] * silu_f(ldf(U + (size_t)row * NIN + OFF_POOL_G + j)));
    }
}
__device__ void ph_conv(const Params& p, int l, int order, int bid, int nb, float* sm) {
    const int TX = otid();
    float* Zs = sm; float* Ks = sm + 4096;
    const int tid = TX, c = tid & 63, tg = tid >> 6;
    const act_t* U = WSP(act_t, WS_U); const act_t* HC = WSP(act_t, WS_HC); act_t* Z2 = WSP(act_t, WS_Z2); act_t* MIX = WSP(act_t, WS_MIX);
    const act_t* zsrc = order == 0 ? HC : Z2; const int zld = order == 0 ? 1536 : 512;
    const int nlat = NB * (SEQ / 64) * 8, nctx = (l < DEPTH - 1) ? NB * (CTXL / 64) * 8 : 0;
    for (int u = nlat + bid; u < nlat + nctx; u += nb) {
        int Lidx, b, T0, c0, L, rowbase;
        if (u < nlat) { Lidx = 0; L = SEQ; b = u >> 8; T0 = ((u >> 3) & 31) * 64; c0 = (u & 7) * 64; rowbase = b * SEQ; }
        else { const int v = u - nlat; Lidx = 1; L = CTXL; b = v >> 5; T0 = ((v >> 3) & 3) * 64; c0 = (v & 7) * 64; rowbase = ROWS_L + b * CTXL; }
        const float* F = WSP(float, WS_FC) + ((size_t)l * 2 + order) * 2 * CTXL * 512;
        float acc[8];
#pragma unroll
        for (int i = 0; i < 8; ++i) acc[i] = 0.f;
        for (int S0 = 0; S0 < L; S0 += 64) {
            for (int i = tid; i < 4096; i += NT) { const int ss = i >> 6, cc = i & 63; Zs[i] = ldf(zsrc + (size_t)(rowbase + S0 + ss) * zld + c0 + cc); }
            for (int i = tid; i < 127 * 64; i += NT) { const int j = i >> 6, cc = i & 63; const int n = T0 - S0 + j - 63;
                Ks[i] = n >= 0 ? F[((size_t)0 * L + n) * 512 + c0 + cc] : F[((size_t)1 * L + (-n)) * 512 + c0 + cc]; }
            __syncthreads();
            for (int ss = 0; ss < 64; ++ss) { const float z = Zs[ss * 64 + c];
#pragma unroll
                for (int i = 0; i < 8; ++i) acc[i] += z * Ks[(tg * 8 + i - ss + 63) * 64 + c]; }
            __syncthreads();
        }
        const float scl = WSP(float, WS_FSCL)[(l * 2 + order) * 512 + c0 + c], bias = p.hy_bias[(l * 2 + order) * 512 + c0 + c]; (void)Lidx;
#pragma unroll
        for (int i = 0; i < 8; ++i) {
            const int row = rowbase + T0 + tg * 8 + i;
            const float zt = ldf(zsrc + (size_t)row * zld + c0 + c);
            const float y = scl * acc[i] + bias * zt;
            if (order == 0) stf(Z2 + (size_t)row * 512 + c0 + c, ldf(HC + (size_t)row * 1536 + 512 + c0 + c) * y);
            else stf(MIX + (size_t)row * DM + c0 + c, ldf(HC + (size_t)row * 1536 + 1024 + c0 + c) * y * silu_f(ldf(U + (size_t)row * NIN + OFF_HY_G + c0 + c)));
        }
    }
}

__device__ void ph_final(const Params& p, int bid, int nb) {
    const int TX = otid();
    const int lane = TX & 63, wid = TX >> 6, nw = NT >> 6;
    for (int row = bid * nw + wid; row < ROWS_L; row += nb * nw) {
        const float* xr = WSP(float, WS_XW) + (size_t)row * DM;
        float ss = 0;
#pragma unroll 2
        for (int j = 0; j < 8; ++j) { const float4 v = *(const float4*)(xr + (j * 64 + lane) * 4); ss += v.x * v.x + v.y * v.y + v.z * v.z + v.w * v.w; }
        ss = wave_sum(ss);
        const float rstd = rsqrtf(ss * (1.f / DM) + EPS);
#pragma unroll 1
        for (int j = 0; j < 8; ++j) { const int k = (j * 64 + lane) * 4; const float4 v = *(const float4*)(xr + k); const float4 g = *(const float4*)(p.final_norm_g + k);
            *(float4*)(p.out + (size_t)row * DM + k) = make_float4(v.x * rstd * g.x, v.y * rstd * g.y, v.z * rstd * g.z, v.w * rstd * g.w); }
    }
}

namespace pg8 {
#define PG8_LAS __attribute__((address_space(3)))
typedef unsigned short bf16_t;
typedef short bf16x8 __attribute__((ext_vector_type(8)));
typedef float f32x4 __attribute__((ext_vector_type(4)));
typedef unsigned u32x4 __attribute__((ext_vector_type(4)));
constexpr int BM = 256, BK = 64, HALF = 128, HTB = HALF * BK * 2  , STAGE_BYTES = 8 * HTB, NXCD = 8, WGM = 8;

__host__ __device__ __forceinline__ int lds_byte(int r, int c) { const int st = (r >> 4) * 2 + (c >> 5), rr = r & 15, cc = c & 31, ob = rr * 64 + cc * 2; return st * 1024 + (ob ^ (((ob >> 9) & 1) << 5)); }
__host__ __device__ __forceinline__ void stage_rc(int b, int& R, int& C) { const int st = b / 1024, sb = b % 1024, swz = sb ^ (((sb >> 9) & 1) << 5); R = (st >> 1) * 16 + swz / 64; C = (st & 1) * 32 + (swz % 64) / 2; }
__host__ __device__ __forceinline__ int perm32(int rho) { const int n = rho >> 4, i = rho & 15; return 8 * (i >> 2) + 4 * n + (i & 3); }

struct Unit { int pm, pn; };
struct Gemm { const bf16_t* A; const bf16_t* Bt; int M, N, K, lda; };

struct StaticOrder {
    int nM, nN, nwg, G, c;
    __host__ __device__ void init(int M, int N, int G_, int c_) { nM = M / BM; nN = N / BM; nwg = nM * nN; G = G_; c = c_; }
    __host__ __device__ bool next(int i, Unit& u) const {
        const long L = (long)i * G + c; if (L >= nwg) return false;
        int wgid = (int)L; { const int q = nwg / NXCD, r = nwg % NXCD, xcd = wgid % NXCD, off = wgid / NXCD; wgid = (xcd < r ? xcd * (q + 1) : r * (q + 1) + (xcd - r) * q) + off; }
        const int nig = WGM * nN, gid = wgid / nig, fm = gid * WGM, gsz = (nM - fm) < WGM ? (nM - fm) : WGM;
        u.pm = fm + ((wgid % nig) % gsz); u.pn = (wgid % nig) / gsz; return true;
    }
    __device__ __forceinline__ void a_ready(const Unit&) const {}
    __device__ __forceinline__ void done(const Unit&) const {}
};

__device__ __forceinline__ unsigned cvt_pk_bf16(float lo, float hi) { unsigned r; asm volatile("v_cvt_pk_bf16_f32 %0, %1, %2" : "=v"(r) : "v"(lo), "v"(hi)); return r; }

typedef unsigned u32x4_t __attribute__((ext_vector_type(4)));
struct EpiStoreBf16 {
    static constexpr bool PERM = true, AFTER_DRAIN = false;
    bf16_t* O; int ldc; int ncols;
    __device__ __forceinline__ void operator()(const f32x4 (&acc)[2][2][4][2], const Unit& u, int wr, int wc, int fr, int fq) const {
        const int row0 = u.pm * BM + wr * 64 + fr, col0 = u.pn * BM + wc * 32 + 8 * fq;
#pragma unroll
        for (int ai = 0; ai < 2; ++ai)
#pragma unroll
            for (int m = 0; m < 4; ++m) { bf16_t* rowp = O + (size_t)(row0 + ai * HALF + m * 16) * ldc + col0;
#pragma unroll
                for (int bj = 0; bj < 2; ++bj) { if (col0 + bj * HALF < ncols) { const f32x4 v0 = acc[ai][bj][m][0], v1 = acc[ai][bj][m][1];
                    u32x4_t w; w.x = cvt_pk_bf16(v0[0], v0[1]); w.y = cvt_pk_bf16(v0[2], v0[3]); w.z = cvt_pk_bf16(v1[0], v1[1]); w.w = cvt_pk_bf16(v1[2], v1[3]);
                    *(u32x4_t*)(rowp + bj * HALF) = w; } } }
    }
};


struct EpiU {
    static constexpr bool PERM = true, AFTER_DRAIN = false;
    bf16_t* U; bf16_t* UT; float* SSP; int ldc, ncols, rows;
    __device__ __forceinline__ void operator()(const f32x4 (&acc)[2][2][4][2], const Unit& u, int wr, int wc, int fr, int fq) const {
        const int row0 = u.pm * BM + wr * 64 + fr, col0 = u.pn * BM + wc * 32 + 8 * fq;
        if (u.pn < 8) {
#pragma unroll
            for (int ai = 0; ai < 2; ++ai)
#pragma unroll
                for (int m = 0; m < 4; ++m) { bf16_t* cp = UT + (size_t)col0 * rows + row0 + ai * HALF + m * 16;
#pragma unroll
                    for (int bj = 0; bj < 2; ++bj)
#pragma unroll
                        for (int n = 0; n < 2; ++n) { const f32x4 v = acc[ai][bj][m][n]; const unsigned w0 = cvt_pk_bf16(v[0], v[1]), w1 = cvt_pk_bf16(v[2], v[3]);
                            bf16_t* q = cp + (size_t)(bj * HALF + 4 * n) * rows;
                            q[0] = (bf16_t)(w0 & 0xffffu); q[rows] = (bf16_t)(w0 >> 16); q[2 * (size_t)rows] = (bf16_t)(w1 & 0xffffu); q[3 * (size_t)rows] = (bf16_t)(w1 >> 16); } }
            return;
        }
        const bool stat = u.pn <= 10;
#pragma unroll
        for (int ai = 0; ai < 2; ++ai)
#pragma unroll
            for (int m = 0; m < 4; ++m) { const int row = row0 + ai * HALF + m * 16; bf16_t* rowp = U + (size_t)row * ldc + col0; float ss = 0.f;
#pragma unroll
                for (int bj = 0; bj < 2; ++bj) { if (col0 + bj * HALF < ncols) { const f32x4 v0 = acc[ai][bj][m][0], v1 = acc[ai][bj][m][1];
                    ss += (v0[0] * v0[0] + v0[1] * v0[1]) + (v0[2] * v0[2] + v0[3] * v0[3]) + (v1[0] * v1[0] + v1[1] * v1[1]) + (v1[2] * v1[2] + v1[3] * v1[3]);
                    u32x4_t w; w.x = cvt_pk_bf16(v0[0], v0[1]); w.y = cvt_pk_bf16(v0[2], v0[3]); w.z = cvt_pk_bf16(v1[0], v1[1]); w.w = cvt_pk_bf16(v1[2], v1[3]);
                    *(u32x4_t*)(rowp + bj * HALF) = w; } }
                if (stat) { ss += __shfl_xor(ss, 16); ss += __shfl_xor(ss, 32);
                    if (fq == 0) SSP[(size_t)row * 12 + (u.pn - 8) * 4 + wc] = ss; } }
    }
};
struct EpiQ {
    static constexpr bool PERM = true, AFTER_DRAIN = false;
    bf16_t* Q; const float* RS; const float* ROPE;
    __device__ __forceinline__ void operator()(const f32x4 (&acc)[2][2][4][2], const Unit& u, int wr, int wc, int fr, int fq) const {
        const int row0 = u.pm * BM + wr * 64 + fr, col0 = u.pn * BM + wc * 32 + 8 * fq;
#pragma unroll
        for (int ai = 0; ai < 2; ++ai)
#pragma unroll
            for (int m = 0; m < 4; ++m) { const int row = row0 + ai * HALF + m * 16; const bool lat = row < 8192;
                const int b = lat ? (row >> 11) : ((row - 8192) >> 8), n = lat ? (row & 2047) : 2048 + ((row - 8192) & 255);
                const float* sp = RS + (size_t)row * 12; const float rs = rsqrtf((((sp[0] + sp[1]) + (sp[2] + sp[3])) + ((sp[4] + sp[5]) + (sp[6] + sp[7]))) * (1.f / 512.f) + 1e-6f);
#pragma unroll
                for (int bj = 0; bj < 2; ++bj) { const int col = col0 + bj * HALF, h = col / 192, d = col - h * 192;
                    f32x4 v0 = acc[ai][bj][m][0] * rs, v1 = acc[ai][bj][m][1] * rs;
                    if (d >= 128 && lat) { const float* rp = ROPE + ((size_t)n * 32 + ((d - 128) >> 1)) * 2; const f32x4 r0 = *(const f32x4*)rp, r1 = *(const f32x4*)(rp + 4);
                        const f32x4 a0 = v0, a1 = v1;
                        v0[0] = a0[0] * r0[0] - a0[1] * r0[1]; v0[1] = a0[0] * r0[1] + a0[1] * r0[0]; v0[2] = a0[2] * r0[2] - a0[3] * r0[3]; v0[3] = a0[2] * r0[3] + a0[3] * r0[2];
                        v1[0] = a1[0] * r1[0] - a1[1] * r1[1]; v1[1] = a1[0] * r1[1] + a1[1] * r1[0]; v1[2] = a1[2] * r1[2] - a1[3] * r1[3]; v1[3] = a1[2] * r1[3] + a1[3] * r1[2]; }
                    u32x4_t w; w.x = cvt_pk_bf16(v0[0], v0[1]); w.y = cvt_pk_bf16(v0[2], v0[3]); w.z = cvt_pk_bf16(v1[0], v1[1]); w.w = cvt_pk_bf16(v1[2], v1[3]);
                    *(u32x4_t*)(Q + ((size_t)(b * 8 + h) * 2304 + n) * 192 + d) = w; } }
    }
};
struct EpiKV {
    static constexpr bool PERM = true, AFTER_DRAIN = false;
    bf16_t* KB; bf16_t* VB; const float* RS;
    __device__ __forceinline__ void operator()(const f32x4 (&acc)[2][2][4][2], const Unit& u, int wr, int wc, int fr, int fq) const {
        const int row0 = u.pm * BM + wr * 64 + fr, col0 = u.pn * BM + wc * 32 + 8 * fq;
#pragma unroll
        for (int ai = 0; ai < 2; ++ai)
#pragma unroll
            for (int m = 0; m < 4; ++m) { const int row = row0 + ai * HALF + m * 16; const bool lat = row < 8192;
                const int b = lat ? (row >> 11) : ((row - 8192) >> 8), n = lat ? (row & 2047) : 2048 + ((row - 8192) & 255);
                const float* sp = RS + (size_t)row * 12 + 8; const float rs = rsqrtf(((sp[0] + sp[1]) + (sp[2] + sp[3])) * (1.f / 256.f) + 1e-6f);
#pragma unroll
                for (int bj = 0; bj < 2; ++bj) { const int col = col0 + bj * HALF, h = col >> 8, d = col & 255;
                    const f32x4 v0 = acc[ai][bj][m][0] * rs, v1 = acc[ai][bj][m][1] * rs;
                    u32x4_t w; w.x = cvt_pk_bf16(v0[0], v0[1]); w.y = cvt_pk_bf16(v0[2], v0[3]); w.z = cvt_pk_bf16(v1[0], v1[1]); w.w = cvt_pk_bf16(v1[2], v1[3]);
                    const size_t pos = (size_t)(b * 8 + h) * 2304 + n;
                    if (d < 128) *(u32x4_t*)(KB + pos * 192 + d) = w; else *(u32x4_t*)(VB + pos * 128 + (d - 128)) = w; } }
    }
};
struct EpiResid {
    static constexpr bool PERM = false, AFTER_DRAIN = false;
    const float* xl; const float* xc; float* XW; const float* gate;
    __device__ __forceinline__ void operator()(const f32x4 (&acc)[2][2][4][2], const Unit& u, int wr, int wc, int fr, int fq) const {
        const int col0 = u.pn * BM + wc * 32 + 4 * fq;
#pragma unroll
        for (int ai = 0; ai < 2; ++ai)
#pragma unroll
            for (int m = 0; m < 4; ++m) { const int row = u.pm * BM + ai * HALF + wr * 64 + m * 16 + fr;
                const float* xr = row < 8192 ? xl + (size_t)row * 2048 : xc + (size_t)(row - 8192) * 2048;
                const float* g = gate + (size_t)(row < 8192 ? (row >> 11) : 4) * 6144;
                float* o = XW + (size_t)row * 2048;
#pragma unroll
                for (int bj = 0; bj < 2; ++bj)
#pragma unroll
                    for (int n = 0; n < 2; ++n) { const int c = col0 + bj * HALF + n * 16;
                        const f32x4 xv = *(const f32x4*)(xr + c), gv = *(const f32x4*)(g + c);
                        *(f32x4*)(o + c) = xv + gv * acc[ai][bj][m][n]; } }
    }
};

template <class Epi, class Sched, bool ALIGN_EPI = false, bool SP2 = false>
__device__ __forceinline__ void gemm_phase(PG8_LAS unsigned char* lds, const Gemm g, const Sched& S, const Epi& E) {
    int tid_ = threadIdx.x; asm volatile("" : "+v"(tid_));
    const int tid = tid_, wid = __builtin_amdgcn_readfirstlane(tid >> 6), lane = tid & 63, wr = wid >> 2, wc = wid & 3, fr = lane & 15, fq = lane >> 4;
    const int K = g.K, nt = K / BK;
    unsigned voffA[2], voffB[2];
#pragma unroll
    for (int i = 0; i < 2; ++i) { int R, C; stage_rc(tid * 16 + i * 8192, R, C); const int Rb = Epi::PERM ? ((R & ~31) + perm32(R & 31)) : R;
        voffA[i] = (unsigned)(R * g.lda + C) * 2u; voffB[i] = (unsigned)(Rb * K + C) * 2u; }
    const size_t kstep = (size_t)(BK * 2);
    const size_t hstep = (size_t)HALF * K * 2;
    const size_t tstep = 2 * hstep;
    const size_t hstepA = (size_t)HALF * g.lda * 2, tstepA = 2 * hstepA;
    const unsigned ldsw = (unsigned)wid * 1024u;
    const int aoff = lds_byte(wr * 64 + fr, fq * 8), boff = lds_byte(wc * 32 + fr, fq * 8);
#define PG8_SA(b, h) (((b) * 2 + (h)) * HTB)
#define PG8_SB(b, h) ((4 + (b) * 2 + (h)) * HTB)
#define PG8_STAGE(bufoff, gbase, voff) do { _Pragma("unroll") for (int _i = 0; _i < 2; ++_i) \
        __builtin_amdgcn_global_load_lds((const unsigned*)((const char*)(gbase) + (voff)[_i]), (PG8_LAS unsigned*)(lds + (bufoff) + ldsw + _i * 8192), 16, 0, 0); } while (0)
#define PG8_LDA(dst, b, h) do { _Pragma("unroll") for (int m = 0; m < 4; ++m) _Pragma("unroll") for (int k = 0; k < 2; ++k) dst[m][k] = *(const PG8_LAS bf16x8*)(lds + PG8_SA(b, h) + aoff + m * 2048 + k * 1024); } while (0)
#define PG8_LDB(dst, b, h) do { _Pragma("unroll") for (int n = 0; n < 2; ++n) _Pragma("unroll") for (int k = 0; k < 2; ++k) dst[n][k] = *(const PG8_LAS bf16x8*)(lds + PG8_SB(b, h) + boff + n * 2048 + k * 1024); } while (0)
#define PG8_MMA(ai, bj, At, Bt) do { __builtin_amdgcn_s_setprio(1); _Pragma("unroll") for (int m = 0; m < 4; ++m) _Pragma("unroll") for (int n = 0; n < 2; ++n) _Pragma("unroll") for (int k = 0; k < 2; ++k) \
        acc[ai][bj][m][n] = __builtin_amdgcn_mfma_f32_16x16x32_bf16(Bt[n][k], At[m][k], acc[ai][bj][m][n], 0, 0, 0); __builtin_amdgcn_s_setprio(0); } while (0)
#define PG8_WAIT_V(n) asm volatile("s_waitcnt vmcnt(" #n ")" ::: "memory")
#define PG8_WAIT_L(n) asm volatile("s_waitcnt lgkmcnt(" #n ")" ::: "memory")
#define PG8_BAR __builtin_amdgcn_s_barrier()
#define PG8_SCHED __builtin_amdgcn_sched_barrier(0)
    Unit cur, nxt; int ui = 0;
    if (!S.next(0, cur)) return;
    f32x4 acc[2][2][4][2];
#pragma unroll
    for (int a = 0; a < 2; ++a)
#pragma unroll
        for (int b = 0; b < 2; ++b)
#pragma unroll
            for (int m = 0; m < 4; ++m)
#pragma unroll
                for (int n = 0; n < 2; ++n) acc[a][b][m][n] = (f32x4){0.f, 0.f, 0.f, 0.f};
    bf16x8 At[4][2], B0[2][2], B1[2][2];
    const char* cA = (const char*)g.A + (size_t)cur.pm * tstepA; const char* cB = (const char*)g.Bt + (size_t)cur.pn * tstep;
    S.a_ready(cur);
    if constexpr (SP2) {
        PG8_STAGE(PG8_SB(0, 0), cB, voffB); PG8_STAGE(PG8_SB(0, 1), cB + hstep, voffB); PG8_STAGE(PG8_SA(0, 0), cA, voffA); PG8_STAGE(PG8_SA(0, 1), cA + hstepA, voffA);
        if (wr == 1) PG8_BAR;
        PG8_WAIT_V(2); PG8_BAR;
        PG8_STAGE(PG8_SB(1, 0), cB + kstep, voffB); PG8_STAGE(PG8_SA(1, 0), cA + kstep, voffA); PG8_STAGE(PG8_SB(1, 1), cB + hstep + kstep, voffB);
        PG8_WAIT_V(6); PG8_BAR;
    } else {
        PG8_STAGE(PG8_SB(0, 0), cB, voffB); PG8_STAGE(PG8_SA(0, 0), cA, voffA); PG8_STAGE(PG8_SB(0, 1), cB + hstep, voffB); PG8_STAGE(PG8_SA(0, 1), cA + hstepA, voffA);
        if (wr == 1) PG8_BAR;
        PG8_WAIT_V(4); PG8_BAR;
        PG8_STAGE(PG8_SB(1, 0), cB + kstep, voffB); PG8_STAGE(PG8_SA(1, 0), cA + kstep, voffA); PG8_STAGE(PG8_SB(1, 1), cB + hstep + kstep, voffB);
        PG8_WAIT_V(6); PG8_BAR;
    }
    for (;;) {
        const bool has_next = S.next(ui + 1, nxt);
        const char* nA = has_next ? (const char*)g.A + (size_t)nxt.pm * tstepA : cA; const char* nB = has_next ? (const char*)g.Bt + (size_t)nxt.pn * tstep : cB;
        for (int t = 0; t < nt; t += 2) {
            const bool last = (t == nt - 2);
            const char* a1 = cA + (size_t)(t + 1) * kstep;
            const char* a2 = last ? nA : cA + (size_t)(t + 2) * kstep; const char* b2 = last ? nB : cB + (size_t)(t + 2) * kstep;
            const char* a3 = a2 + kstep; const char* b3 = b2 + kstep;
            if (last && has_next) S.a_ready(nxt);
            if constexpr (SP2) {
            PG8_LDB(B0, 0, 0); PG8_LDB(B1, 0, 1); PG8_SCHED; PG8_LDA(At, 0, 0); PG8_STAGE(PG8_SA(1, 1), a1 + hstepA, voffA);
            PG8_WAIT_V(8); PG8_WAIT_L(0); PG8_BAR; PG8_MMA(0, 0, At, B0); PG8_MMA(0, 1, At, B1); PG8_BAR; PG8_SCHED;
            PG8_LDA(At, 0, 1); PG8_STAGE(PG8_SB(0, 0), b2, voffB); PG8_STAGE(PG8_SB(0, 1), b2 + hstep, voffB); PG8_STAGE(PG8_SA(0, 0), a2, voffA);
            PG8_WAIT_V(8); PG8_WAIT_L(0); PG8_BAR; PG8_MMA(1, 0, At, B0); PG8_MMA(1, 1, At, B1); PG8_BAR; PG8_SCHED;
            PG8_LDB(B0, 1, 0); PG8_LDB(B1, 1, 1); PG8_SCHED; PG8_LDA(At, 1, 0); PG8_STAGE(PG8_SA(0, 1), a2 + hstepA, voffA);
            PG8_WAIT_V(8); PG8_WAIT_L(0); PG8_BAR; PG8_MMA(0, 0, At, B0); PG8_MMA(0, 1, At, B1); PG8_BAR; PG8_SCHED;
            PG8_LDA(At, 1, 1); PG8_STAGE(PG8_SB(1, 0), b3, voffB); PG8_STAGE(PG8_SB(1, 1), b3 + hstep, voffB); PG8_STAGE(PG8_SA(1, 0), a3, voffA);
            PG8_WAIT_V(8); PG8_WAIT_L(0); PG8_BAR; PG8_MMA(1, 0, At, B0); PG8_MMA(1, 1, At, B1); PG8_BAR; PG8_SCHED;
            } else {
            PG8_LDB(B0, 0, 0); PG8_SCHED; PG8_LDA(At, 0, 0); PG8_STAGE(PG8_SA(1, 1), a1 + hstepA, voffA);
            PG8_WAIT_L(8); PG8_BAR; PG8_WAIT_L(0); PG8_MMA(0, 0, At, B0); PG8_BAR; PG8_SCHED;
            PG8_LDB(B1, 0, 1); PG8_STAGE(PG8_SB(0, 0), b2, voffB);
            PG8_BAR; PG8_WAIT_L(0); PG8_MMA(0, 1, At, B1); PG8_BAR;
            PG8_LDA(At, 0, 1); PG8_STAGE(PG8_SA(0, 0), a2, voffA);
            PG8_BAR; PG8_WAIT_L(0); PG8_MMA(1, 0, At, B0); PG8_BAR; PG8_SCHED;
            PG8_STAGE(PG8_SB(0, 1), b2 + hstep, voffB);
            PG8_WAIT_V(6); PG8_BAR; PG8_MMA(1, 1, At, B1); PG8_BAR;
            PG8_LDB(B0, 1, 0); PG8_SCHED; PG8_LDA(At, 1, 0); PG8_STAGE(PG8_SA(0, 1), a2 + hstepA, voffA);
            PG8_WAIT_L(8); PG8_BAR; PG8_WAIT_L(0); PG8_MMA(0, 0, At, B0); PG8_BAR; PG8_SCHED;
            PG8_LDB(B1, 1, 1); PG8_STAGE(PG8_SB(1, 0), b3, voffB);
            PG8_BAR; PG8_WAIT_L(0); PG8_MMA(0, 1, At, B1); PG8_BAR;
            PG8_LDA(At, 1, 1); PG8_STAGE(PG8_SA(1, 0), a3, voffA);
            PG8_BAR; PG8_WAIT_L(0); PG8_MMA(1, 0, At, B0); PG8_BAR; PG8_SCHED;
            PG8_STAGE(PG8_SB(1, 1), b3 + hstep, voffB);
            PG8_WAIT_V(6); PG8_BAR; PG8_MMA(1, 1, At, B1); PG8_BAR;
            }
        }
        if constexpr (ALIGN_EPI) { if (wr == 0) PG8_BAR; }
        if constexpr (!Epi::AFTER_DRAIN) { E(acc, cur, wr, wc, fr, fq); S.done(cur); }
        if (!has_next) break;
#pragma unroll
        for (int a = 0; a < 2; ++a)
#pragma unroll
            for (int b = 0; b < 2; ++b)
#pragma unroll
                for (int m = 0; m < 4; ++m)
#pragma unroll
                    for (int n = 0; n < 2; ++n) acc[a][b][m][n] = (f32x4){0.f, 0.f, 0.f, 0.f};
        cur = nxt; cA = nA; cB = nB; ++ui;
        if constexpr (ALIGN_EPI) { if (wr == 1) PG8_BAR; }
    }
    PG8_WAIT_V(0);
    if constexpr (!ALIGN_EPI) { if (wr == 0) PG8_BAR; }
    PG8_BAR;
    if constexpr (Epi::AFTER_DRAIN) { E.fused(acc, cur, wr, wc, fr, fq, lds, wid, lane); S.done(cur); }
#undef PG8_SA
#undef PG8_SB
#undef PG8_STAGE
#undef PG8_LDA
#undef PG8_LDB
#undef PG8_MMA
#undef PG8_WAIT_V
#undef PG8_WAIT_L
#undef PG8_BAR
#undef PG8_SCHED
}
}


namespace att {
using bf16x8 = __attribute__((ext_vector_type(8))) short;
using s16x4  = __attribute__((ext_vector_type(4))) short;
using f32x16 = __attribute__((ext_vector_type(16))) float;
using u32x4  = __attribute__((ext_vector_type(4))) unsigned;
constexpr int QBLK = 32, KVBLK = 64, NW = 8;
constexpr float SCALE = 0.07216878364870322f, THR = 8.f;
constexpr int SHM_V = 16384, SHM_KN = 16384, SHM_KR = 8192;
constexpr int OFF_V = 0, OFF_KN = 2 * SHM_V, OFF_KR = OFF_KN + 2 * SHM_KN, OFF_WS = OFF_KR + 2 * SHM_KR, OFF_QR = OFF_WS + NW * 64 * 4, SHM_TOTAL = OFF_QR + NW * 4096;
#define KSWZ(row, colB) ((row) * 256 + ((colB) ^ (((row) & 7) << 4)))
#define RSWZ(row, ch) ((row) * 128 + ((((ch) ^ (((row) >> 1) & 7))) << 4))
#define SBAR() __builtin_amdgcn_sched_barrier(0)
__device__ __forceinline__ int crow(int r, int hi) { return (r & 3) + 8 * (r >> 2) + 4 * hi; }
__device__ __forceinline__ unsigned cvtpk(float lo, float hi) { unsigned r; asm volatile("v_cvt_pk_bf16_f32 %0, %1, %2" : "=v"(r) : "v"(lo), "v"(hi)); return r; }
__device__ __forceinline__ bf16x8 ld8(const bf16_t* p) { return *reinterpret_cast<const bf16x8*>(p); }

__device__ __forceinline__ void partialSM(f32x16& p0, f32x16& p1, float& m_reg, float& mn, float& alpha) {
  constexpr float C = SCALE * 1.4426950408889634f;
  float pmax = p0[0];
#pragma unroll
  for (int r = 1; r < 16; ++r) pmax = fmaxf(pmax, p0[r]);
#pragma unroll
  for (int r = 0; r < 16; ++r) pmax = fmaxf(pmax, p1[r]);
  { auto rr = __builtin_amdgcn_permlane32_swap(__float_as_uint(pmax), __float_as_uint(pmax), false, false);
    pmax = fmaxf(__uint_as_float(rr[0]), __uint_as_float(rr[1])); }
  if (__builtin_expect(__all(pmax - m_reg <= THR / SCALE), 1)) { mn = m_reg; alpha = 1.f; }
  else { mn = fmaxf(m_reg, pmax); alpha = __builtin_amdgcn_exp2f((m_reg - mn) * C); m_reg = mn; }
  const float mnC = -mn * C;
#pragma unroll
  for (int r = 0; r < 16; ++r) p0[r] = fmaf(p0[r], C, mnC);
#pragma unroll
  for (int r = 0; r < 16; ++r) p1[r] = fmaf(p1[r], C, mnC);
#pragma unroll
  for (int r = 0; r < 16; ++r) p0[r] = __builtin_amdgcn_exp2f(p0[r]);
}
__device__ __forceinline__ void finishSM(f32x16& p0, f32x16& p1, float alpha, float& l_reg, bf16x8& pa0, bf16x8& pa1, bf16x8& pa2, bf16x8& pa3) {
#pragma unroll
  for (int r = 0; r < 16; ++r) p1[r] = __builtin_amdgcn_exp2f(p1[r]);
  float ps = 0;
#pragma unroll
  for (int r = 0; r < 16; ++r) ps += p0[r];
#pragma unroll
  for (int r = 0; r < 16; ++r) ps += p1[r];
  { auto rr = __builtin_amdgcn_permlane32_swap(__float_as_uint(ps), __float_as_uint(ps), false, false);
    ps = __uint_as_float(rr[0]) + __uint_as_float(rr[1]); }
  l_reg = l_reg * alpha + ps;
#define PK4(P, BASE, OUT) do { unsigned a0 = cvtpk(P[BASE + 0], P[BASE + 1]), a1 = cvtpk(P[BASE + 2], P[BASE + 3]);   \
    unsigned b0 = cvtpk(P[BASE + 4], P[BASE + 5]), b1 = cvtpk(P[BASE + 6], P[BASE + 7]);                              \
    auto r0 = __builtin_amdgcn_permlane32_swap(a0, b0, false, false); auto r1 = __builtin_amdgcn_permlane32_swap(a1, b1, false, false); \
    u32x4 w = {r0[0], r1[0], r0[1], r1[1]}; OUT = *reinterpret_cast<bf16x8*>(&w); } while (0)
  PK4(p0, 0, pa0); PK4(p0, 8, pa1); PK4(p1, 0, pa2); PK4(p1, 8, pa3);
#undef PK4
}
__device__ __forceinline__ void qkt(f32x16& p0, f32x16& p1, const char* Kn, const char* Kr, const bf16x8* qr, const char* qrl, int r32, int hi) {
  p0 = f32x16{}; p1 = f32x16{};
#pragma unroll
  for (int d0 = 0; d0 < 8; ++d0) { const int cb = (d0 * 16 + hi * 8) * 2;
    const bf16x8 b0 = *reinterpret_cast<const bf16x8*>(Kn + KSWZ(r32, cb));
    const bf16x8 b1 = *reinterpret_cast<const bf16x8*>(Kn + KSWZ(32 + r32, cb));
    p0 = __builtin_amdgcn_mfma_f32_32x32x16_bf16(b0, qr[d0], p0, 0, 0, 0);
    p1 = __builtin_amdgcn_mfma_f32_32x32x16_bf16(b1, qr[d0], p1, 0, 0, 0); }
#pragma unroll
  for (int d0 = 0; d0 < 4; ++d0) { const int ch = d0 * 2 + hi;
    const bf16x8 b0 = *reinterpret_cast<const bf16x8*>(Kr + RSWZ(r32, ch));
    const bf16x8 b1 = *reinterpret_cast<const bf16x8*>(Kr + RSWZ(32 + r32, ch));
    const bf16x8 qv = *reinterpret_cast<const bf16x8*>(qrl + d0 * 1024);
    p0 = __builtin_amdgcn_mfma_f32_32x32x16_bf16(b0, qv, p0, 0, 0, 0);
    p1 = __builtin_amdgcn_mfma_f32_32x32x16_bf16(b1, qv, p1, 0, 0, 0); }
}
__device__ __forceinline__ int v_st(int k, int c) { const int kk = (k & ~0xC) | ((k & 4) << 1) | ((k & 8) >> 1); return ((kk >> 3) * 4 + (c >> 5)) * 512 + ((kk & 7) * 32 + (c & 31)) * 2; }
__device__ __forceinline__ int v_rd_base(int lane) { return ((lane & 3) << 3) | (((lane >> 2) & 3) << 6) | (((lane >> 4) & 1) << 5) | (((lane >> 5) & 1) << 8); }
constexpr int v_rd_off(int d0, int ks, int half) { return d0 * 512 + ks * 4096 + half * 2048; }
template <int OFF> __device__ __forceinline__ s16x4 tr_read(int vb) {
  s16x4 r; asm volatile("ds_read_b64_tr_b16 %0, %1 offset:%2" : "=&v"(r) : "v"(vb), "i"(OFF) : "memory"); return r;
}
template <int D0> __device__ __forceinline__ void pv_one(f32x16& od, int vb, bf16x8 pa0, bf16x8 pa1, bf16x8 pa2, bf16x8 pa3) {
  const s16x4 l0 = tr_read<v_rd_off(D0, 0, 0)>(vb), h0 = tr_read<v_rd_off(D0, 0, 1)>(vb), l1 = tr_read<v_rd_off(D0, 1, 0)>(vb), h1 = tr_read<v_rd_off(D0, 1, 1)>(vb);
  const s16x4 l2 = tr_read<v_rd_off(D0, 2, 0)>(vb), h2 = tr_read<v_rd_off(D0, 2, 1)>(vb), l3 = tr_read<v_rd_off(D0, 3, 0)>(vb), h3 = tr_read<v_rd_off(D0, 3, 1)>(vb);
  asm volatile("s_waitcnt lgkmcnt(0)" ::: "memory"); SBAR();
#define PK(L, H) (bf16x8){L[0], L[1], L[2], L[3], H[0], H[1], H[2], H[3]}
  od = __builtin_amdgcn_mfma_f32_32x32x16_bf16(pa0, PK(l0, h0), od, 0, 0, 0);
  od = __builtin_amdgcn_mfma_f32_32x32x16_bf16(pa1, PK(l1, h1), od, 0, 0, 0);
  od = __builtin_amdgcn_mfma_f32_32x32x16_bf16(pa2, PK(l2, h2), od, 0, 0, 0);
  od = __builtin_amdgcn_mfma_f32_32x32x16_bf16(pa3, PK(l3, h3), od, 0, 0, 0);
#undef PK
}
__device__ __forceinline__ void pv_d0(f32x16* o, int vb, bf16x8 pa0, bf16x8 pa1, bf16x8 pa2, bf16x8 pa3) {
  pv_one<0>(o[0], vb, pa0, pa1, pa2, pa3); pv_one<1>(o[1], vb, pa0, pa1, pa2, pa3); pv_one<2>(o[2], vb, pa0, pa1, pa2, pa3); pv_one<3>(o[3], vb, pa0, pa1, pa2, pa3);
}
__device__ __forceinline__ void attn_unit(const bf16_t* __restrict__ Qb, const bf16_t* __restrict__ Kh, const bf16_t* __restrict__ Vh, int seq,
                                          bf16_t* __restrict__ Mo, const bf16_t* __restrict__ G, char* lds) {
  int tid_ = threadIdx.x; asm volatile("" : "+v"(tid_));
  const int tid = tid_, wid = tid >> 6, lane = tid & 63, r32 = lane & 31, hi = lane >> 5;
  char* V_lds = lds + OFF_V; char* KN_lds = lds + OFF_KN; char* KR_lds = lds + OFF_KR;
  float* ws = (float*)(lds + OFF_WS) + wid * 64; float* li_l = ws; float* al_l = ws + 32;
  float m_reg = -1e30f, l_reg = 0; f32x16 o[4] = {}; bf16x8 qr[8];
  const bf16_t* Qw = Qb + (long)(wid * QBLK + r32) * 192 + hi * 8;
  char* qrl = lds + OFF_QR + wid * 4096 + lane * 16;
#pragma unroll
  for (int d0 = 0; d0 < 8; ++d0) qr[d0] = ld8(Qw + d0 * 16);
#pragma unroll
  for (int d0 = 0; d0 < 4; ++d0) *reinterpret_cast<bf16x8*>(qrl + d0 * 1024) = ld8(Qw + (8 + d0) * 16);
  const int sr = tid >> 4, sc = (tid & 15) * 8, vst0 = v_st(sr, sc), vst1 = v_st(32 + sr, sc);
  const int rr_ = tid >> 3, rch = tid & 7;
  const int vb0 = (int)(uintptr_t)V_lds + v_rd_base(lane);
  bf16x8 vs0, vs1, ks0, ks1, kr0;
  const int vo0 = sr * 128 + sc, ko0 = sr * 192 + sc, kro = rr_ * 192 + 128 + rch * 8;
#define SLOAD(k0) do { const bf16_t* vt_ = Vh + (long)(k0) * 128; const bf16_t* kt_ = Kh + (long)(k0) * 192; \
    vs0 = ld8(vt_ + vo0); vs1 = ld8(vt_ + vo0 + 32 * 128); ks0 = ld8(kt_ + ko0); ks1 = ld8(kt_ + ko0 + 32 * 192); kr0 = ld8(kt_ + kro); } while (0)
#define SWRITE(b) do { *(bf16x8*)(V_lds + (b) * SHM_V + vst0) = vs0; *(bf16x8*)(V_lds + (b) * SHM_V + vst1) = vs1; const int kc = sc * 2; \
    *(bf16x8*)(KN_lds + (b) * SHM_KN + KSWZ(sr, kc)) = ks0; *(bf16x8*)(KN_lds + (b) * SHM_KN + KSWZ(32 + sr, kc)) = ks1; \
    *(bf16x8*)(KR_lds + (b) * SHM_KR + RSWZ(rr_, rch)) = kr0; } while (0)
#define SWAIT() asm volatile("s_waitcnt vmcnt(0)" ::: "memory")
#define RESC(a) do { if (__any((a) < 1.f)) { if (hi == 0) al_l[r32] = (a); asm volatile("s_waitcnt lgkmcnt(0)" ::: "memory"); \
    _Pragma("unroll") for (int d = 0; d < 4; ++d) _Pragma("unroll") for (int r = 0; r < 16; ++r) o[d][r] *= al_l[crow(r, hi)]; } } while (0)
  f32x16 pA0, pA1, pB0, pB1; float mnA, mnB, alA, alB; bf16x8 pa0, pa1, pa2, pa3; const int NTL = seq / KVBLK;
  SLOAD(0); SWAIT(); SWRITE(0); __syncthreads();
  qkt(pA0, pA1, KN_lds, KR_lds, qr, qrl, r32, hi); partialSM(pA0, pA1, m_reg, mnA, alA);
  SLOAD(KVBLK);
  SWAIT(); SWRITE(1); __syncthreads();
  for (int j = 1; j + 1 < NTL; j += 2) {
    SBAR(); qkt(pB0, pB1, KN_lds + SHM_KN, KR_lds + SHM_KR, qr, qrl, r32, hi);
    finishSM(pA0, pA1, alA, l_reg, pa0, pa1, pa2, pa3); SBAR();
    SLOAD((j + 1) * KVBLK); SBAR();
    pv_d0(o, vb0, pa0, pa1, pa2, pa3); partialSM(pB0, pB1, m_reg, mnB, alB);
    __syncthreads(); SWAIT(); SWRITE(0);
    RESC(alB); __syncthreads();
    SBAR(); qkt(pA0, pA1, KN_lds, KR_lds, qr, qrl, r32, hi);
    finishSM(pB0, pB1, alB, l_reg, pa0, pa1, pa2, pa3); SBAR();
    SLOAD((j + 2) * KVBLK); SBAR();
    pv_d0(o, vb0 + SHM_V, pa0, pa1, pa2, pa3); partialSM(pA0, pA1, m_reg, mnA, alA);
    __syncthreads(); SWAIT(); SWRITE(1);
    RESC(alA); __syncthreads();
  }
  SBAR(); qkt(pB0, pB1, KN_lds + SHM_KN, KR_lds + SHM_KR, qr, qrl, r32, hi);
  finishSM(pA0, pA1, alA, l_reg, pa0, pa1, pa2, pa3); SBAR();
  pv_d0(o, vb0, pa0, pa1, pa2, pa3); partialSM(pB0, pB1, m_reg, mnB, alB);
  __syncthreads(); RESC(alB);
  finishSM(pB0, pB1, alB, l_reg, pa0, pa1, pa2, pa3); SBAR();
  pv_d0(o, vb0 + SHM_V, pa0, pa1, pa2, pa3);
  if (hi == 0) li_l[r32] = l_reg; asm volatile("s_waitcnt lgkmcnt(0)" ::: "memory");
  float rli[16];
#pragma unroll
  for (int r = 0; r < 16; ++r) rli[r] = __builtin_amdgcn_rcpf(li_l[crow(r, hi)]);
#pragma unroll
  for (int r = 0; r < 16; ++r) { const int row = wid * QBLK + crow(r, hi);
#pragma unroll
    for (int d0 = 0; d0 < 4; ++d0) { const int col = d0 * 32 + r32; const float g = bf2f(G[(long)row * NIN + col]);
      Mo[(long)row * DM + col] = f2bf(o[d0][r] * rli[r] * (g / (1.f + __expf(-g)))); } }
  __syncthreads();
#undef SLOAD
#undef SWRITE
#undef SWAIT
#undef RESC
}
#undef SBAR
}

__device__ void ph_attn_mfma(const Params& p, int l, int bid, int nb, char* lds) {
    const bf16_t* Q = WSP(bf16_t, WS_Q); const bf16_t* KB = WSP(bf16_t, WS_KB); const bf16_t* VB = WSP(bf16_t, WS_VB); const bf16_t* U = WSP(bf16_t, WS_U); bf16_t* MIX = WSP(bf16_t, WS_MIX);
    const int vcu = (nb % 8 == 0) ? (bid % 8) * (nb / 8) + bid / 8 : bid;
    const int nlat = NB * NH * (SEQ / 256), nctx = (l < DEPTH - 1) ? NB * NH : 0;
    for (int u = vcu; u < nlat + nctx; u += nb) {
        if (u < nlat) { const int bh = u >> 3, qb = u & 7, b = bh >> 3, h = bh & 7; const size_t hb = (size_t)bh * LK; const size_t rowbase = (size_t)b * SEQ + qb * 256;
            att::attn_unit(Q + (hb + qb * 256) * 192, KB + hb * 192, VB + hb * 128, LK, MIX + rowbase * DM + 512 + h * 128, U + rowbase * NIN + OFF_MLA_G + h * 128, lds); }
        else { const int bh = u - nlat, b = bh >> 3, h = bh & 7; const size_t hb = (size_t)bh * LK + SEQ; const size_t rowbase = (size_t)ROWS_L + b * CTXL;
            att::attn_unit(Q + hb * 192, KB + hb * 192, VB + hb * 128, CTXL, MIX + rowbase * DM + 512 + h * 128, U + rowbase * NIN + OFF_MLA_G + h * 128, lds); }
    }
}


namespace hy {
using bf16x8 = __attribute__((ext_vector_type(8))) short;
using f32x16 = __attribute__((ext_vector_type(16))) float;
using u32x4 = __attribute__((ext_vector_type(4))) unsigned;
using u32x2 = __attribute__((ext_vector_type(2))) unsigned;
constexpr int PADB = 8, ROWB = 80;
constexpr int CPQ = 544, NCH = 520, CH0 = 260;
constexpr int OFF_RHO = 0, OFF_Z = 8 * CPQ * 16, OFF_X1 = OFF_Z + 80 * 4 * ROWB, OFF_X2 = OFF_X1 + 64 * 4 * ROWB, LDS_END = OFF_X2 + 64 * 4 * ROWB;
constexpr unsigned SQ = 0x0F9C9460u;
__device__ __forceinline__ int copy_base(int q) { return q * CPQ + (int)((SQ >> (4 * q)) & 15u); }
__device__ __forceinline__ unsigned pk2bf(float lo, float hi) { unsigned r; asm volatile("v_cvt_pk_bf16_f32 %0, %1, %2" : "=v"(r) : "v"(lo), "v"(hi)); return r; }
__device__ __forceinline__ float blo(unsigned w) { return __uint_as_float(w << 16); }
__device__ __forceinline__ float bhi(unsigned w) { return __uint_as_float(w & 0xffff0000u); }

__device__ __forceinline__ void build_rho(const bf16_t* __restrict__ RHOg, char* lds, int tid) {
    for (int nn = tid; nn < NCH; nn += NT) {
        const int e0 = 8 * nn - 32;
        u32x4 g0 = {0u, 0u, 0u, 0u}, g1 = {0u, 0u, 0u, 0u};
        if (e0 >= 0 && e0 <= 4088) g0 = *reinterpret_cast<const u32x4*>(RHOg + e0);
        if (e0 + 8 >= 0 && e0 + 8 <= 4088) g1 = *reinterpret_cast<const u32x4*>(RHOg + e0 + 8);
        const unsigned w[8] = {g0.x, g0.y, g0.z, g0.w, g1.x, g1.y, g1.z, g1.w};
#pragma unroll
        for (int q = 0; q < 8; ++q) {
            u32x4 o;
            if ((q & 1) == 0) { o.x = w[q / 2]; o.y = w[q / 2 + 1]; o.z = w[q / 2 + 2]; o.w = w[q / 2 + 3]; }
            else { const int a = (q - 1) / 2;
                o.x = __builtin_amdgcn_alignbit(w[a + 1], w[a], 16); o.y = __builtin_amdgcn_alignbit(w[a + 2], w[a + 1], 16);
                o.z = __builtin_amdgcn_alignbit(w[a + 3], w[a + 2], 16); o.w = __builtin_amdgcn_alignbit(w[a + 4], w[a + 3], 16); }
            *reinterpret_cast<u32x4*>(lds + OFF_RHO + (copy_base(q) + nn) * 16) = o;
        }
    }
}
__device__ __forceinline__ f32x16 conv_tile(const char* lds, int I0, int lane) {
    const int i = lane & 31, h = lane >> 5, q = (8 - (i & 7)) & 7;
    const char* pa = lds + OFF_RHO + (copy_base(q) + CH0 + h - (i >> 3) - (q ? 1 : 0) - 4 * (I0 - 63)) * 16;
    const char* pb = lds + OFF_Z + ((63 + PADB) * 4 + i) * ROWB + 16 * h;
    f32x16 acc = {};
#pragma unroll 4
    for (int dd = 0; dd < 72; ++dd) {
        const bf16x8 a0 = *reinterpret_cast<const bf16x8*>(pa - 64 * dd), a1 = *reinterpret_cast<const bf16x8*>(pa - 64 * dd + 32);
        const bf16x8 b0 = *reinterpret_cast<const bf16x8*>(pb - 320 * dd), b1 = *reinterpret_cast<const bf16x8*>(pb - 320 * dd + 32);
        acc = __builtin_amdgcn_mfma_f32_32x32x16_bf16(a0, b0, acc, 0, 0, 0);
        acc = __builtin_amdgcn_mfma_f32_32x32x16_bf16(a1, b1, acc, 0, 0, 0);
    }
    return acc;
}
__device__ __forceinline__ void load_sc16(const bf16_t* __restrict__ row, int t0, float w0, float w1, float w2, float bb, float (&out)[16]) {
    const u32x4 a = *reinterpret_cast<const u32x4*>(row), b = *reinterpret_cast<const u32x4*>(row + 8);
    float in[18];
    in[0] = t0 > 0 ? bf2f(row[-1]) : 0.f; in[17] = t0 + 16 < SEQ ? bf2f(row[16]) : 0.f;
    const unsigned ww[8] = {a.x, a.y, a.z, a.w, b.x, b.y, b.z, b.w};
#pragma unroll
    for (int k = 0; k < 8; ++k) { in[1 + 2 * k] = blo(ww[k]); in[2 + 2 * k] = bhi(ww[k]); }
#pragma unroll
    for (int j = 0; j < 16; ++j) out[j] = w0 * in[j] + w1 * in[j + 1] + w2 * in[j + 2] + bb;
}
__device__ __forceinline__ void st16(char* dst, const float (&v)[16]) {
    u32x4 a, b;
    a.x = pk2bf(v[0], v[1]); a.y = pk2bf(v[2], v[3]); a.z = pk2bf(v[4], v[5]); a.w = pk2bf(v[6], v[7]);
    b.x = pk2bf(v[8], v[9]); b.y = pk2bf(v[10], v[11]); b.z = pk2bf(v[12], v[13]); b.w = pk2bf(v[14], v[15]);
    *reinterpret_cast<u32x4*>(dst) = a; *reinterpret_cast<u32x4*>(dst + 16) = b;
}
__device__ __forceinline__ void hyena_unit(const Params& p, int l, int c, char* lds) {
    int tid_ = threadIdx.x; asm volatile("" : "+v"(tid_));
    const int tid = tid_, lane = tid & 63, wid = __builtin_amdgcn_readfirstlane(tid >> 6);
    const bf16_t* UT = WSP(bf16_t, WS_UT);
    { const int b = tid >> 7, t0 = (tid & 127) * 16; const size_t tok0 = (size_t)b * SEQ + t0;
      const float* cw = p.hy_conv_w + (size_t)l * 3 * 1536; const float* cb = p.hy_conv_b + l * 1536;
      const int J = t0 >> 5, po = (t0 & 31) * 2;
      float v[16];
      load_sc16(UT + (size_t)c * ROWS + tok0, t0, cw[c], cw[1536 + c], cw[3072 + c], cb[c], v);
      st16(lds + OFF_Z + ((J + PADB) * 4 + b) * ROWB + po, v);
      load_sc16(UT + (size_t)(512 + c) * ROWS + tok0, t0, cw[512 + c], cw[1536 + 512 + c], cw[3072 + 512 + c], cb[512 + c], v);
      st16(lds + OFF_X1 + (J * 4 + b) * ROWB + po, v);
      load_sc16(UT + (size_t)(1024 + c) * ROWS + tok0, t0, cw[1024 + c], cw[1536 + 1024 + c], cw[3072 + 1024 + c], cb[1024 + c], v);
      { const bf16_t* gr = UT + (size_t)(1536 + c) * ROWS + tok0; const u32x4 ga = *reinterpret_cast<const u32x4*>(gr), gb = *reinterpret_cast<const u32x4*>(gr + 8);
        const unsigned gw[8] = {ga.x, ga.y, ga.z, ga.w, gb.x, gb.y, gb.z, gb.w};
#pragma unroll
        for (int k = 0; k < 8; ++k) { const float g0 = blo(gw[k]), g1 = bhi(gw[k]); v[2 * k] *= g0 / (1.f + __expf(-g0)); v[2 * k + 1] *= g1 / (1.f + __expf(-g1)); } }
      st16(lds + OFF_X2 + (J * 4 + b) * ROWB + po, v);
      if (tid < 320) { const int rz = tid < 160 ? tid : (72 * 4 * 5 - 160) + tid;
          unsigned zz = 0u; asm volatile("" : "+v"(zz));
          *reinterpret_cast<u32x4*>(lds + OFF_Z + rz * 16) = (u32x4){zz, zz, zz, zz}; } }
    build_rho(WSP(bf16_t, WS_RHO) + (((size_t)l * 2 + 0) * 512 + c) * 4096, lds, tid);
    __syncthreads();
    const int I0 = 8 * wid, r = lane & 31, h = lane >> 5;
    f32x16 acc = conv_tile(lds, I0, lane);
    __syncthreads();
#pragma unroll
    for (int g = 0; g < 4; ++g) {
        const int off = (I0 * 4 + r) * ROWB + 16 * g + 8 * h;
        const u32x2 xv = *reinterpret_cast<const u32x2*>(lds + OFF_X1 + off);
        u32x2 o; o.x = pk2bf(acc[4 * g] * blo(xv.x), acc[4 * g + 1] * bhi(xv.x)); o.y = pk2bf(acc[4 * g + 2] * blo(xv.y), acc[4 * g + 3] * bhi(xv.y));
        *reinterpret_cast<u32x2*>(lds + OFF_Z + PADB * 4 * ROWB + off) = o;
    }
    build_rho(WSP(bf16_t, WS_RHO) + (((size_t)l * 2 + 1) * 512 + c) * 4096, lds, tid);
    __syncthreads();
    acc = conv_tile(lds, I0, lane);
#pragma unroll
    for (int g = 0; g < 4; ++g) {
        const int off = (I0 * 4 + r) * ROWB + 16 * g + 8 * h;
        const u32x2 xv = *reinterpret_cast<const u32x2*>(lds + OFF_X2 + off);
        u32x2 o; o.x = pk2bf(acc[4 * g] * blo(xv.x), acc[4 * g + 1] * bhi(xv.x)); o.y = pk2bf(acc[4 * g + 2] * blo(xv.y), acc[4 * g + 3] * bhi(xv.y));
        *reinterpret_cast<u32x2*>(lds + OFF_X1 + off) = o;
    }
    __syncthreads();
    bf16_t* HT = WSP(bf16_t, WS_HT) + (size_t)c * ROWS;
#pragma unroll
    for (int k = 0; k < 2; ++k) { const int id = tid + k * NT, b = id >> 8, J = (id >> 2) & 63, q4 = id & 3;
        *reinterpret_cast<u32x4*>(HT + (size_t)b * SEQ + 32 * J + 8 * q4) = *reinterpret_cast<const u32x4*>(lds + OFF_X1 + (J * 4 + b) * ROWB + q4 * 16); }
    __syncthreads();
}
}
static_assert(hy::LDS_END <= LDS_BYTES, "hyena LDS map");

__device__ void ph_hyena_mfma(const Params& p, int l, int bid, int nb, char* lds) {
    for (int c = bid; c < HYW; c += nb) hy::hyena_unit(p, l, c, lds);
}
__device__ void ph_transpose(const bf16_t* __restrict__ src, int spitch, bf16_t* __restrict__ dst, int dpitch, int R, int C, int bid, int nb, bf16_t* tile) {
    const int TX = otid();
    const int tr = R / 64, tc = C / 64;
    for (int t = bid; t < tr * tc; t += nb) {
        const int r0 = (t / tc) * 64, c0 = (t % tc) * 64;
        { const int rr = TX >> 3, cc = (TX & 7) * 8; *(uint4*)(tile + rr * 72 + cc) = *(const uint4*)(src + (size_t)(r0 + rr) * spitch + c0 + cc); }
        __syncthreads();
        { const int dr = TX >> 3, dc = (TX & 7) * 8; unsigned w[4];
#pragma unroll
          for (int k = 0; k < 4; ++k) w[k] = (unsigned)tile[(dc + 2 * k) * 72 + dr] | ((unsigned)tile[(dc + 2 * k + 1) * 72 + dr] << 16);
          *(uint4*)(dst + (size_t)(c0 + dr) * dpitch + r0 + dc) = make_uint4(w[0], w[1], w[2], w[3]); }
        __syncthreads();
    }
}

#define LAS __attribute__((address_space(3)))
typedef unsigned v4u __attribute__((ext_vector_type(4)));
__device__ __forceinline__ unsigned pk2(float lo, float hi) { return (unsigned)f2bf(lo) | ((unsigned)f2bf(hi) << 16); }
__device__ __forceinline__ void transpose_item(const float* W, int K, int N, bf16_t* WT, float* scr, int item, int lane, const float* gs = nullptr) {
    const int nblk = N / 32, kb = item / nblk, nb_ = item % nblk, k0 = 64 * kb, n0 = 32 * nb_;
#pragma unroll 8
    for (int i = 0; i < 32; ++i) { const int kk = 2 * i + (lane >> 5); scr[kk * 33 + (lane & 31)] = W[(size_t)(k0 + kk) * N + n0 + (lane & 31)] * (gs ? gs[k0 + kk] : 1.f); }
    asm volatile("s_waitcnt lgkmcnt(0)" ::: "memory");
    const int c = lane & 7;
#pragma unroll
    for (int j = 0; j < 4; ++j) { const int n = (lane >> 3) + 8 * j; const float* sp = scr + (8 * c) * 33 + n;
        v4u o; o.x = pk2(sp[0 * 33], sp[1 * 33]); o.y = pk2(sp[2 * 33], sp[3 * 33]); o.z = pk2(sp[4 * 33], sp[5 * 33]); o.w = pk2(sp[6 * 33], sp[7 * 33]);
        *(v4u*)(WT + (size_t)(n0 + n) * K + k0 + 8 * c) = o; }
    asm volatile("s_waitcnt lgkmcnt(0)" ::: "memory");
}
__device__ void ph_prologue(const Params& p, int bid, int nb, float* sm) {
    const int tid = otid(), lane = tid & 63, wid = tid >> 6;
    if (bid < DEPTH * 24) {
        float* sil = sm; float* part = sm + 5 * DM;
        for (int i = tid; i < 5 * DM; i += NT) { const int r = i >> 11, k = i & 2047; sil[i] = silu_f(r < 4 ? p.c[r * DM + k] : p.c_ctx[k]); }
        __syncthreads();
        for (int u = bid; u < DEPTH * 24; u += nb) {
            const int l = u / 24, n0 = (u % 24) * 256;
            const float* W = p.w_ada + (size_t)l * DM * 6144 + n0 + lane * 4;
            float4 a[5];
#pragma unroll
            for (int r = 0; r < 5; ++r) a[r] = make_float4(0.f, 0.f, 0.f, 0.f);
#pragma unroll 8
            for (int kk = 0; kk < 256; ++kk) { const int k = wid * 256 + kk; const float4 w = *(const float4*)(W + (size_t)k * 6144);
#pragma unroll
                for (int r = 0; r < 5; ++r) { const float sv = sil[r * DM + k]; a[r].x += sv * w.x; a[r].y += sv * w.y; a[r].z += sv * w.z; a[r].w += sv * w.w; } }
#pragma unroll
            for (int r = 0; r < 5; ++r) *(float4*)(part + (wid * 5 + r) * 256 + lane * 4) = a[r];
            __syncthreads();
            for (int i = tid; i < 5 * 256; i += NT) { const int r = i >> 8, c = i & 255; float sacc = p.b_ada[l * 6144 + n0 + c];
#pragma unroll
                for (int w = 0; w < 8; ++w) sacc += part[(w * 5 + r) * 256 + c];
                WSP(float, WS_MOD)[(size_t)(l * 5 + r) * 6144 + n0 + c] = sacc; }
            __syncthreads();
        }
    }
    __syncthreads();
    float* scr = sm + wid * (64 * 33 + 16);
    const int gw = bid * 8 + wid, NGW = nb * 8;
    constexpr int I_IN = (DM / 64) * (NIN / 32), I_OUT = (DM / 64) * (DM / 32), I_UQ = (512 / 64) * (1536 / 32), I_UKV = (256 / 64) * (2048 / 32), I_ALL = I_IN + I_OUT + I_UQ + I_UKV;
    for (int it = gw; it < DEPTH * I_ALL; it += NGW) {
        const int l = it / I_ALL; int r = it % I_ALL;
        if (r < I_IN) { transpose_item(p.w_in + (size_t)l * DM * NIN, DM, NIN, WSP(bf16_t, WS_WINT) + (size_t)l * NINP * DM, scr, r, lane); continue; } r -= I_IN;
        if (r < I_OUT) { transpose_item(p.w_out + (size_t)l * DM * DM, DM, DM, WSP(bf16_t, WS_WOUTT) + (size_t)l * DM * DM, scr, r, lane); continue; } r -= I_OUT;
        if (r < I_UQ) { transpose_item(p.w_uq + (size_t)l * 512 * 1536, 512, 1536, WSP(bf16_t, WS_WUQT) + (size_t)l * 1536 * 512, scr, r, lane, p.q_norm_g + l * 512); continue; } r -= I_UQ;
        transpose_item(p.w_ukv + (size_t)l * 256 * 2048, 256, 2048, WSP(bf16_t, WS_WUKVT) + (size_t)l * 2048 * 256, scr, r, lane, p.kv_norm_g + l * 256);
    }
    for (int i = bid * NT + tid; i < DEPTH * DM * 512; i += nb * NT) {
        const int l = i >> 20, k = (i >> 9) & 2047, n = i & 511, g = n >> 7, j = n & 127;
        const float* wi = p.w_in + ((size_t)l * DM + k) * NIN + OFF_POOL + g * 128; const float* wp = p.w_pool + (size_t)(l * 4 + g) * 128 * 128 + j;
        float a = 0.f;
#pragma unroll 8
        for (int c = 0; c < 128; ++c) a += wi[c] * wp[(size_t)c * 128];
        WSP(float, WS_WP)[i] = a;
    }
    for (int i = bid * NT + tid; i < SEQ * 32; i += nb * NT) {
        const int t = i >> 5, pr = i & 31; const float inv = expf(-(float)(pr & 15) * (9.210340371976184f / 16.f));
        const float ang = (float)(pr < 16 ? (t >> 6) : (t & 63)) * inv;
        WSP(float, WS_ROPE)[2 * i] = fcos(ang); WSP(float, WS_ROPE)[2 * i + 1] = fsin(ang);
    }
    for (size_t i = (size_t)bid * NT + tid; i < (size_t)DEPTH * (NINP - NIN) * DM / 8; i += (size_t)nb * NT) {
        const size_t per = (size_t)(NINP - NIN) * DM / 8; const int l = (int)(i / per); const size_t o = i % per;
        *(v4u*)(WSP(bf16_t, WS_WINT) + ((size_t)l * NINP + NIN) * DM + o * 8) = (v4u){0u, 0u, 0u, 0u};
    }
    __syncthreads();
}


namespace hyc {
constexpr int KPAD = 664, ZP = 260, SLOT_F = 2 * KPAD + 16 * ZP;
__device__ __forceinline__ void conv4(const float* __restrict__ kp, const float* __restrict__ zb, int t0, float (&acc)[4]) {
#pragma unroll
    for (int i = 0; i < 4; ++i) acc[i] = 0.f;
#pragma unroll 2
    for (int s0 = 0; s0 < CTXL; s0 += 8) {
        const int m0 = t0 - s0 + 257; const float* wp = kp + (m0 + (m0 >> 2));
        float w[11], zz[8];
#pragma unroll
        for (int j = 0; j < 11; ++j) w[j] = wp[j + (j >= 3 ? 1 : 0) + (j >= 7 ? 1 : 0)];
#pragma unroll
        for (int uu = 0; uu < 8; ++uu) zz[uu] = zb[s0 + uu];
#pragma unroll
        for (int uu = 0; uu < 8; ++uu)
#pragma unroll
            for (int i = 0; i < 4; ++i) acc[i] += zz[uu] * w[i - uu + 7];
    }
}
__device__ __forceinline__ void sc4(const bf16_t* __restrict__ row, int t0, float w0, float w1, float w2, float bb, float (&out)[4]) {
    const uint2 a = *reinterpret_cast<const uint2*>(row); float in[6];
    in[0] = t0 > 0 ? bf2f(row[-1]) : 0.f; in[5] = t0 + 4 < CTXL ? bf2f(row[4]) : 0.f;
    in[1] = __uint_as_float(a.x << 16); in[2] = __uint_as_float(a.x & 0xffff0000u); in[3] = __uint_as_float(a.y << 16); in[4] = __uint_as_float(a.y & 0xffff0000u);
#pragma unroll
    for (int j = 0; j < 4; ++j) out[j] = w0 * in[j] + w1 * in[j + 1] + w2 * in[j + 2] + bb;
}
__device__ __forceinline__ void unit(const Params& p, int l, int c0, float* sm) {
    int tid_ = threadIdx.x; asm volatile("" : "+v"(tid_));
    const int tid = tid_, slot = tid >> 8, b = (tid >> 6) & 3, tg = tid & 63, t0 = 4 * tg, c = c0 + slot;
    float* base = sm + slot * SLOT_F; float* kap = base; float* zb = base + 2 * KPAD + b * ZP; float* z2b = zb + 4 * ZP; float* x1b = zb + 8 * ZP; float* x2b = zb + 12 * ZP;
    const bf16_t* UT = WSP(bf16_t, WS_UT); const size_t tok0 = (size_t)ROWS_L + b * CTXL + t0;
    const float* cw = p.hy_conv_w + (size_t)l * 3 * 1536; const float* cb = p.hy_conv_b + l * 1536;
    float v[4];
    sc4(UT + (size_t)c * ROWS + tok0, t0, cw[c], cw[1536 + c], cw[3072 + c], cb[c], v);
#pragma unroll
    for (int i = 0; i < 4; ++i) zb[t0 + i] = v[i];
    sc4(UT + (size_t)(512 + c) * ROWS + tok0, t0, cw[512 + c], cw[1536 + 512 + c], cw[3072 + 512 + c], cb[512 + c], v);
#pragma unroll
    for (int i = 0; i < 4; ++i) x1b[t0 + i] = v[i];
    sc4(UT + (size_t)(1024 + c) * ROWS + tok0, t0, cw[1024 + c], cw[1536 + 1024 + c], cw[3072 + 1024 + c], cb[1024 + c], v);
    { const uint2 ga = *reinterpret_cast<const uint2*>(UT + (size_t)(1536 + c) * ROWS + tok0);
      const float g[4] = {__uint_as_float(ga.x << 16), __uint_as_float(ga.x & 0xffff0000u), __uint_as_float(ga.y << 16), __uint_as_float(ga.y & 0xffff0000u)};
#pragma unroll
      for (int i = 0; i < 4; ++i) x2b[t0 + i] = v[i] * (g[i] / (1.f + __expf(-g[i]))); }
    { const float* KC = WSP(float, WS_KC) + ((size_t)l * 2 * 512 + c) * 512;
#pragma unroll
      for (int k = 0; k < 4; ++k) { const int idx = (tid & 255) + 256 * k, o = idx >> 9, e = idx & 511, m = e + 8; kap[o * KPAD + m + (m >> 2)] = KC[(size_t)o * 512 * 512 + e]; } }
    __syncthreads();
    float acc[4];
    conv4(kap, zb, t0, acc);
#pragma unroll
    for (int i = 0; i < 4; ++i) z2b[t0 + i] = x1b[t0 + i] * acc[i];
    __syncthreads();
    conv4(kap + KPAD, z2b, t0, acc);
    uint2 o2; o2.x = (unsigned)f2bf(acc[0] * x2b[t0]) | ((unsigned)f2bf(acc[1] * x2b[t0 + 1]) << 16); o2.y = (unsigned)f2bf(acc[2] * x2b[t0 + 2]) | ((unsigned)f2bf(acc[3] * x2b[t0 + 3]) << 16);
    *reinterpret_cast<uint2*>(WSP(bf16_t, WS_HT) + (size_t)c * ROWS + tok0) = o2;
    __syncthreads();
}
}
__device__ void ph_hyena_ctx(const Params& p, int l, int bid, int nb, float* sm) {
    if (l == DEPTH - 1) return;
    for (int u = nb - 1 - bid; u < HYW / 2; u += nb) hyc::unit(p, l, 2 * u, sm);
}
__device__ void ph_kc(const Params& p, int bid, int nb) {
    const int TX = otid();
    const int lane = TX & 63, wid = TX >> 6;
    for (int idx = bid * 8 + wid; idx < DEPTH * 1024; idx += nb * 8) {
        const int l = idx >> 10, o = (idx >> 9) & 1, c = idx & 511, L = CTXL;
        const float* F = WSP(float, WS_FC) + (size_t)l * 2 * 2 * CTXL * 512;
        float a[4], bq[4], s = 0;
#pragma unroll
        for (int i = 0; i < 4; ++i) { const int pos = lane + 64 * i;
            a[i] = F[(((size_t)o * 2 + 0) * L + pos) * 512 + c]; bq[i] = F[(((size_t)o * 2 + 1) * L + pos) * 512 + c];
            s += a[i] * a[i]; if (pos >= 1) s += bq[i] * bq[i]; }
        s = wave_sum(s);
        const float sc = rsqrtf(s + EPS);
        float* KC = WSP(float, WS_KC) + (size_t)idx * 512;
#pragma unroll
        for (int i = 0; i < 4; ++i) { const int pos = lane + 64 * i;
            KC[256 + pos] = sc * a[i] + (pos == 0 ? p.hy_bias[(l * 2 + o) * 512 + c] : 0.f);
            if (pos >= 1) KC[256 - pos] = sc * bq[i]; else KC[0] = 0.f; }
    }
}

#define XB_TMO      128
#define XB_XCNT(j)  (256  + 64 * (j))
#define XB_XSUB(j)  (1280 + 64 * (j))
#define XB_XGEN(j)  (2304 + 64 * (j))
#define XB_TOP      3328
#define XB_TOPGEN   3392
#define XCD_BAR_WORDS 3456
#define XB_SPIN_CAP (1u << 18)
__device__ __forceinline__ unsigned xb_ld(unsigned* p)              { return __hip_atomic_load(p, __ATOMIC_RELAXED, __HIP_MEMORY_SCOPE_AGENT); }
__device__ __forceinline__ unsigned xb_add(unsigned* p, unsigned v) { return __hip_atomic_fetch_add(p, v, __ATOMIC_RELAXED, __HIP_MEMORY_SCOPE_AGENT); }
__device__ __forceinline__ unsigned xb_xcc_id() { return (unsigned)__builtin_amdgcn_s_getreg((3 << 11) | 20) & 0xFu; }
#define XB_SPIN(cond, bar) do { unsigned _sp = 0; while (cond) { __builtin_amdgcn_s_sleep(1); \
    if ((++_sp & 255u) == 0u) { if (xb_ld(&(bar)[XB_TMO])) break; if (_sp > XB_SPIN_CAP) { atomicAdd(&(bar)[XB_TMO], 1u); break; } } } } while (0)
struct XcdBarrier { unsigned* bar; unsigned x; volatile LAS unsigned* st; };
__device__ __forceinline__ XcdBarrier xcd_barrier_post(unsigned* bar, volatile LAS unsigned* st) {
    XcdBarrier b; b.bar = bar; b.x = xb_xcc_id(); b.st = st;
    if (threadIdx.x == 0) (void)xb_add(&bar[XB_XCNT(b.x)], 1u);
    return b;
}
__device__ __forceinline__ void xcd_barrier_complete(unsigned* bar, unsigned x, unsigned& nloc, unsigned& nx) {
    const unsigned G = gridDim.x * gridDim.y * gridDim.z;
    unsigned sum, cnt, mine, sp = 0u;
    for (;;) {
        sum = 0u; cnt = 0u; mine = 0u;
#pragma unroll
        for (unsigned j = 0; j < 16; ++j) { const unsigned c = xb_ld(&bar[XB_XCNT(j)]); sum += c; cnt += (c > 0u) ? 1u : 0u; mine = (j == x) ? c : mine; }
        if (sum == G) break;
        __builtin_amdgcn_s_sleep(1);
        if ((++sp & 255u) == 0u) { if (xb_ld(&bar[XB_TMO])) break; if (sp > XB_SPIN_CAP) { atomicAdd(&bar[XB_TMO], 1u); break; } }
    }
    nloc = mine > 0u ? mine : 1u; nx = cnt > 0u ? cnt : 1u;
}
__device__ __forceinline__ void xcd_barrier(const XcdBarrier& b) {
    asm volatile("s_waitcnt vmcnt(0)" ::: "memory");
    __syncthreads();
    if (threadIdx.x == 0) {
        unsigned* bar = b.bar;
        __builtin_amdgcn_s_waitcnt(0);
        unsigned nloc = b.st[0], nx = b.st[1];
        if (nloc == 0u) { xcd_barrier_complete(bar, b.x, nloc, nx); b.st[0] = nloc; b.st[1] = nx; }
        const unsigned old = xb_add(&bar[XB_XSUB(b.x)], 1u);
        const unsigned gen = old / nloc;
        if (old + 1u == (gen + 1u) * nloc) {
            __builtin_amdgcn_fence(__ATOMIC_RELEASE, "agent");
            asm volatile("s_waitcnt vmcnt(0)" ::: "memory");
            const unsigned og = xb_add(&bar[XB_TOP], 1u);
            const unsigned tg = og / nx;
            if (og + 1u == (tg + 1u) * nx) xb_add(&bar[XB_TOPGEN], 1u);
            else XB_SPIN(xb_ld(&bar[XB_TOPGEN]) == tg, bar);
            __builtin_amdgcn_fence(__ATOMIC_ACQUIRE, "agent");
            xb_add(&bar[XB_XGEN(b.x)], 1u);
            asm volatile("s_waitcnt vmcnt(0)" ::: "memory");
        } else {
            XB_SPIN(xb_ld(&bar[XB_XGEN(b.x)]) == gen, bar);
            __builtin_amdgcn_fence(__ATOMIC_ACQUIRE, "agent");
            asm volatile("s_waitcnt vmcnt(0)" ::: "memory");
        }
    }
    __syncthreads();
}

__device__ void ph_wp_transpose(const Params& p, int bid, int nb, float* sm) {
    const int tid = otid(), lane = tid & 63, wid = tid >> 6;
    float* scr = sm + wid * (64 * 33 + 16);
    constexpr int I_WP = (DM / 64) * (512 / 32);
    for (int it = bid * 8 + wid; it < DEPTH * I_WP; it += nb * 8) { const int l = it / I_WP, r = it % I_WP;
        transpose_item(WSP(float, WS_WP) + (size_t)l * DM * 512, DM, 512, WSP(bf16_t, WS_WINT) + ((size_t)l * NINP + OFF_POOL) * DM, scr, r, lane); }
    __syncthreads();
}
template <int HALF> __device__ __forceinline__ void pool_chunk(const bf16_t* __restrict__ Us, int t0, int L, float ps, bf16_t* __restrict__ Ms) {
    constexpr int NV = 16 + 2 * HALF - 1;
    float v[NV];
#pragma unroll
    for (int i = 0; i < NV; ++i) { const int sidx = t0 - HALF + i; v[i] = (sidx >= 0 && sidx < L) ? bf2f(Us[(size_t)sidx * NIN]) : 0.f; }
    float g[16];
#pragma unroll
    for (int tt = 0; tt < 16; ++tt) g[tt] = bf2f(Us[(size_t)(t0 + tt) * NIN + (OFF_POOL_G - OFF_POOL)]);
    float sum = 0.f;
#pragma unroll
    for (int i = 0; i < 2 * HALF; ++i) sum += v[i];
#pragma unroll
    for (int tt = 0; tt < 16; ++tt) { const int t = t0 + tt, lo = max(t - HALF, 0), hi = min(t + HALF, L);
        const float y = sum / (float)(hi - lo) - v[tt + HALF];
        Ms[(size_t)t * DM] = f2bf(y * ps * silu_f(g[tt]));
        if (tt < 15) sum += v[tt + 2 * HALF] - v[tt]; }
}
__device__ void ph_poolwin(const Params& p, int l, int bid, int nb) {
    const int TX = otid();
    const bf16_t* U = WSP(bf16_t, WS_U); bf16_t* MIX = WSP(bf16_t, WS_MIX);
    for (int idx = bid * NT + TX; idx < (ROWS / 16) * 512; idx += nb * NT) {
        const int j = idx & 511, row0 = (idx >> 9) * 16; const RowInfo r = rowinfo(row0);
        const bf16_t* Us = U + (size_t)(row0 - r.t) * NIN + OFF_POOL + j; bf16_t* Ms = MIX + (size_t)(row0 - r.t) * DM + 1536 + j;
        const float ps = p.pool_scale[l * 512 + j];
        switch (j >> 7) { case 0: pool_chunk<1>(Us, r.t, r.L, ps, Ms); break; case 1: pool_chunk<2>(Us, r.t, r.L, ps, Ms); break;
                          case 2: pool_chunk<4>(Us, r.t, r.L, ps, Ms); break; default: pool_chunk<8>(Us, r.t, r.L, ps, Ms); break; }
    }
}

enum { PH_ADALN = 0, PH_1, PH_2, PH_3, PH_4, PH_5, PH_6, PH_7, PH_FINAL, PH_PRO_B };
__device__ __forceinline__ void run_phase(const Params& pin, int ph, int l, int bid, int nb, float* sm) {
    asm volatile("" : "+s"(bid), "+s"(nb), "+s"(l));
#if defined(__HIP_DEVICE_COMPILE__)
    const __attribute__((address_space(4))) Params* pk = (const __attribute__((address_space(4))) Params*)__builtin_amdgcn_kernarg_segment_ptr();
    asm volatile("" : "+s"(pk));
    const Params p = *pk; (void)pin;
#else
    const Params p = pin;
#endif
    switch (ph) {
    case PH_ADALN: ph_prologue(p, bid, nb, sm); ph_h2(p, bid, nb, sm); ph_filter_ctx(p, bid, nb, sm); break;
    case PH_PRO_B: ph_wp_transpose(p, bid, nb, sm); ph_rho_units(p, bid, nb, sm); ph_kc(p, bid, nb); break;
    case PH_1: ph_norm(p, l, bid, nb); break;
    case PH_2:
        { pg8::Gemm g{WSP(bf16_t, WS_HA), WSP(bf16_t, WS_WINT) + (size_t)l * NINP * DM, ROWS, NINP, DM, DM}; pg8::StaticOrder S; S.init(ROWS, NINP, nb, bid);
          pg8::EpiU E{WSP(bf16_t, WS_U), WSP(bf16_t, WS_UT), WSP(float, WS_RS), NIN, NIN, ROWS};
          pg8::gemm_phase<pg8::EpiU, pg8::StaticOrder, true, true>((PG8_LAS unsigned char*)sm, g, S, E); } break;
    case PH_3: break;
    case PH_4:
        { pg8::Gemm g{WSP(bf16_t, WS_U) + OFF_Q, WSP(bf16_t, WS_WUQT) + (size_t)l * 1536 * 512, ROWS, 1536, 512, NIN}; pg8::StaticOrder S; S.init(ROWS, 1536, nb, bid);
          pg8::EpiQ E{WSP(bf16_t, WS_Q), WSP(float, WS_RS), WSP(float, WS_ROPE)};
          pg8::gemm_phase<pg8::EpiQ, pg8::StaticOrder, true, true>((PG8_LAS unsigned char*)sm, g, S, E); }
        { pg8::Gemm g{WSP(bf16_t, WS_U) + OFF_KV, WSP(bf16_t, WS_WUKVT) + (size_t)l * 2048 * 256, ROWS, 2048, 256, NIN}; pg8::StaticOrder S; S.init(ROWS, 2048, nb, bid);
          pg8::EpiKV E{WSP(bf16_t, WS_KB), WSP(bf16_t, WS_VB), WSP(float, WS_RS)};
          pg8::gemm_phase<pg8::EpiKV, pg8::StaticOrder, true, true>((PG8_LAS unsigned char*)sm, g, S, E); }
        ph_krope(p, bid, nb);
        __syncthreads();
        ph_hyena_mfma(p, l, bid, nb, (char*)sm);
        ph_hyena_ctx(p, l, bid, nb, sm); break;
    case PH_5: break;
    case PH_6: ph_attn_mfma(p, l, bid, nb, (char*)sm); ph_poolwin(p, l, bid, nb);
        ph_transpose(WSP(bf16_t, WS_HT), ROWS, WSP(bf16_t, WS_MIX), DM, 512, ROWS, bid, nb, (bf16_t*)sm); break;
    case PH_7: { const int Mrows = l == DEPTH - 1 ? ROWS_L : ROWS;
          pg8::Gemm g{WSP(bf16_t, WS_MIX), WSP(bf16_t, WS_WOUTT) + (size_t)l * DM * DM, Mrows, DM, DM, DM}; pg8::StaticOrder S; S.init(Mrows, DM, nb, bid);
          pg8::EpiResid E{l == 0 ? p.x : WSP(float, WS_XW), l == 0 ? p.ctx : WSP(float, WS_XW) + (size_t)ROWS_L * DM, WSP(float, WS_XW), WSP(float, WS_MOD) + (size_t)l * 5 * 6144 + 4096};
          pg8::gemm_phase<pg8::EpiResid, pg8::StaticOrder, true, true>((PG8_LAS unsigned char*)sm, g, S, E); } break;
    case PH_FINAL: ph_final(p, bid, nb); break;
    }
}

#if ONE_LAUNCH
__global__ void __launch_bounds__(NT, 2) mega_fwd(Params p) {
    extern __shared__ __attribute__((aligned(16))) unsigned char lds[];
    cg::grid_group grid = cg::this_grid();
    float* sm = (float*)lds; const int bid = blockIdx.x, nb = gridDim.x;
    if (threadIdx.x < 16) ((LAS unsigned*)(lds + LDS_BYTES - 64))[threadIdx.x] = 0u;
    __syncthreads();
    const XcdBarrier bar = xcd_barrier_post((unsigned*)(p.ws + WS_CTL), (volatile LAS unsigned*)(lds + LDS_BYTES - 64));
#define SEAM() xcd_barrier(bar)
#define RUNP(PH, K) do { int nrep_ = (REP_PH == (K)) ? 2 : 1; asm volatile("" : "+s"(nrep_)); _Pragma("unroll 1") for (int rep_ = 0; rep_ < nrep_; ++rep_) run_phase(p, PH, l, bid, nb, sm); } while (0)
    run_phase(p, PH_ADALN, 0, bid, nb, sm);
    grid.sync();
    run_phase(p, PH_PRO_B, 0, bid, nb, sm);
#pragma unroll 1
    for (int l = 0; l < DEPTH; ++l) {
        SEAM(); RUNP(PH_1, 1);
        SEAM(); RUNP(PH_2, 2);
        SEAM(); RUNP(PH_4, 4);
        SEAM(); RUNP(PH_6, 6);
        SEAM(); RUNP(PH_7, 7);
    }
    SEAM();
    run_phase(p, PH_FINAL, 0, bid, nb, sm);
#undef SEAM
}
#else
__global__ void __launch_bounds__(NT) k_phase(Params p, int ph, int l) {
    extern __shared__ __attribute__((aligned(16))) unsigned char lds[];
    run_phase(p, ph, l, blockIdx.x, gridDim.x, (float*)lds);
}
#endif

extern "C" void kernel_launch(void* const* d_in, const int* in_sizes, int n_in, void* d_out, int out_size, void* d_ws, size_t ws_size, hipStream_t stream) {
    if (n_in != 25 || ws_size < WS_END) { fprintf(stderr, "kernel_launch: bad inputs (n_in %d, ws %zu < %zu)\n", n_in, ws_size, (size_t)WS_END); return; }
    Params p{};
    const float** pp = (const float**)&p;
    for (int i = 0; i < 25; ++i) pp[i] = (const float*)d_in[i];
    p.out = (float*)d_out; p.ws = (unsigned char*)d_ws;
#if ONE_LAUNCH
    static int grid = 0;
    if (!grid) {
        int dev = 0, cus = 0, per_cu = 0;
        hipGetDevice(&dev); hipDeviceGetAttribute(&cus, hipDeviceAttributeMultiprocessorCount, dev);
        hipFuncSetAttribute((const void*)mega_fwd, hipFuncAttributeMaxDynamicSharedMemorySize, LDS_BYTES);
        hipOccupancyMaxActiveBlocksPerMultiprocessor(&per_cu, (const void*)mega_fwd, NT, LDS_BYTES);
        if (per_cu < 1) per_cu = 1;
        grid = cus * 1;
    }
    (void)hipMemsetAsync((char*)d_ws + WS_CTL, 0, CTL_BYTES, stream);
    void* args[] = {&p};
    hipError_t e = hipLaunchCooperativeKernel((const void*)mega_fwd, dim3(grid), dim3(NT), args, LDS_BYTES, stream);
    if (e != hipSuccess) fprintf(stderr, "cooperative launch failed: %s (grid %d)\n", hipGetErrorString(e), grid);
#else
    static int init = 0;
    if (!init) { hipFuncSetAttribute((const void*)k_phase, hipFuncAttributeMaxDynamicSharedMemorySize, LDS_BYTES); init = 1; }
    const int G = 1024;
    k_phase<<<G, NT, LDS_BYTES, stream>>>(p, PH_ADALN, 0);
    k_phase<<<G, NT, LDS_BYTES, stream>>>(p, PH_PRO_B, 0);
    for (int l = 0; l < DEPTH; ++l)
        for (int ph = PH_1; ph <= PH_7; ++ph) k_phase<<<G, NT, LDS_BYTES, stream>>>(p, ph, l);
    k_phase<<<G, NT, LDS_BYTES, stream>>>(p, PH_FINAL, 0);
#endif
}
```

```cpp
#include <hip/hip_runtime.h>
#include <hip/hip_cooperative_groups.h>
#include <cstdio>
#include <cstdint>
namespace cg = cooperative_groups;

#ifndef ONE_LAUNCH
#define ONE_LAUNCH 1
#endif
#ifndef REP_PH
#define REP_PH -1
#endif

constexpr int DM = 2048, NB = 4, SEQ = 2048, DEPTH = 4, CTXL = 256;
constexpr int HYW = 512, NH = 8, QRANK = 512, KVRANK = 256, POOLW = 512;
constexpr int OFF_HY_G = 1536, OFF_Q = 2048, OFF_KV = 2560, OFF_KR = 2816, OFF_MLA_G = 2880, OFF_POOL = 3904, OFF_POOL_G = 4416, NIN = 4928;
constexpr int ROWS_L = NB * SEQ, ROWS_C = NB * CTXL, ROWS = ROWS_L + ROWS_C;
constexpr int LK = SEQ + CTXL;
constexpr float EPS = 1e-6f;
constexpr float ATTN_SCALE = 0.07216878364870322f;
constexpr int NT = 512;
constexpr int NINP = 5120;

typedef unsigned short bf16_t;
typedef bf16_t act_t;

struct Params {
    const float *x, *c, *ctx, *c_ctx, *norm_g, *w_ada, *b_ada, *w_in, *hy_conv_w, *hy_conv_b, *hf_w1, *hf_b1, *hf_freq, *hf_w2, *hf_b2, *hf_w3, *hy_bias,
        *q_norm_g, *w_uq, *kv_norm_g, *w_ukv, *w_pool, *pool_scale, *w_out, *final_norm_g;
    float* out; unsigned char* ws;
};

constexpr size_t al256(size_t x) { return (x + 255) / 256 * 256; }
constexpr size_t WS_MOD = 0;
constexpr size_t WS_FSCL = WS_MOD + al256((size_t)4 * 5 * 6144 * 4);
constexpr size_t WS_H2L = WS_FSCL + al256((size_t)4 * 2 * 512 * 4);
constexpr size_t WS_FC = WS_H2L + al256((size_t)(4 * 2048 + 1) * 64 * 4);
constexpr size_t WS_HA = WS_FC + al256((size_t)4 * 2 * 2 * 256 * 512 * 4);
constexpr size_t WS_KVRAW = WS_HA;
constexpr size_t WS_U = WS_HA + al256((size_t)ROWS * 2048 * sizeof(act_t));
constexpr size_t WS_QN = WS_U + al256((size_t)ROWS * NIN * sizeof(act_t));
constexpr size_t WS_KVN = WS_QN + al256((size_t)ROWS * 512 * sizeof(act_t));
constexpr size_t WS_QRAW = WS_KVN + al256((size_t)ROWS * 256 * sizeof(act_t));
constexpr size_t WS_Q = WS_QRAW + al256((size_t)ROWS * 1536 * sizeof(act_t));
constexpr size_t WS_KB = WS_Q + al256((size_t)NB * NH * LK * 192 * sizeof(act_t));
constexpr size_t WS_VB = WS_KB + al256((size_t)NB * NH * LK * 192 * sizeof(act_t));
constexpr size_t WS_HC = WS_VB + al256((size_t)NB * NH * LK * 128 * sizeof(act_t));
constexpr size_t WS_Z2 = WS_HC + al256((size_t)ROWS * 1536 * sizeof(act_t));
constexpr size_t WS_PD = WS_Z2 + al256((size_t)ROWS * 512 * sizeof(act_t));
constexpr size_t WS_PY = WS_PD + al256((size_t)ROWS * 512 * sizeof(act_t));
constexpr size_t WS_MIX = WS_PY + al256((size_t)ROWS * 512 * sizeof(act_t));
constexpr size_t WS_XW = WS_MIX + al256((size_t)ROWS * 2048 * sizeof(act_t));
constexpr size_t WS_WINT = WS_XW + al256((size_t)ROWS * 2048 * 4);
constexpr size_t WS_WOUTT = WS_WINT + al256((size_t)DEPTH * NINP * DM * 2);
constexpr size_t WS_WUQT = WS_WOUTT + al256((size_t)DEPTH * DM * DM * 2);
constexpr size_t WS_WUKVT = WS_WUQT + al256((size_t)DEPTH * 1536 * 512 * 2);
constexpr size_t WS_WP = WS_WUKVT + al256((size_t)DEPTH * 2048 * 256 * 2);
constexpr size_t WS_UT = WS_WP + al256((size_t)DEPTH * 2048 * 512 * 4);
constexpr size_t WS_HT = WS_UT + al256((size_t)2048 * ROWS * 2);
constexpr size_t WS_RHO = WS_HT + al256((size_t)512 * ROWS * 2);
constexpr size_t WS_RS = WS_RHO + al256((size_t)DEPTH * 2 * 512 * 4096 * 2);
constexpr size_t WS_ROPE = WS_RS + al256((size_t)ROWS * 12 * 4);
constexpr size_t WS_KC = WS_ROPE + al256((size_t)SEQ * 32 * 2 * 4);
constexpr size_t WS_H2B = WS_KC + al256((size_t)DEPTH * 2 * 512 * 512 * 4);
constexpr size_t WS_W3T = WS_H2B + al256((size_t)DEPTH * SEQ * 64 * 2);
constexpr size_t WS_GG = WS_W3T + al256((size_t)DEPTH * 2048 * 64 * 2);
constexpr size_t WS_BIAS = WS_GG + al256((size_t)DEPTH * 5 * DM * 4);
constexpr size_t WS_XSS = WS_BIAS + al256((size_t)DEPTH * 5 * NINP * 4);
constexpr size_t WS_CTL = WS_XSS + al256((size_t)ROWS * 32 * 4);
constexpr size_t CTL_BYTES = 16384;
constexpr size_t WS_END = WS_CTL + CTL_BYTES;

constexpr int LDS_BYTES = 147456;

__device__ __forceinline__ float ldf(const float* p) { return *p; }
__device__ __forceinline__ void stf(float* p, float v) { *p = v; }
__device__ __forceinline__ float bf2f(bf16_t v) { return __uint_as_float((unsigned)v << 16); }
__device__ __forceinline__ bf16_t f2bf(float f) { const unsigned u = __float_as_uint(f); return (bf16_t)((u + 0x7fffu + ((u >> 16) & 1u)) >> 16); }
__device__ __forceinline__ float ldf(const bf16_t* p) { return bf2f(*p); }
__device__ __forceinline__ void stf(bf16_t* p, float v) { *p = f2bf(v); }
__device__ __forceinline__ float fsin(float x) { return __builtin_amdgcn_sinf(x * 0.15915494309189535f); }
__device__ __forceinline__ float fcos(float x) { return __builtin_amdgcn_cosf(x * 0.15915494309189535f); }
__device__ __forceinline__ float silu_f(float x) { return x / (1.f + expf(-x)); }
__device__ __forceinline__ float wave_sum(float v) {
    int lane = (int)__builtin_amdgcn_mbcnt_hi(~0u, __builtin_amdgcn_mbcnt_lo(~0u, 0u)); asm volatile("" : "+v"(lane));
#pragma unroll
    for (int o = 32; o > 0; o >>= 1) v += __int_as_float(__builtin_amdgcn_ds_bpermute((lane ^ o) << 2, __float_as_int(v)));
    return v;
}
struct RowInfo { int b, t, L, n, mr; };
__device__ __forceinline__ RowInfo rowinfo(int row) {
    RowInfo r;
    if (row < ROWS_L) { r.b = row >> 11; r.t = row & 2047; r.L = SEQ; r.n = r.t; r.mr = r.b; }
    else { const int q = row - ROWS_L; r.b = q >> 8; r.t = q & 255; r.L = CTXL; r.n = SEQ + r.t; r.mr = 4; }
    return r;
}
__device__ __forceinline__ const float* xin_row(const Params& p, int l, int row) {
    if (l == 0) return row < ROWS_L ? p.x + (size_t)row * DM : p.ctx + (size_t)(row - ROWS_L) * DM;
    return (const float*)(p.ws + WS_XW) + (size_t)row * DM;
}
#define WSP(T, off) ((T*)(p.ws + (off)))
__device__ __forceinline__ int otid() { int t = threadIdx.x; asm volatile("" : "+v"(t)); return t; }

__device__ void ph_adaln(const Params& p, int bid, int nb, float* sm) {
    const int TX = otid();
    for (int i = TX; i < 5 * DM; i += NT) { const int r = i >> 11, k = i & 2047; sm[i] = silu_f(r < 4 ? p.c[r * DM + k] : p.c_ctx[k]); }
    __syncthreads();
    float* MOD = WSP(float, WS_MOD);
    for (int idx = bid * NT + TX; idx < DEPTH * 6144; idx += nb * NT) {
        const int l = idx / 6144, n = idx % 6144;
        const float* W = p.w_ada + (size_t)l * DM * 6144 + n;
        float a0 = 0, a1 = 0, a2 = 0, a3 = 0, a4 = 0;
        for (int k = 0; k < DM; ++k) { const float w = W[(size_t)k * 6144]; a0 += sm[k] * w; a1 += sm[2048 + k] * w; a2 += sm[4096 + k] * w; a3 += sm[6144 + k] * w; a4 += sm[8192 + k] * w; }
        const float bb = p.b_ada[l * 6144 + n];
        MOD[(l * 5 + 0) * 6144 + n] = a0 + bb; MOD[(l * 5 + 1) * 6144 + n] = a1 + bb; MOD[(l * 5 + 2) * 6144 + n] = a2 + bb;
        MOD[(l * 5 + 3) * 6144 + n] = a3 + bb; MOD[(l * 5 + 4) * 6144 + n] = a4 + bb;
    }
    __syncthreads();
}

__device__ __forceinline__ float filt_feat(int idx, float t, float wpos) {
    if (idx == 0) return t;
    const int i = (idx - 1) & 15; const float band = 1e-4f + (float)i * ((15.f - 1e-4f) / 15.f); const float a = band * wpos;
    return (idx <= 16) ? fcos(a) : -fsin(a);
}
constexpr float HY_DA = -3.0701134573253944f, HY_DB = -15.350567286626973f;
__device__ void ph_filter_ctx(const Params& p, int bid, int nb, float* sm) {
    const int TX = otid();
    float* feats = sm; float* h1 = sm + 64; float* h2 = sm + 128;
    const int tid = TX;
    for (int u = bid; u < DEPTH * CTXL; u += nb) {
        const int l = u >> 8, pos = u & 255, L = CTXL;
        const float t = (float)pos / (float)(L - 1), wpos = (6.283185307179586f / (float)L) * (float)pos;
        if (tid < 33) feats[tid] = filt_feat(tid, t, wpos);
        __syncthreads();
        if (tid < 64) { float s = p.hf_b1[l * 64 + tid];
#pragma unroll 4
            for (int e = 0; e < 33; ++e) s += feats[e] * p.hf_w1[(l * 33 + e) * 64 + tid]; h1[tid] = fsin(p.hf_freq[l * 64 + tid] * s); }
        __syncthreads();
        if (tid < 64) { float s = p.hf_b2[l * 64 + tid];
#pragma unroll 4
            for (int i = 0; i < 64; ++i) s += h1[i] * p.hf_w2[(l * 64 + i) * 64 + tid]; h2[tid] = fsin(p.hf_freq[l * 64 + tid] * s); }
        __syncthreads();
        float* F = WSP(float, WS_FC) + (size_t)l * 2 * 2 * CTXL * 512;
        for (int n = tid; n < 2048; n += NT) {
            float s = 0;
#pragma unroll 8
            for (int j = 0; j < 64; ++j) s += h2[j] * p.hf_w3[((size_t)l * 64 + j) * 2048 + n];
            const int o = n >> 10, d = (n >> 9) & 1, c = n & 511;
            const float delta = fabsf(HY_DA + (float)c * ((HY_DB - HY_DA) / 511.f));
            F[(((size_t)o * 2 + d) * L + pos) * 512 + c] = s * expf(-t * delta);
        }
        __syncthreads();
    }
}
__device__ void ph_fscale_ctx(const Params& p, int bid, int nb) {
    const int TX = otid();
    const int lane = TX & 63, wid = TX >> 6;
    float* FS = WSP(float, WS_FSCL);
    for (int idx = bid * 8 + wid; idx < DEPTH * 1024; idx += nb * 8) {
        const int l = idx >> 10, o = (idx >> 9) & 1, c = idx & 511, L = CTXL;
        const float* F = WSP(float, WS_FC) + (size_t)l * 2 * 2 * CTXL * 512;
        float s = 0;
#pragma unroll
        for (int i = 0; i < 4; ++i) { const int pos = lane + 64 * i;
            const float a = F[(((size_t)o * 2 + 0) * L + pos) * 512 + c]; s += a * a;
            if (pos >= 1) { const float b2 = F[(((size_t)o * 2 + 1) * L + pos) * 512 + c]; s += b2 * b2; } }
        s = wave_sum(s);
        if (lane == 0) FS[idx] = rsqrtf(s + EPS);
    }
}
__device__ void ph_h2(const Params& p, int bid, int nb, float* sm) {
    const int TX = otid();
    const int lane = TX & 63, wid = TX >> 6;
    float* fe = sm + wid * 128; float* h1s = fe + 64;
    for (int u = bid * 8 + wid; u < DEPTH * SEQ; u += nb * 8) {
        const int l = u >> 11, pos = u & 2047;
        const float t = (float)pos / (float)(SEQ - 1), wpos = (6.283185307179586f / (float)SEQ) * (float)pos;
        fe[lane] = lane < 33 ? filt_feat(lane, t, wpos) : 0.f;
        const float fq = p.hf_freq[l * 64 + lane];
        float s = p.hf_b1[l * 64 + lane];
#pragma unroll 3
        for (int e = 0; e < 33; ++e) s += fe[e] * p.hf_w1[(l * 33 + e) * 64 + lane];
        h1s[lane] = fsin(fq * s);
        float s2 = p.hf_b2[l * 64 + lane];
#pragma unroll 4
        for (int i = 0; i < 64; ++i) s2 += h1s[i] * p.hf_w2[(l * 64 + i) * 64 + lane];
        WSP(bf16_t, WS_H2B)[((size_t)l * SEQ + pos) * 64 + lane] = f2bf(fsin(fq * s2));
    }
}
__device__ void ph_rho_mfma(const Params& p, int bid, int nb, float* sm) {
    using bf16x8 = __attribute__((ext_vector_type(8))) short; using f32x16 = __attribute__((ext_vector_type(16))) float;
    const int TX = otid();
    const int tid = TX, lane = tid & 63, wid = tid >> 6, n = lane & 31, h = lane >> 5, dir = n >> 4, ci = n & 15;
    float* red = sm; float* scl = sm + 512;
    for (int u = bid; u < DEPTH * 2 * 32; u += nb) {
        const int l = u >> 6, o = (u >> 5) & 1, c = (u & 31) * 16 + ci;
        const bf16_t* wrow = WSP(bf16_t, WS_W3T) + ((size_t)l * 2048 + o * 1024 + dir * 512 + c) * 64 + 8 * h;
        bf16x8 bfr[4];
#pragma unroll
        for (int ks = 0; ks < 4; ++ks) bfr[ks] = *reinterpret_cast<const bf16x8*>(wrow + 16 * ks);
        const bf16_t* hb = WSP(bf16_t, WS_H2B) + ((size_t)l * SEQ + wid * 256 + n) * 64 + 8 * h;
        f32x16 acc[8];
#pragma unroll
        for (int blk = 0; blk < 8; ++blk) { acc[blk] = f32x16{};
#pragma unroll
            for (int ks = 0; ks < 4; ++ks) acc[blk] = __builtin_amdgcn_mfma_f32_32x32x16_bf16(*reinterpret_cast<const bf16x8*>(hb + (size_t)blk * 32 * 64 + 16 * ks), bfr[ks], acc[blk], 0, 0, 0); }
        const float delta = fabsf(HY_DA + (float)c * ((HY_DB - HY_DA) / 511.f)) * (-1.f / (float)(SEQ - 1));
        int ppb = wid * 256 + 4 * h; asm volatile("" : "+v"(ppb));
        float ss = 0.f;
#pragma unroll
        for (int blk = 0; blk < 8; ++blk)
#pragma unroll
            for (int r = 0; r < 16; ++r) { const int pp = ppb + blk * 32 + (r & 3) + 8 * (r >> 2);
                float v = acc[blk][r] * __expf((float)pp * delta); if (dir == 1 && pp == 0) v = 0.f;
                acc[blk][r] = v; ss += v * v; }
        __syncthreads();
        red[tid] = ss; __syncthreads();
        if (tid < 16) { float t2 = 0.f;
            for (int w = 0; w < 8; ++w) t2 += (red[w * 64 + tid] + red[w * 64 + 16 + tid]) + (red[w * 64 + 32 + tid] + red[w * 64 + 48 + tid]);
            scl[tid] = rsqrtf(t2 + EPS); }
        __syncthreads();
        const float sc = scl[ci], bias = p.hy_bias[(l * 2 + o) * 512 + c];
        bf16_t* R = WSP(bf16_t, WS_RHO) + (((size_t)l * 2 + o) * 512 + c) * 4096 + 2048;
        if (dir == 0) { bf16_t* Rb = R - (wid * 256 + 4 * h);
            if (wid == 0 && h == 0) { acc[0][0] += bias / sc; R[-2048] = 0; }
#pragma unroll
            for (int blk = 0; blk < 8; ++blk)
#pragma unroll
                for (int r = 0; r < 16; ++r) Rb[-(blk * 32 + (r & 3) + 8 * (r >> 2))] = f2bf(acc[blk][r] * sc);
        } else { bf16_t* Rb = R + (wid * 256 + 4 * h);
#pragma unroll
            for (int blk = 0; blk < 8; ++blk)
#pragma unroll
                for (int r = 0; r < 16; ++r) { if (!(blk == 0 && r == 0 && wid == 0 && h == 0)) Rb[blk * 32 + (r & 3) + 8 * (r >> 2)] = f2bf(acc[blk][r] * sc); }
        }
    }
    __syncthreads();
}

__device__ void ph_norm(const Params& p, int l, int bid, int nb) {
    const int TX = otid();
    const int lane = TX & 63, wid = TX >> 6, nw = NT >> 6;
    const float* MOD = WSP(float, WS_MOD); act_t* HA = WSP(act_t, WS_HA);
    for (int row = bid * nw + wid; row < ROWS; row += nb * nw) {
        const RowInfo r = rowinfo(row);
        const float* xr = xin_row(p, l, row);
        float ss = 0;
#pragma unroll 2
        for (int j = 0; j < 8; ++j) { const float4 v = *(const float4*)(xr + (j * 64 + lane) * 4); ss += v.x * v.x + v.y * v.y + v.z * v.z + v.w * v.w; }
        ss = wave_sum(ss);
        const float rstd = rsqrtf(ss * (1.f / DM) + EPS);
        const float* g = p.norm_g + l * DM; const float* sh = MOD + (size_t)(l * 5 + r.mr) * 6144; const float* sc = sh + 2048;
#pragma unroll 1
        for (int j = 0; j < 8; ++j) {
            const int k = (j * 64 + lane) * 4;
            const float4 v = *(const float4*)(xr + k);
            const float e[4] = {v.x, v.y, v.z, v.w};
#pragma unroll
            for (int q = 0; q < 4; ++q) stf(HA + (size_t)row * DM + k + q, e[q] * rstd * g[k + q] * (1.f + sc[k + q]) + sh[k + q]);
        }
    }
}

template <int EPI>
__device__ void gemm_naive(const Params& p, int l, const act_t* A, int lda, const float* B, int ldb, act_t* C, int ldc, int M, int N, int K, int bid, int nb, float* sm) {
    const int TX = otid();
    float* As = sm; float* Bs = sm + 16 * 132;
    const int tid = TX, tx = tid & 15, ty = tid >> 4;
    const int tilesN = N / 64, tiles = (M / 128) * tilesN;
    for (int tile = bid; tile < tiles; tile += nb) {
        const int m0 = (tile / tilesN) * 128, n0 = (tile % tilesN) * 64;
        float acc[4][4];
#pragma unroll
        for (int i = 0; i < 4; ++i)
#pragma unroll
            for (int j = 0; j < 4; ++j) acc[i][j] = 0.f;
        for (int k0 = 0; k0 < K; k0 += 16) {
            { const int r = tid >> 2, kq = (tid & 3) * 4; const act_t* ap = A + (size_t)(m0 + r) * lda + k0 + kq;
              As[(kq + 0) * 132 + r] = ldf(ap); As[(kq + 1) * 132 + r] = ldf(ap + 1); As[(kq + 2) * 132 + r] = ldf(ap + 2); As[(kq + 3) * 132 + r] = ldf(ap + 3); }
            { const int kk = tid >> 5, nn = (tid & 31) * 2; const float* bp = B + (size_t)(k0 + kk) * ldb + n0 + nn; Bs[kk * 64 + nn] = bp[0]; Bs[kk * 64 + nn + 1] = bp[1]; }
            __syncthreads();
#pragma unroll
            for (int kk = 0; kk < 16; ++kk) {
                const float4 a = *(const float4*)&As[kk * 132 + ty * 4]; const float4 b = *(const float4*)&Bs[kk * 64 + tx * 4];
                const float av[4] = {a.x, a.y, a.z, a.w}, bv[4] = {b.x, b.y, b.z, b.w};
#pragma unroll
                for (int i = 0; i < 4; ++i)
#pragma unroll
                    for (int j = 0; j < 4; ++j) acc[i][j] += av[i] * bv[j];
            }
            __syncthreads();
        }
#pragma unroll
        for (int i = 0; i < 4; ++i) {
            const int m = m0 + ty * 4 + i;
            if (EPI == 0) {
#pragma unroll
                for (int j = 0; j < 4; ++j) stf(C + (size_t)m * ldc + n0 + tx * 4 + j, acc[i][j]);
            } else {
                const RowInfo r = rowinfo(m);
                const float* xr = xin_row(p, l, m);
                const float* gate = WSP(float, WS_MOD) + (size_t)(l * 5 + r.mr) * 6144 + 4096;
                float* XW = WSP(float, WS_XW) + (size_t)m * DM;
#pragma unroll
                for (int j = 0; j < 4; ++j) { const int n = n0 + tx * 4 + j; XW[n] = xr[n] + gate[n] * acc[i][j]; }
            }
        }
    }
}

__device__ void ph_rstd(const Params& p, int bid, int nb) {
    const int TX = otid();
    const int lane = TX & 63, wid = TX >> 6;
    const bf16_t* U = WSP(bf16_t, WS_U); float* RS = WSP(float, WS_RS);
    for (int row = bid * 8 + wid; row < ROWS; row += nb * 8) {
        const bf16_t* ur = U + (size_t)row * NIN;
        const uint4 a = *(const uint4*)(ur + OFF_Q + lane * 8); const uint2 k = *(const uint2*)(ur + OFF_KV + lane * 4);
        const unsigned w[4] = {a.x, a.y, a.z, a.w}; float sq = 0.f, sk = 0.f;
#pragma unroll
        for (int i = 0; i < 4; ++i) { const float lo = __uint_as_float(w[i] << 16), hi = __uint_as_float(w[i] & 0xffff0000u); sq += lo * lo + hi * hi; }
        { const float lo0 = __uint_as_float(k.x << 16), hi0 = __uint_as_float(k.x & 0xffff0000u), lo1 = __uint_as_float(k.y << 16), hi1 = __uint_as_float(k.y & 0xffff0000u); sk = lo0 * lo0 + hi0 * hi0 + lo1 * lo1 + hi1 * hi1; }
        sq = wave_sum(sq); sk = wave_sum(sk);
        if (lane == 0) { RS[2 * row] = rsqrtf(sq * (1.f / QRANK) + EPS); RS[2 * row + 1] = rsqrtf(sk * (1.f / KVRANK) + EPS); }
    }
}
__device__ void ph_krope(const Params& p, int bid, int nb) {
    const int TX = otid();
    const bf16_t* U = WSP(bf16_t, WS_U); bf16_t* KB = WSP(bf16_t, WS_KB); const float* ROPE = WSP(float, WS_ROPE);
    for (int idx = bid * NT + TX; idx < ROWS * 8; idx += nb * NT) {
        const int row = idx >> 3, ch = idx & 7; const RowInfo r = rowinfo(row);
        const uint4 a = *(const uint4*)(U + (size_t)row * NIN + OFF_KR + ch * 8);
        const unsigned w[4] = {a.x, a.y, a.z, a.w}; unsigned o[4];
#pragma unroll
        for (int i = 0; i < 4; ++i) { float x0 = __uint_as_float(w[i] << 16), x1 = __uint_as_float(w[i] & 0xffff0000u);
            if (row < ROWS_L) { const float cs = ROPE[((size_t)r.t * 32 + ch * 4 + i) * 2], sn = ROPE[((size_t)r.t * 32 + ch * 4 + i) * 2 + 1]; const float y0 = x0 * cs - x1 * sn, y1 = x0 * sn + x1 * cs; x0 = y0; x1 = y1; }
            o[i] = (unsigned)f2bf(x0) | ((unsigned)f2bf(x1) << 16); }
#pragma unroll
        for (int h = 0; h < 8; ++h) *(uint4*)(KB + ((size_t)(r.b * NH + h) * LK + r.n) * 192 + 128 + ch * 8) = make_uint4(o[0], o[1], o[2], o[3]);
    }
}
__device__ void ph_shortconv(const Params& p, int l, int bid, int nb) {
    const int TX = otid();
    const act_t* U = WSP(act_t, WS_U); act_t* HC = WSP(act_t, WS_HC);
    const float* w = p.hy_conv_w + (size_t)l * 3 * 1536; const float* bb = p.hy_conv_b + l * 1536;
    for (size_t idx = (size_t)bid * NT + TX; idx < (size_t)ROWS_C * 1536; idx += (size_t)nb * NT) {
        const int row = ROWS_L + (int)(idx / 1536), c = (int)(idx % 1536);
        const RowInfo r = rowinfo(row);
        const float cur = ldf(U + (size_t)row * NIN + c);
        const float prev = r.t > 0 ? ldf(U + (size_t)(row - 1) * NIN + c) : 0.f;
        const float next = r.t < r.L - 1 ? ldf(U + (size_t)(row + 1) * NIN + c) : 0.f;
        stf(HC + (size_t)row * 1536 + c, prev * w[c] + cur * w[1536 + c] + next * w[3072 + c] + bb[c]);
    }
}
__device__ void ph_pooldiff(const Params& p, int bid, int nb) {
    const int TX = otid();
    const act_t* U = WSP(act_t, WS_U); act_t* PD = WSP(act_t, WS_PD);
    for (size_t idx = (size_t)bid * NT + TX; idx < (size_t)ROWS * 512; idx += (size_t)nb * NT) {
        const int row = (int)(idx >> 9), j = (int)(idx & 511);
        const RowInfo r = rowinfo(row);
        const int half = 1 << (j >> 7);
        const int lo = max(r.t - half, 0), hi = min(r.t + half, r.L);
        float s = 0;
        for (int q = lo; q < hi; ++q) s += ldf(U + (size_t)(row - r.t + q) * NIN + OFF_POOL + j);
        stf(PD + idx, s / (float)(hi - lo) - ldf(U + (size_t)row * NIN + OFF_POOL + j));
    }
}
__device__ void ph_poolgate(const Params& p, int l, int bid, int nb) {
    const int TX = otid();
    const act_t* U = WSP(act_t, WS_U); const act_t* PY = WSP(act_t, WS_PY); act_t* MIX = WSP(act_t, WS_MIX);
    for (size_t idx = (size_t)bid * NT + TX; idx < (size_t)ROWS * 512; idx += (size_t)nb * NT) {
        const int row = (int)(idx >> 9), j = (int)(idx & 511);
        stf(MIX + (size_t)row * DM + 1536 + j, ldf(PY + idx) * p.pool_scale[l * 512 + j] * silu_f(ldf(U + (size_t)row * NIN + OFF_POOL_G + j)));
    }
}
__device__ void ph_conv(const Params& p, int l, int order, int bid, int nb, float* sm) {
    const int TX = otid();
    float* Zs = sm; float* Ks = sm + 4096;
    const int tid = TX, c = tid & 63, tg = tid >> 6;
    const act_t* U = WSP(act_t, WS_U); const act_t* HC = WSP(act_t, WS_HC); act_t* Z2 = WSP(act_t, WS_Z2); act_t* MIX = WSP(act_t, WS_MIX);
    const act_t* zsrc = order == 0 ? HC : Z2; const int zld = order == 0 ? 1536 : 512;
    const int nlat = NB * (SEQ / 64) * 8, nctx = (l < DEPTH - 1) ? NB * (CTXL / 64) * 8 : 0;
    for (int u = nlat + bid; u < nlat + nctx; u += nb) {
        int Lidx, b, T0, c0, L, rowbase;
        if (u < nlat) { Lidx = 0; L = SEQ; b = u >> 8; T0 = ((u >> 3) & 31) * 64; c0 = (u & 7) * 64; rowbase = b * SEQ; }
        else { const int v = u - nlat; Lidx = 1; L = CTXL; b = v >> 5; T0 = ((v >> 3) & 3) * 64; c0 = (v & 7) * 64; rowbase = ROWS_L + b * CTXL; }
        const float* F = WSP(float, WS_FC) + ((size_t)l * 2 + order) * 2 * CTXL * 512;
        float acc[8];
#pragma unroll
        for (int i = 0; i < 8; ++i) acc[i] = 0.f;
        for (int S0 = 0; S0 < L; S0 += 64) {
            for (int i = tid; i < 4096; i += NT) { const int ss = i >> 6, cc = i & 63; Zs[i] = ldf(zsrc + (size_t)(rowbase + S0 + ss) * zld + c0 + cc); }
            for (int i = tid; i < 127 * 64; i += NT) { const int j = i >> 6, cc = i & 63; const int n = T0 - S0 + j - 63;
                Ks[i] = n >= 0 ? F[((size_t)0 * L + n) * 512 + c0 + cc] : F[((size_t)1 * L + (-n)) * 512 + c0 + cc]; }
            __syncthreads();
            for (int ss = 0; ss < 64; ++ss) { const float z = Zs[ss * 64 + c];
#pragma unroll
                for (int i = 0; i < 8; ++i) acc[i] += z * Ks[(tg * 8 + i - ss + 63) * 64 + c]; }
            __syncthreads();
        }
        const float scl = WSP(float, WS_FSCL)[(l * 2 + order) * 512 + c0 + c], bias = p.hy_bias[(l * 2 + order) * 512 + c0 + c]; (void)Lidx;
#pragma unroll
        for (int i = 0; i < 8; ++i) {
            const int row = rowbase + T0 + tg * 8 + i;
            const float zt = ldf(zsrc + (size_t)row * zld + c0 + c);
            const float y = scl * acc[i] + bias * zt;
            if (order == 0) stf(Z2 + (size_t)row * 512 + c0 + c, ldf(HC + (size_t)row * 1536 + 512 + c0 + c) * y);
            else stf(MIX + (size_t)row * DM + c0 + c, ldf(HC + (size_t)row * 1536 + 1024 + c0 + c) * y * silu_f(ldf(U + (size_t)row * NIN + OFF_HY_G + c0 + c)));
        }
    }
}

__device__ void ph_final(const Params& p, int bid, int nb) {
    const int TX = otid();
    const int lane = TX & 63, wid = TX >> 6, nw = NT >> 6;
    for (int row = bid * nw + wid; row < ROWS_L; row += nb * nw) {
        const float* xr = WSP(float, WS_XW) + (size_t)row * DM;
        float ss = lane < 32 ? WSP(float, WS_XSS)[(size_t)row * 32 + lane] : 0.f;
        ss = wave_sum(ss);
        const float rstd = rsqrtf(ss * (1.f / DM) + EPS);
#pragma unroll 2
        for (int j = 0; j < 8; ++j) { const int k = (j * 64 + lane) * 4; const float4 v = *(const float4*)(xr + k); const float4 g = *(const float4*)(p.final_norm_g + k);
            *(float4*)(p.out + (size_t)row * DM + k) = make_float4(v.x * rstd * g.x, v.y * rstd * g.y, v.z * rstd * g.z, v.w * rstd * g.w); }
    }
}

namespace pg8 {
#define PG8_LAS __attribute__((address_space(3)))
typedef unsigned short bf16_t;
typedef short bf16x8 __attribute__((ext_vector_type(8)));
typedef float f32x4 __attribute__((ext_vector_type(4)));
typedef unsigned u32x4 __attribute__((ext_vector_type(4)));
constexpr int BM = 256, BK = 64, HALF = 128, HTB = HALF * BK * 2  , STAGE_BYTES = 8 * HTB, NXCD = 8, WGM = 8;

__host__ __device__ __forceinline__ int lds_byte(int r, int c) { const int st = (r >> 4) * 2 + (c >> 5), rr = r & 15, cc = c & 31, ob = rr * 64 + cc * 2; return st * 1024 + (ob ^ (((ob >> 9) & 1) << 5)); }
__host__ __device__ __forceinline__ void stage_rc(int b, int& R, int& C) { const int st = b / 1024, sb = b % 1024, swz = sb ^ (((sb >> 9) & 1) << 5); R = (st >> 1) * 16 + swz / 64; C = (st & 1) * 32 + (swz % 64) / 2; }
__host__ __device__ __forceinline__ int perm32(int rho) { const int n = rho >> 4, i = rho & 15; return 8 * (i >> 2) + 4 * n + (i & 3); }

struct Unit { int pm, pn; };
struct Gemm { const bf16_t* A; const bf16_t* Bt; int M, N, K, lda; };

struct StaticOrder {
    int nM, nN, nwg, G, c;
    __host__ __device__ void init(int M, int N, int G_, int c_) { nM = M / BM; nN = N / BM; nwg = nM * nN; G = G_; c = c_; }
    __host__ __device__ bool next(int i, Unit& u) const {
        const long L = (long)i * G + c; if (L >= nwg) return false;
        int wgid = (int)L; { const int q = nwg / NXCD, r = nwg % NXCD, xcd = wgid % NXCD, off = wgid / NXCD; wgid = (xcd < r ? xcd * (q + 1) : r * (q + 1) + (xcd - r) * q) + off; }
        const int nig = WGM * nN, gid = wgid / nig, fm = gid * WGM, gsz = (nM - fm) < WGM ? (nM - fm) : WGM;
        u.pm = fm + ((wgid % nig) % gsz); u.pn = (wgid % nig) / gsz; return true;
    }
    __device__ __forceinline__ void a_ready(const Unit&) const {}
    __device__ __forceinline__ void done(const Unit&) const {}
};

__device__ __forceinline__ unsigned cvt_pk_bf16(float lo, float hi) { unsigned r; asm volatile("v_cvt_pk_bf16_f32 %0, %1, %2" : "=v"(r) : "v"(lo), "v"(hi)); return r; }

typedef unsigned u32x4_t __attribute__((ext_vector_type(4)));
struct EpiStoreBf16 {
    static constexpr bool PERM = true, AFTER_DRAIN = false;
    bf16_t* O; int ldc; int ncols;
    __device__ __forceinline__ void operator()(const f32x4 (&acc)[2][2][4][2], const Unit& u, int wr, int wc, int fr, int fq) const {
        const int row0 = u.pm * BM + wr * 64 + fr, col0 = u.pn * BM + wc * 32 + 8 * fq;
#pragma unroll
        for (int ai = 0; ai < 2; ++ai)
#pragma unroll
            for (int m = 0; m < 4; ++m) { bf16_t* rowp = O + (size_t)(row0 + ai * HALF + m * 16) * ldc + col0;
#pragma unroll
                for (int bj = 0; bj < 2; ++bj) { if (col0 + bj * HALF < ncols) { const f32x4 v0 = acc[ai][bj][m][0], v1 = acc[ai][bj][m][1];
                    u32x4_t w; w.x = cvt_pk_bf16(v0[0], v0[1]); w.y = cvt_pk_bf16(v0[2], v0[3]); w.z = cvt_pk_bf16(v1[0], v1[1]); w.w = cvt_pk_bf16(v1[2], v1[3]);
                    *(u32x4_t*)(rowp + bj * HALF) = w; } } }
    }
};


struct EpiU {
    static constexpr bool PERM = true, AFTER_DRAIN = false;
    bf16_t* U; bf16_t* UT; float* SSP; int ldc, ncols, rows; const float* XSS; const float* BIAS;
    __device__ __forceinline__ void operator()(const f32x4 (&accin)[2][2][4][2], const Unit& u, int wr, int wc, int fr, int fq) const {
        const int row0 = u.pm * BM + wr * 64 + fr, col0 = u.pn * BM + wc * 32 + 8 * fq;
        f32x4 acc[2][2][4][2];
        const float* bp = BIAS + (size_t)(u.pm < 32 ? (u.pm >> 3) : 4) * 5120 + col0;
        const f32x4 bb[2][2] = {{*(const f32x4*)bp, *(const f32x4*)(bp + 4)}, {*(const f32x4*)(bp + HALF), *(const f32x4*)(bp + HALF + 4)}};
#pragma unroll
        for (int ai = 0; ai < 2; ++ai)
#pragma unroll
            for (int m = 0; m < 4; ++m) { const int row = row0 + ai * HALF + m * 16;
                const f32x4 s0 = *(const f32x4*)(XSS + (size_t)row * 32 + fq * 8), s1 = *(const f32x4*)(XSS + (size_t)row * 32 + fq * 8 + 4);
                float ps = ((s0[0] + s0[1]) + (s0[2] + s0[3])) + ((s1[0] + s1[1]) + (s1[2] + s1[3]));
                ps += __shfl_xor(ps, 16); ps += __shfl_xor(ps, 32);
                const float rstd = rsqrtf(ps * (1.f / 2048.f) + 1e-6f);
#pragma unroll
                for (int bj = 0; bj < 2; ++bj) { acc[ai][bj][m][0] = accin[ai][bj][m][0] * rstd + bb[bj][0]; acc[ai][bj][m][1] = accin[ai][bj][m][1] * rstd + bb[bj][1]; } }
        if (u.pn < 8) {
#pragma unroll
            for (int ai = 0; ai < 2; ++ai)
#pragma unroll
                for (int m = 0; m < 4; ++m) { bf16_t* cp = UT + (size_t)col0 * rows + row0 + ai * HALF + m * 16;
#pragma unroll
                    for (int bj = 0; bj < 2; ++bj)
#pragma unroll
                        for (int n = 0; n < 2; ++n) { const f32x4 v = acc[ai][bj][m][n]; const unsigned w0 = cvt_pk_bf16(v[0], v[1]), w1 = cvt_pk_bf16(v[2], v[3]);
                            bf16_t* q = cp + (size_t)(bj * HALF + 4 * n) * rows;
                            q[0] = (bf16_t)(w0 & 0xffffu); q[rows] = (bf16_t)(w0 >> 16); q[2 * (size_t)rows] = (bf16_t)(w1 & 0xffffu); q[3 * (size_t)rows] = (bf16_t)(w1 >> 16); } }
            return;
        }
        const bool stat = u.pn <= 10;
#pragma unroll
        for (int ai = 0; ai < 2; ++ai)
#pragma unroll
            for (int m = 0; m < 4; ++m) { const int row = row0 + ai * HALF + m * 16; bf16_t* rowp = U + (size_t)row * ldc + col0; float ss = 0.f;
#pragma unroll
                for (int bj = 0; bj < 2; ++bj) { if (col0 + bj * HALF < ncols) { const f32x4 v0 = acc[ai][bj][m][0], v1 = acc[ai][bj][m][1];
                    ss += (v0[0] * v0[0] + v0[1] * v0[1]) + (v0[2] * v0[2] + v0[3] * v0[3]) + (v1[0] * v1[0] + v1[1] * v1[1]) + (v1[2] * v1[2] + v1[3] * v1[3]);
                    u32x4_t w; w.x = cvt_pk_bf16(v0[0], v0[1]); w.y = cvt_pk_bf16(v0[2], v0[3]); w.z = cvt_pk_bf16(v1[0], v1[1]); w.w = cvt_pk_bf16(v1[2], v1[3]);
                    *(u32x4_t*)(rowp + bj * HALF) = w; } }
                if (stat) { ss += __shfl_xor(ss, 16); ss += __shfl_xor(ss, 32);
                    if (fq == 0) SSP[(size_t)row * 12 + (u.pn - 8) * 4 + wc] = ss; } }
    }
};
struct EpiQ {
    static constexpr bool PERM = true, AFTER_DRAIN = false;
    bf16_t* Q; const float* RS; const float* ROPE;
    __device__ __forceinline__ void operator()(const f32x4 (&acc)[2][2][4][2], const Unit& u, int wr, int wc, int fr, int fq) const {
        const int row0 = u.pm * BM + wr * 64 + fr, col0 = u.pn * BM + wc * 32 + 8 * fq;
#pragma unroll
        for (int ai = 0; ai < 2; ++ai)
#pragma unroll
            for (int m = 0; m < 4; ++m) { const int row = row0 + ai * HALF + m * 16; const bool lat = row < 8192;
                const int b = lat ? (row >> 11) : ((row - 8192) >> 8), n = lat ? (row & 2047) : 2048 + ((row - 8192) & 255);
                const float* sp = RS + (size_t)row * 12; const float rs = rsqrtf((((sp[0] + sp[1]) + (sp[2] + sp[3])) + ((sp[4] + sp[5]) + (sp[6] + sp[7]))) * (1.f / 512.f) + 1e-6f);
#pragma unroll
                for (int bj = 0; bj < 2; ++bj) { const int col = col0 + bj * HALF, h = col / 192, d = col - h * 192;
                    f32x4 v0 = acc[ai][bj][m][0] * rs, v1 = acc[ai][bj][m][1] * rs;
                    if (d >= 128 && lat) { const float* rp = ROPE + ((size_t)n * 32 + ((d - 128) >> 1)) * 2; const f32x4 r0 = *(const f32x4*)rp, r1 = *(const f32x4*)(rp + 4);
                        const f32x4 a0 = v0, a1 = v1;
                        v0[0] = a0[0] * r0[0] - a0[1] * r0[1]; v0[1] = a0[0] * r0[1] + a0[1] * r0[0]; v0[2] = a0[2] * r0[2] - a0[3] * r0[3]; v0[3] = a0[2] * r0[3] + a0[3] * r0[2];
                        v1[0] = a1[0] * r1[0] - a1[1] * r1[1]; v1[1] = a1[0] * r1[1] + a1[1] * r1[0]; v1[2] = a1[2] * r1[2] - a1[3] * r1[3]; v1[3] = a1[2] * r1[3] + a1[3] * r1[2]; }
                    u32x4_t w; w.x = cvt_pk_bf16(v0[0], v0[1]); w.y = cvt_pk_bf16(v0[2], v0[3]); w.z = cvt_pk_bf16(v1[0], v1[1]); w.w = cvt_pk_bf16(v1[2], v1[3]);
                    *(u32x4_t*)(Q + ((size_t)(b * 8 + h) * 2304 + n) * 192 + d) = w; } }
    }
};
struct EpiKV {
    static constexpr bool PERM = true, AFTER_DRAIN = false;
    bf16_t* KB; bf16_t* VB; const float* RS;
    __device__ __forceinline__ void operator()(const f32x4 (&acc)[2][2][4][2], const Unit& u, int wr, int wc, int fr, int fq) const {
        const int row0 = u.pm * BM + wr * 64 + fr, col0 = u.pn * BM + wc * 32 + 8 * fq;
#pragma unroll
        for (int ai = 0; ai < 2; ++ai)
#pragma unroll
            for (int m = 0; m < 4; ++m) { const int row = row0 + ai * HALF + m * 16; const bool lat = row < 8192;
                const int b = lat ? (row >> 11) : ((row - 8192) >> 8), n = lat ? (row & 2047) : 2048 + ((row - 8192) & 255);
                const float* sp = RS + (size_t)row * 12 + 8; const float rs = rsqrtf(((sp[0] + sp[1]) + (sp[2] + sp[3])) * (1.f / 256.f) + 1e-6f);
#pragma unroll
                for (int bj = 0; bj < 2; ++bj) { const int col = col0 + bj * HALF, h = col >> 8, d = col & 255;
                    const f32x4 v0 = acc[ai][bj][m][0] * rs, v1 = acc[ai][bj][m][1] * rs;
                    u32x4_t w; w.x = cvt_pk_bf16(v0[0], v0[1]); w.y = cvt_pk_bf16(v0[2], v0[3]); w.z = cvt_pk_bf16(v1[0], v1[1]); w.w = cvt_pk_bf16(v1[2], v1[3]);
                    const size_t pos = (size_t)(b * 8 + h) * 2304 + n;
                    if (d < 128) *(u32x4_t*)(KB + pos * 192 + d) = w; else *(u32x4_t*)(VB + pos * 128 + (d - 128)) = w; } }
    }
};
struct EpiResid {
    static constexpr bool PERM = true, AFTER_DRAIN = false;
    const float* xl; const float* xc; float* XW; const float* gate;
    const float* GG; bf16_t* XG; float* XSS;
    __device__ __forceinline__ void operator()(const f32x4 (&acc)[2][2][4][2], const Unit& u, int wr, int wc, int fr, int fq) const {
        const int col0 = u.pn * BM + wc * 32 + 8 * fq, mr = u.pm < 32 ? (u.pm >> 3) : 4;
        f32x4 gt[2][2], gg[2][2];
#pragma unroll
        for (int bj = 0; bj < 2; ++bj)
#pragma unroll
            for (int n = 0; n < 2; ++n) { const int c = col0 + bj * HALF + n * 4; gt[bj][n] = *(const f32x4*)(gate + (size_t)mr * 6144 + c);
                gg[bj][n] = GG ? *(const f32x4*)(GG + (size_t)mr * 2048 + c) : (f32x4){0.f, 0.f, 0.f, 0.f}; }
#pragma unroll
        for (int ai = 0; ai < 2; ++ai)
#pragma unroll
            for (int m = 0; m < 4; ++m) { const int row = u.pm * BM + ai * HALF + wr * 64 + m * 16 + fr;
                const float* xr = row < 8192 ? xl + (size_t)row * 2048 : xc + (size_t)(row - 8192) * 2048;
                float* o = XW + (size_t)row * 2048; float ss = 0.f;
#pragma unroll
                for (int bj = 0; bj < 2; ++bj) { const int c = col0 + bj * HALF;
                    const f32x4 x0 = *(const f32x4*)(xr + c), x1 = *(const f32x4*)(xr + c + 4);
                    const f32x4 n0 = x0 + gt[bj][0] * acc[ai][bj][m][0], n1 = x1 + gt[bj][1] * acc[ai][bj][m][1];
                    *(f32x4*)(o + c) = n0; *(f32x4*)(o + c + 4) = n1;
                    ss += ((n0[0] * n0[0] + n0[1] * n0[1]) + (n0[2] * n0[2] + n0[3] * n0[3])) + ((n1[0] * n1[0] + n1[1] * n1[1]) + (n1[2] * n1[2] + n1[3] * n1[3]));
                    if (GG) { const f32x4 q0 = n0 * gg[bj][0], q1 = n1 * gg[bj][1]; u32x4_t w; w.x = cvt_pk_bf16(q0[0], q0[1]); w.y = cvt_pk_bf16(q0[2], q0[3]); w.z = cvt_pk_bf16(q1[0], q1[1]); w.w = cvt_pk_bf16(q1[2], q1[3]);
                        *(u32x4_t*)(XG + (size_t)row * 2048 + c) = w; } }
                ss += __shfl_xor(ss, 16); ss += __shfl_xor(ss, 32);
                if (fq == 0) XSS[(size_t)row * 32 + u.pn * 4 + wc] = ss; }
    }
};

template <class Epi, class Sched, bool ALIGN_EPI = false, bool SP2 = false>
__device__ __forceinline__ void gemm_phase(PG8_LAS unsigned char* lds, const Gemm g, const Sched& S, const Epi& E) {
    int tid_ = threadIdx.x; asm volatile("" : "+v"(tid_));
    const int tid = tid_, wid = __builtin_amdgcn_readfirstlane(tid >> 6), lane = tid & 63, wr = wid >> 2, wc = wid & 3, fr = lane & 15, fq = lane >> 4;
    const int K = g.K, nt = K / BK;
    unsigned voffA[2], voffB[2];
#pragma unroll
    for (int i = 0; i < 2; ++i) { int R, C; stage_rc(tid * 16 + i * 8192, R, C); const int Rb = Epi::PERM ? ((R & ~31) + perm32(R & 31)) : R;
        voffA[i] = (unsigned)(R * g.lda + C) * 2u; voffB[i] = (unsigned)(Rb * K + C) * 2u; }
    const size_t kstep = (size_t)(BK * 2);
    const size_t hstep = (size_t)HALF * K * 2;
    const size_t tstep = 2 * hstep;
    const size_t hstepA = (size_t)HALF * g.lda * 2, tstepA = 2 * hstepA;
    const unsigned ldsw = (unsigned)wid * 1024u;
    const int aoff = lds_byte(wr * 64 + fr, fq * 8), boff = lds_byte(wc * 32 + fr, fq * 8);
#define PG8_SA(b, h) (((b) * 2 + (h)) * HTB)
#define PG8_SB(b, h) ((4 + (b) * 2 + (h)) * HTB)
#define PG8_STAGE(bufoff, gbase, voff) do { _Pragma("unroll") for (int _i = 0; _i < 2; ++_i) \
        __builtin_amdgcn_global_load_lds((const unsigned*)((const char*)(gbase) + (voff)[_i]), (PG8_LAS unsigned*)(lds + (bufoff) + ldsw + _i * 8192), 16, 0, 0); } while (0)
#define PG8_LDA(dst, b, h) do { _Pragma("unroll") for (int m = 0; m < 4; ++m) _Pragma("unroll") for (int k = 0; k < 2; ++k) dst[m][k] = *(const PG8_LAS bf16x8*)(lds + PG8_SA(b, h) + aoff + m * 2048 + k * 1024); } while (0)
#define PG8_LDB(dst, b, h) do { _Pragma("unroll") for (int n = 0; n < 2; ++n) _Pragma("unroll") for (int k = 0; k < 2; ++k) dst[n][k] = *(const PG8_LAS bf16x8*)(lds + PG8_SB(b, h) + boff + n * 2048 + k * 1024); } while (0)
#define PG8_MMA(ai, bj, At, Bt) do { __builtin_amdgcn_s_setprio(1); _Pragma("unroll") for (int m = 0; m < 4; ++m) _Pragma("unroll") for (int n = 0; n < 2; ++n) _Pragma("unroll") for (int k = 0; k < 2; ++k) \
        acc[ai][bj][m][n] = __builtin_amdgcn_mfma_f32_16x16x32_bf16(Bt[n][k], At[m][k], acc[ai][bj][m][n], 0, 0, 0); __builtin_amdgcn_s_setprio(0); } while (0)
#define PG8_WAIT_V(n) asm volatile("s_waitcnt vmcnt(" #n ")" ::: "memory")
#define PG8_WAIT_L(n) asm volatile("s_waitcnt lgkmcnt(" #n ")" ::: "memory")
#define PG8_BAR __builtin_amdgcn_s_barrier()
#define PG8_SCHED __builtin_amdgcn_sched_barrier(0)
    Unit cur, nxt; int ui = 0;
    if (!S.next(0, cur)) return;
    f32x4 acc[2][2][4][2];
#pragma unroll
    for (int a = 0; a < 2; ++a)
#pragma unroll
        for (int b = 0; b < 2; ++b)
#pragma unroll
            for (int m = 0; m < 4; ++m)
#pragma unroll
                for (int n = 0; n < 2; ++n) acc[a][b][m][n] = (f32x4){0.f, 0.f, 0.f, 0.f};
    bf16x8 At[4][2], B0[2][2], B1[2][2];
    const char* cA = (const char*)g.A + (size_t)cur.pm * tstepA; const char* cB = (const char*)g.Bt + (size_t)cur.pn * tstep;
    S.a_ready(cur);
    if constexpr (SP2) {
        PG8_STAGE(PG8_SB(0, 0), cB, voffB); PG8_STAGE(PG8_SB(0, 1), cB + hstep, voffB); PG8_STAGE(PG8_SA(0, 0), cA, voffA); PG8_STAGE(PG8_SA(0, 1), cA + hstepA, voffA);
        if (wr == 1) PG8_BAR;
        PG8_WAIT_V(2); PG8_BAR;
        PG8_STAGE(PG8_SB(1, 0), cB + kstep, voffB); PG8_STAGE(PG8_SA(1, 0), cA + kstep, voffA); PG8_STAGE(PG8_SB(1, 1), cB + hstep + kstep, voffB);
        PG8_WAIT_V(6); PG8_BAR;
    } else {
        PG8_STAGE(PG8_SB(0, 0), cB, voffB); PG8_STAGE(PG8_SA(0, 0), cA, voffA); PG8_STAGE(PG8_SB(0, 1), cB + hstep, voffB); PG8_STAGE(PG8_SA(0, 1), cA + hstepA, voffA);
        if (wr == 1) PG8_BAR;
        PG8_WAIT_V(4); PG8_BAR;
        PG8_STAGE(PG8_SB(1, 0), cB + kstep, voffB); PG8_STAGE(PG8_SA(1, 0), cA + kstep, voffA); PG8_STAGE(PG8_SB(1, 1), cB + hstep + kstep, voffB);
        PG8_WAIT_V(6); PG8_BAR;
    }
    for (;;) {
        const bool has_next = S.next(ui + 1, nxt);
        const char* nA = has_next ? (const char*)g.A + (size_t)nxt.pm * tstepA : cA; const char* nB = has_next ? (const char*)g.Bt + (size_t)nxt.pn * tstep : cB;
        for (int t = 0; t < nt; t += 2) {
            const bool last = (t == nt - 2);
            const char* a1 = cA + (size_t)(t + 1) * kstep;
            const char* a2 = last ? nA : cA + (size_t)(t + 2) * kstep; const char* b2 = last ? nB : cB + (size_t)(t + 2) * kstep;
            const char* a3 = a2 + kstep; const char* b3 = b2 + kstep;
            if (last && has_next) S.a_ready(nxt);
            if constexpr (SP2) {
            PG8_LDB(B0, 0, 0); PG8_LDB(B1, 0, 1); PG8_SCHED; PG8_LDA(At, 0, 0); PG8_STAGE(PG8_SA(1, 1), a1 + hstepA, voffA);
            PG8_WAIT_V(8); PG8_WAIT_L(0); PG8_BAR; PG8_MMA(0, 0, At, B0); PG8_MMA(0, 1, At, B1); PG8_BAR; PG8_SCHED;
            PG8_LDA(At, 0, 1); PG8_STAGE(PG8_SB(0, 0), b2, voffB); PG8_STAGE(PG8_SB(0, 1), b2 + hstep, voffB); PG8_STAGE(PG8_SA(0, 0), a2, voffA);
            PG8_WAIT_V(8); PG8_WAIT_L(0); PG8_BAR; PG8_MMA(1, 0, At, B0); PG8_MMA(1, 1, At, B1); PG8_BAR; PG8_SCHED;
            PG8_LDB(B0, 1, 0); PG8_LDB(B1, 1, 1); PG8_SCHED; PG8_LDA(At, 1, 0); PG8_STAGE(PG8_SA(0, 1), a2 + hstepA, voffA);
            PG8_WAIT_V(8); PG8_WAIT_L(0); PG8_BAR; PG8_MMA(0, 0, At, B0); PG8_MMA(0, 1, At, B1); PG8_BAR; PG8_SCHED;
            PG8_LDA(At, 1, 1); PG8_STAGE(PG8_SB(1, 0), b3, voffB); PG8_STAGE(PG8_SB(1, 1), b3 + hstep, voffB); PG8_STAGE(PG8_SA(1, 0), a3, voffA);
            PG8_WAIT_V(8); PG8_WAIT_L(0); PG8_BAR; PG8_MMA(1, 0, At, B0); PG8_MMA(1, 1, At, B1); PG8_BAR; PG8_SCHED;
            } else {
            PG8_LDB(B0, 0, 0); PG8_SCHED; PG8_LDA(At, 0, 0); PG8_STAGE(PG8_SA(1, 1), a1 + hstepA, voffA);
            PG8_WAIT_L(8); PG8_BAR; PG8_WAIT_L(0); PG8_MMA(0, 0, At, B0); PG8_BAR; PG8_SCHED;
            PG8_LDB(B1, 0, 1); PG8_STAGE(PG8_SB(0, 0), b2, voffB);
            PG8_BAR; PG8_WAIT_L(0); PG8_MMA(0, 1, At, B1); PG8_BAR;
            PG8_LDA(At, 0, 1); PG8_STAGE(PG8_SA(0, 0), a2, voffA);
            PG8_BAR; PG8_WAIT_L(0); PG8_MMA(1, 0, At, B0); PG8_BAR; PG8_SCHED;
            PG8_STAGE(PG8_SB(0, 1), b2 + hstep, voffB);
            PG8_WAIT_V(6); PG8_BAR; PG8_MMA(1, 1, At, B1); PG8_BAR;
            PG8_LDB(B0, 1, 0); PG8_SCHED; PG8_LDA(At, 1, 0); PG8_STAGE(PG8_SA(0, 1), a2 + hstepA, voffA);
            PG8_WAIT_L(8); PG8_BAR; PG8_WAIT_L(0); PG8_MMA(0, 0, At, B0); PG8_BAR; PG8_SCHED;
            PG8_LDB(B1, 1, 1); PG8_STAGE(PG8_SB(1, 0), b3, voffB);
            PG8_BAR; PG8_WAIT_L(0); PG8_MMA(0, 1, At, B1); PG8_BAR;
            PG8_LDA(At, 1, 1); PG8_STAGE(PG8_SA(1, 0), a3, voffA);
            PG8_BAR; PG8_WAIT_L(0); PG8_MMA(1, 0, At, B0); PG8_BAR; PG8_SCHED;
            PG8_STAGE(PG8_SB(1, 1), b3 + hstep, voffB);
            PG8_WAIT_V(6); PG8_BAR; PG8_MMA(1, 1, At, B1); PG8_BAR;
            }
        }
        if constexpr (ALIGN_EPI) { if (wr == 0) PG8_BAR; }
        if constexpr (!Epi::AFTER_DRAIN) { E(acc, cur, wr, wc, fr, fq); S.done(cur); }
        if (!has_next) break;
#pragma unroll
        for (int a = 0; a < 2; ++a)
#pragma unroll
            for (int b = 0; b < 2; ++b)
#pragma unroll
                for (int m = 0; m < 4; ++m)
#pragma unroll
                    for (int n = 0; n < 2; ++n) acc[a][b][m][n] = (f32x4){0.f, 0.f, 0.f, 0.f};
        cur = nxt; cA = nA; cB = nB; ++ui;
        if constexpr (ALIGN_EPI) { if (wr == 1) PG8_BAR; }
    }
    PG8_WAIT_V(0);
    if constexpr (!ALIGN_EPI) { if (wr == 0) PG8_BAR; }
    PG8_BAR;
    if constexpr (Epi::AFTER_DRAIN) { E.fused(acc, cur, wr, wc, fr, fq, lds, wid, lane); S.done(cur); }
#undef PG8_SA
#undef PG8_SB
#undef PG8_STAGE
#undef PG8_LDA
#undef PG8_LDB
#undef PG8_MMA
#undef PG8_WAIT_V
#undef PG8_WAIT_L
#undef PG8_BAR
#undef PG8_SCHED
}
}


namespace att {
using bf16x8 = __attribute__((ext_vector_type(8))) short;
using s16x4  = __attribute__((ext_vector_type(4))) short;
using f32x16 = __attribute__((ext_vector_type(16))) float;
using u32x4  = __attribute__((ext_vector_type(4))) unsigned;
constexpr int QBLK = 32, KVBLK = 64, NW = 8;
constexpr float SCALE = 0.07216878364870322f, THR = 8.f;
constexpr int SHM_V = 16384, SHM_KN = 16384, SHM_KR = 8192;
constexpr int OFF_V = 0, OFF_KN = 2 * SHM_V, OFF_KR = OFF_KN + 2 * SHM_KN, OFF_WS = OFF_KR + 2 * SHM_KR, OFF_QR = OFF_WS + NW * 64 * 4, SHM_TOTAL = OFF_QR + NW * 4096;
#define KSWZ(row, colB) ((row) * 256 + ((colB) ^ (((row) & 7) << 4)))
#define RSWZ(row, ch) ((row) * 128 + ((((ch) ^ (((row) >> 1) & 7))) << 4))
#define SBAR() __builtin_amdgcn_sched_barrier(0)
__device__ __forceinline__ int crow(int r, int hi) { return (r & 3) + 8 * (r >> 2) + 4 * hi; }
__device__ __forceinline__ unsigned cvtpk(float lo, float hi) { unsigned r; asm volatile("v_cvt_pk_bf16_f32 %0, %1, %2" : "=v"(r) : "v"(lo), "v"(hi)); return r; }
__device__ __forceinline__ bf16x8 ld8(const bf16_t* p) { return *reinterpret_cast<const bf16x8*>(p); }

__device__ __forceinline__ void partialSM(f32x16& p0, f32x16& p1, float& m_reg, float& mn, float& alpha) {
  constexpr float C = SCALE * 1.4426950408889634f;
  float pmax = p0[0];
#pragma unroll
  for (int r = 1; r < 16; ++r) pmax = fmaxf(pmax, p0[r]);
#pragma unroll
  for (int r = 0; r < 16; ++r) pmax = fmaxf(pmax, p1[r]);
  { auto rr = __builtin_amdgcn_permlane32_swap(__float_as_uint(pmax), __float_as_uint(pmax), false, false);
    pmax = fmaxf(__uint_as_float(rr[0]), __uint_as_float(rr[1])); }
  if (__builtin_expect(__all(pmax - m_reg <= THR / SCALE), 1)) { mn = m_reg; alpha = 1.f; }
  else { mn = fmaxf(m_reg, pmax); alpha = __builtin_amdgcn_exp2f((m_reg - mn) * C); m_reg = mn; }
  const float mnC = -mn * C;
#pragma unroll
  for (int r = 0; r < 16; ++r) p0[r] = fmaf(p0[r], C, mnC);
#pragma unroll
  for (int r = 0; r < 16; ++r) p1[r] = fmaf(p1[r], C, mnC);
#pragma unroll
  for (int r = 0; r < 16; ++r) p0[r] = __builtin_amdgcn_exp2f(p0[r]);
}
__device__ __forceinline__ void finishSM(f32x16& p0, f32x16& p1, float alpha, float& l_reg, bf16x8& pa0, bf16x8& pa1, bf16x8& pa2, bf16x8& pa3) {
#pragma unroll
  for (int r = 0; r < 16; ++r) p1[r] = __builtin_amdgcn_exp2f(p1[r]);
  float ps = 0;
#pragma unroll
  for (int r = 0; r < 16; ++r) ps += p0[r];
#pragma unroll
  for (int r = 0; r < 16; ++r) ps += p1[r];
  { auto rr = __builtin_amdgcn_permlane32_swap(__float_as_uint(ps), __float_as_uint(ps), false, false);
    ps = __uint_as_float(rr[0]) + __uint_as_float(rr[1]); }
  l_reg = l_reg * alpha + ps;
#define PK4(P, BASE, OUT) do { unsigned a0 = cvtpk(P[BASE + 0], P[BASE + 1]), a1 = cvtpk(P[BASE + 2], P[BASE + 3]);   \
    unsigned b0 = cvtpk(P[BASE + 4], P[BASE + 5]), b1 = cvtpk(P[BASE + 6], P[BASE + 7]);                              \
    auto r0 = __builtin_amdgcn_permlane32_swap(a0, b0, false, false); auto r1 = __builtin_amdgcn_permlane32_swap(a1, b1, false, false); \
    u32x4 w = {r0[0], r1[0], r0[1], r1[1]}; OUT = *reinterpret_cast<bf16x8*>(&w); } while (0)
  PK4(p0, 0, pa0); PK4(p0, 8, pa1); PK4(p1, 0, pa2); PK4(p1, 8, pa3);
#undef PK4
}
__device__ __forceinline__ void qkt(f32x16& p0, f32x16& p1, const char* Kn, const char* Kr, const bf16x8* qr, const char* qrl, int r32, int hi) {
  p0 = f32x16{}; p1 = f32x16{};
#pragma unroll
  for (int d0 = 0; d0 < 8; ++d0) { const int cb = (d0 * 16 + hi * 8) * 2;
    const bf16x8 b0 = *reinterpret_cast<const bf16x8*>(Kn + KSWZ(r32, cb));
    const bf16x8 b1 = *reinterpret_cast<const bf16x8*>(Kn + KSWZ(32 + r32, cb));
    p0 = __builtin_amdgcn_mfma_f32_32x32x16_bf16(b0, qr[d0], p0, 0, 0, 0);
    p1 = __builtin_amdgcn_mfma_f32_32x32x16_bf16(b1, qr[d0], p1, 0, 0, 0); }
#pragma unroll
  for (int d0 = 0; d0 < 4; ++d0) { const int ch = d0 * 2 + hi;
    const bf16x8 b0 = *reinterpret_cast<const bf16x8*>(Kr + RSWZ(r32, ch));
    const bf16x8 b1 = *reinterpret_cast<const bf16x8*>(Kr + RSWZ(32 + r32, ch));
    const bf16x8 qv = *reinterpret_cast<const bf16x8*>(qrl + d0 * 1024);
    p0 = __builtin_amdgcn_mfma_f32_32x32x16_bf16(b0, qv, p0, 0, 0, 0);
    p1 = __builtin_amdgcn_mfma_f32_32x32x16_bf16(b1, qv, p1, 0, 0, 0); }
}
__device__ __forceinline__ int v_st(int k, int c) { const int kk = (k & ~0xC) | ((k & 4) << 1) | ((k & 8) >> 1); return ((kk >> 3) * 4 + (c >> 5)) * 512 + ((kk & 7) * 32 + (c & 31)) * 2; }
__device__ __forceinline__ int v_rd_base(int lane) { return ((lane & 3) << 3) | (((lane >> 2) & 3) << 6) | (((lane >> 4) & 1) << 5) | (((lane >> 5) & 1) << 8); }
constexpr int v_rd_off(int d0, int ks, int half) { return d0 * 512 + ks * 4096 + half * 2048; }
template <int OFF> __device__ __forceinline__ s16x4 tr_read(int vb) {
  s16x4 r; asm volatile("ds_read_b64_tr_b16 %0, %1 offset:%2" : "=&v"(r) : "v"(vb), "i"(OFF) : "memory"); return r;
}
template <int D0> __device__ __forceinline__ void pv_one(f32x16& od, int vb, bf16x8 pa0, bf16x8 pa1, bf16x8 pa2, bf16x8 pa3) {
  const s16x4 l0 = tr_read<v_rd_off(D0, 0, 0)>(vb), h0 = tr_read<v_rd_off(D0, 0, 1)>(vb), l1 = tr_read<v_rd_off(D0, 1, 0)>(vb), h1 = tr_read<v_rd_off(D0, 1, 1)>(vb);
  const s16x4 l2 = tr_read<v_rd_off(D0, 2, 0)>(vb), h2 = tr_read<v_rd_off(D0, 2, 1)>(vb), l3 = tr_read<v_rd_off(D0, 3, 0)>(vb), h3 = tr_read<v_rd_off(D0, 3, 1)>(vb);
  asm volatile("s_waitcnt lgkmcnt(0)" ::: "memory"); SBAR();
#define PK(L, H) (bf16x8){L[0], L[1], L[2], L[3], H[0], H[1], H[2], H[3]}
  od = __builtin_amdgcn_mfma_f32_32x32x16_bf16(pa0, PK(l0, h0), od, 0, 0, 0);
  od = __builtin_amdgcn_mfma_f32_32x32x16_bf16(pa1, PK(l1, h1), od, 0, 0, 0);
  od = __builtin_amdgcn_mfma_f32_32x32x16_bf16(pa2, PK(l2, h2), od, 0, 0, 0);
  od = __builtin_amdgcn_mfma_f32_32x32x16_bf16(pa3, PK(l3, h3), od, 0, 0, 0);
#undef PK
}
__device__ __forceinline__ void pv_d0(f32x16* o, int vb, bf16x8 pa0, bf16x8 pa1, bf16x8 pa2, bf16x8 pa3) {
  pv_one<0>(o[0], vb, pa0, pa1, pa2, pa3); pv_one<1>(o[1], vb, pa0, pa1, pa2, pa3); pv_one<2>(o[2], vb, pa0, pa1, pa2, pa3); pv_one<3>(o[3], vb, pa0, pa1, pa2, pa3);
}
__device__ __forceinline__ void attn_unit(const bf16_t* __restrict__ Qb, const bf16_t* __restrict__ Kh, const bf16_t* __restrict__ Vh, int seq,
                                          bf16_t* __restrict__ Mo, const bf16_t* __restrict__ G, char* lds) {
  int tid_ = threadIdx.x; asm volatile("" : "+v"(tid_));
  const int tid = tid_, wid = tid >> 6, lane = tid & 63, r32 = lane & 31, hi = lane >> 5;
  char* V_lds = lds + OFF_V; char* KN_lds = lds + OFF_KN; char* KR_lds = lds + OFF_KR;
  float* ws = (float*)(lds + OFF_WS) + wid * 64; float* li_l = ws; float* al_l = ws + 32;
  float m_reg = -1e30f, l_reg = 0; f32x16 o[4] = {}; bf16x8 qr[8];
  const bf16_t* Qw = Qb + (long)(wid * QBLK + r32) * 192 + hi * 8;
  char* qrl = lds + OFF_QR + wid * 4096 + lane * 16;
#pragma unroll
  for (int d0 = 0; d0 < 8; ++d0) qr[d0] = ld8(Qw + d0 * 16);
#pragma unroll
  for (int d0 = 0; d0 < 4; ++d0) *reinterpret_cast<bf16x8*>(qrl + d0 * 1024) = ld8(Qw + (8 + d0) * 16);
  const int sr = tid >> 4, sc = (tid & 15) * 8, vst0 = v_st(sr, sc), vst1 = v_st(32 + sr, sc);
  const int rr_ = tid >> 3, rch = tid & 7;
  const int vb0 = (int)(uintptr_t)V_lds + v_rd_base(lane);
  bf16x8 vs0, vs1, ks0, ks1, kr0;
  const int vo0 = sr * 128 + sc, ko0 = sr * 192 + sc, kro = rr_ * 192 + 128 + rch * 8;
#define SLOAD(k0) do { const bf16_t* vt_ = Vh + (long)(k0) * 128; const bf16_t* kt_ = Kh + (long)(k0) * 192; \
    vs0 = ld8(vt_ + vo0); vs1 = ld8(vt_ + vo0 + 32 * 128); ks0 = ld8(kt_ + ko0); ks1 = ld8(kt_ + ko0 + 32 * 192); kr0 = ld8(kt_ + kro); } while (0)
#define SWRITE(b) do { *(bf16x8*)(V_lds + (b) * SHM_V + vst0) = vs0; *(bf16x8*)(V_lds + (b) * SHM_V + vst1) = vs1; const int kc = sc * 2; \
    *(bf16x8*)(KN_lds + (b) * SHM_KN + KSWZ(sr, kc)) = ks0; *(bf16x8*)(KN_lds + (b) * SHM_KN + KSWZ(32 + sr, kc)) = ks1; \
    *(bf16x8*)(KR_lds + (b) * SHM_KR + RSWZ(rr_, rch)) = kr0; } while (0)
#define SWAIT() asm volatile("s_waitcnt vmcnt(0)" ::: "memory")
#define RESC(a) do { if (__any((a) < 1.f)) { if (hi == 0) al_l[r32] = (a); asm volatile("s_waitcnt lgkmcnt(0)" ::: "memory"); \
    _Pragma("unroll") for (int d = 0; d < 4; ++d) _Pragma("unroll") for (int r = 0; r < 16; ++r) o[d][r] *= al_l[crow(r, hi)]; } } while (0)
  f32x16 pA0, pA1, pB0, pB1; float mnA, mnB, alA, alB; bf16x8 pa0, pa1, pa2, pa3; const int NTL = seq / KVBLK;
  SLOAD(0); SWAIT(); SWRITE(0); __syncthreads();
  qkt(pA0, pA1, KN_lds, KR_lds, qr, qrl, r32, hi); partialSM(pA0, pA1, m_reg, mnA, alA);
  SLOAD(KVBLK);
  SWAIT(); SWRITE(1); __syncthreads();
  for (int j = 1; j + 1 < NTL; j += 2) {
    SBAR(); qkt(pB0, pB1, KN_lds + SHM_KN, KR_lds + SHM_KR, qr, qrl, r32, hi);
    finishSM(pA0, pA1, alA, l_reg, pa0, pa1, pa2, pa3); SBAR();
    SLOAD((j + 1) * KVBLK); SBAR();
    pv_d0(o, vb0, pa0, pa1, pa2, pa3); partialSM(pB0, pB1, m_reg, mnB, alB);
    __syncthreads(); SWAIT(); SWRITE(0);
    RESC(alB); __syncthreads();
    SBAR(); qkt(pA0, pA1, KN_lds, KR_lds, qr, qrl, r32, hi);
    finishSM(pB0, pB1, alB, l_reg, pa0, pa1, pa2, pa3); SBAR();
    SLOAD((j + 2) * KVBLK); SBAR();
    pv_d0(o, vb0 + SHM_V, pa0, pa1, pa2, pa3); partialSM(pA0, pA1, m_reg, mnA, alA);
    __syncthreads(); SWAIT(); SWRITE(1);
    RESC(alA); __syncthreads();
  }
  SBAR(); qkt(pB0, pB1, KN_lds + SHM_KN, KR_lds + SHM_KR, qr, qrl, r32, hi);
  finishSM(pA0, pA1, alA, l_reg, pa0, pa1, pa2, pa3); SBAR();
  pv_d0(o, vb0, pa0, pa1, pa2, pa3); partialSM(pB0, pB1, m_reg, mnB, alB);
  __syncthreads(); RESC(alB);
  finishSM(pB0, pB1, alB, l_reg, pa0, pa1, pa2, pa3); SBAR();
  pv_d0(o, vb0 + SHM_V, pa0, pa1, pa2, pa3);
  if (hi == 0) li_l[r32] = l_reg; asm volatile("s_waitcnt lgkmcnt(0)" ::: "memory");
  float rli[16];
#pragma unroll
  for (int r = 0; r < 16; ++r) rli[r] = __builtin_amdgcn_rcpf(li_l[crow(r, hi)]);
#pragma unroll
  for (int r = 0; r < 16; ++r) { const int row = wid * QBLK + crow(r, hi);
#pragma unroll
    for (int d0 = 0; d0 < 4; ++d0) { const int col = d0 * 32 + r32; const float g = bf2f(G[(long)row * NIN + col]);
      Mo[(long)row * DM + col] = f2bf(o[d0][r] * rli[r] * (g / (1.f + __expf(-g)))); } }
  __syncthreads();
#undef SLOAD
#undef SWRITE
#undef SWAIT
#undef RESC
}
#undef SBAR
}

__device__ void ph_attn_mfma(const Params& p, int l, int bid, int nb, char* lds) {
    const bf16_t* Q = WSP(bf16_t, WS_Q); const bf16_t* KB = WSP(bf16_t, WS_KB); const bf16_t* VB = WSP(bf16_t, WS_VB); const bf16_t* U = WSP(bf16_t, WS_U); bf16_t* MIX = WSP(bf16_t, WS_MIX);
    const int vcu = (nb % 8 == 0) ? (bid % 8) * (nb / 8) + bid / 8 : bid;
    const int nlat = NB * NH * (SEQ / 256), nctx = (l < DEPTH - 1) ? NB * NH : 0;
    for (int u = vcu; u < nlat + nctx; u += nb) {
        if (u < nlat) { const int bh = u >> 3, qb = u & 7, b = bh >> 3, h = bh & 7; const size_t hb = (size_t)bh * LK; const size_t rowbase = (size_t)b * SEQ + qb * 256;
            att::attn_unit(Q + (hb + qb * 256) * 192, KB + hb * 192, VB + hb * 128, LK, MIX + rowbase * DM + 512 + h * 128, U + rowbase * NIN + OFF_MLA_G + h * 128, lds); }
        else { const int bh = u - nlat, b = bh >> 3, h = bh & 7; const size_t hb = (size_t)bh * LK + SEQ; const size_t rowbase = (size_t)ROWS_L + b * CTXL;
            att::attn_unit(Q + hb * 192, KB + hb * 192, VB + hb * 128, CTXL, MIX + rowbase * DM + 512 + h * 128, U + rowbase * NIN + OFF_MLA_G + h * 128, lds); }
    }
}


namespace hy {
using bf16x8 = __attribute__((ext_vector_type(8))) short;
using f32x16 = __attribute__((ext_vector_type(16))) float;
using u32x4 = __attribute__((ext_vector_type(4))) unsigned;
using u32x2 = __attribute__((ext_vector_type(2))) unsigned;
constexpr int PADB = 8, ROWB = 80;
constexpr int CPQ = 544, NCH = 520, CH0 = 260;
constexpr int OFF_RHO = 0, OFF_Z = 8 * CPQ * 16, OFF_X1 = OFF_Z + 80 * 4 * ROWB, OFF_X2 = OFF_X1 + 64 * 4 * ROWB, LDS_END = OFF_X2 + 64 * 4 * ROWB;
constexpr unsigned SQ = 0x0F9C9460u;
__device__ __forceinline__ int copy_base(int q) { return q * CPQ + (int)((SQ >> (4 * q)) & 15u); }
__device__ __forceinline__ unsigned pk2bf(float lo, float hi) { unsigned r; asm volatile("v_cvt_pk_bf16_f32 %0, %1, %2" : "=v"(r) : "v"(lo), "v"(hi)); return r; }
__device__ __forceinline__ float blo(unsigned w) { return __uint_as_float(w << 16); }
__device__ __forceinline__ float bhi(unsigned w) { return __uint_as_float(w & 0xffff0000u); }

__device__ __forceinline__ void build_rho(const bf16_t* __restrict__ RHOg, char* lds, int tid) {
    for (int nn = tid; nn < NCH; nn += NT) {
        const int e0 = 8 * nn - 32;
        u32x4 g0 = {0u, 0u, 0u, 0u}, g1 = {0u, 0u, 0u, 0u};
        if (e0 >= 0 && e0 <= 4088) g0 = *reinterpret_cast<const u32x4*>(RHOg + e0);
        if (e0 + 8 >= 0 && e0 + 8 <= 4088) g1 = *reinterpret_cast<const u32x4*>(RHOg + e0 + 8);
        const unsigned w[8] = {g0.x, g0.y, g0.z, g0.w, g1.x, g1.y, g1.z, g1.w};
#pragma unroll
        for (int q = 0; q < 8; ++q) {
            u32x4 o;
            if ((q & 1) == 0) { o.x = w[q / 2]; o.y = w[q / 2 + 1]; o.z = w[q / 2 + 2]; o.w = w[q / 2 + 3]; }
            else { const int a = (q - 1) / 2;
                o.x = __builtin_amdgcn_alignbit(w[a + 1], w[a], 16); o.y = __builtin_amdgcn_alignbit(w[a + 2], w[a + 1], 16);
                o.z = __builtin_amdgcn_alignbit(w[a + 3], w[a + 2], 16); o.w = __builtin_amdgcn_alignbit(w[a + 4], w[a + 3], 16); }
            *reinterpret_cast<u32x4*>(lds + OFF_RHO + (copy_base(q) + nn) * 16) = o;
        }
    }
}
__device__ __forceinline__ f32x16 conv_tile(const char* lds, int I0, int lane) {
    const int i = lane & 31, h = lane >> 5, q = (8 - (i & 7)) & 7;
    const char* pa = lds + OFF_RHO + (copy_base(q) + CH0 + h - (i >> 3) - (q ? 1 : 0) - 4 * (I0 - 63)) * 16;
    const char* pb = lds + OFF_Z + ((63 + PADB) * 4 + i) * ROWB + 16 * h;
    f32x16 acc = {};
#pragma unroll 4
    for (int dd = 0; dd < 72; ++dd) {
        const bf16x8 a0 = *reinterpret_cast<const bf16x8*>(pa - 64 * dd), a1 = *reinterpret_cast<const bf16x8*>(pa - 64 * dd + 32);
        const bf16x8 b0 = *reinterpret_cast<const bf16x8*>(pb - 320 * dd), b1 = *reinterpret_cast<const bf16x8*>(pb - 320 * dd + 32);
        acc = __builtin_amdgcn_mfma_f32_32x32x16_bf16(a0, b0, acc, 0, 0, 0);
        acc = __builtin_amdgcn_mfma_f32_32x32x16_bf16(a1, b1, acc, 0, 0, 0);
    }
    return acc;
}
__device__ __forceinline__ void load_sc16(const bf16_t* __restrict__ row, int t0, float w0, float w1, float w2, float bb, float (&out)[16]) {
    const u32x4 a = *reinterpret_cast<const u32x4*>(row), b = *reinterpret_cast<const u32x4*>(row + 8);
    float in[18];
    in[0] = t0 > 0 ? bf2f(row[-1]) : 0.f; in[17] = t0 + 16 < SEQ ? bf2f(row[16]) : 0.f;
    const unsigned ww[8] = {a.x, a.y, a.z, a.w, b.x, b.y, b.z, b.w};
#pragma unroll
    for (int k = 0; k < 8; ++k) { in[1 + 2 * k] = blo(ww[k]); in[2 + 2 * k] = bhi(ww[k]); }
#pragma unroll
    for (int j = 0; j < 16; ++j) out[j] = w0 * in[j] + w1 * in[j + 1] + w2 * in[j + 2] + bb;
}
__device__ __forceinline__ void st16(char* dst, const float (&v)[16]) {
    u32x4 a, b;
    a.x = pk2bf(v[0], v[1]); a.y = pk2bf(v[2], v[3]); a.z = pk2bf(v[4], v[5]); a.w = pk2bf(v[6], v[7]);
    b.x = pk2bf(v[8], v[9]); b.y = pk2bf(v[10], v[11]); b.z = pk2bf(v[12], v[13]); b.w = pk2bf(v[14], v[15]);
    *reinterpret_cast<u32x4*>(dst) = a; *reinterpret_cast<u32x4*>(dst + 16) = b;
}
__device__ __forceinline__ void hyena_unit(const Params& p, int l, int c, char* lds) {
    int tid_ = threadIdx.x; asm volatile("" : "+v"(tid_));
    const int tid = tid_, lane = tid & 63, wid = __builtin_amdgcn_readfirstlane(tid >> 6);
    const bf16_t* UT = WSP(bf16_t, WS_UT);
    { const int b = tid >> 7, t0 = (tid & 127) * 16; const size_t tok0 = (size_t)b * SEQ + t0;
      const float* cw = p.hy_conv_w + (size_t)l * 3 * 1536; const float* cb = p.hy_conv_b + l * 1536;
      const int J = t0 >> 5, po = (t0 & 31) * 2;
      float v[16];
      load_sc16(UT + (size_t)c * ROWS + tok0, t0, cw[c], cw[1536 + c], cw[3072 + c], cb[c], v);
      st16(lds + OFF_Z + ((J + PADB) * 4 + b) * ROWB + po, v);
      load_sc16(UT + (size_t)(512 + c) * ROWS + tok0, t0, cw[512 + c], cw[1536 + 512 + c], cw[3072 + 512 + c], cb[512 + c], v);
      st16(lds + OFF_X1 + (J * 4 + b) * ROWB + po, v);
      load_sc16(UT + (size_t)(1024 + c) * ROWS + tok0, t0, cw[1024 + c], cw[1536 + 1024 + c], cw[3072 + 1024 + c], cb[1024 + c], v);
      { const bf16_t* gr = UT + (size_t)(1536 + c) * ROWS + tok0; const u32x4 ga = *reinterpret_cast<const u32x4*>(gr), gb = *reinterpret_cast<const u32x4*>(gr + 8);
        const unsigned gw[8] = {ga.x, ga.y, ga.z, ga.w, gb.x, gb.y, gb.z, gb.w};
#pragma unroll
        for (int k = 0; k < 8; ++k) { const float g0 = blo(gw[k]), g1 = bhi(gw[k]); v[2 * k] *= g0 / (1.f + __expf(-g0)); v[2 * k + 1] *= g1 / (1.f + __expf(-g1)); } }
      st16(lds + OFF_X2 + (J * 4 + b) * ROWB + po, v);
      if (tid < 320) { const int rz = tid < 160 ? tid : (72 * 4 * 5 - 160) + tid;
          unsigned zz = 0u; asm volatile("" : "+v"(zz));
          *reinterpret_cast<u32x4*>(lds + OFF_Z + rz * 16) = (u32x4){zz, zz, zz, zz}; } }
    build_rho(WSP(bf16_t, WS_RHO) + (((size_t)l * 2 + 0) * 512 + c) * 4096, lds, tid);
    __syncthreads();
    const int I0 = 8 * wid, r = lane & 31, h = lane >> 5;
    f32x16 acc = conv_tile(lds, I0, lane);
    __syncthreads();
#pragma unroll
    for (int g = 0; g < 4; ++g) {
        const int off = (I0 * 4 + r) * ROWB + 16 * g + 8 * h;
        const u32x2 xv = *reinterpret_cast<const u32x2*>(lds + OFF_X1 + off);
        u32x2 o; o.x = pk2bf(acc[4 * g] * blo(xv.x), acc[4 * g + 1] * bhi(xv.x)); o.y = pk2bf(acc[4 * g + 2] * blo(xv.y), acc[4 * g + 3] * bhi(xv.y));
        *reinterpret_cast<u32x2*>(lds + OFF_Z + PADB * 4 * ROWB + off) = o;
    }
    build_rho(WSP(bf16_t, WS_RHO) + (((size_t)l * 2 + 1) * 512 + c) * 4096, lds, tid);
    __syncthreads();
    acc = conv_tile(lds, I0, lane);
#pragma unroll
    for (int g = 0; g < 4; ++g) {
        const int off = (I0 * 4 + r) * ROWB + 16 * g + 8 * h;
        const u32x2 xv = *reinterpret_cast<const u32x2*>(lds + OFF_X2 + off);
        u32x2 o; o.x = pk2bf(acc[4 * g] * blo(xv.x), acc[4 * g + 1] * bhi(xv.x)); o.y = pk2bf(acc[4 * g + 2] * blo(xv.y), acc[4 * g + 3] * bhi(xv.y));
        *reinterpret_cast<u32x2*>(lds + OFF_X1 + off) = o;
    }
    __syncthreads();
    bf16_t* HT = WSP(bf16_t, WS_HT) + (size_t)c * ROWS;
#pragma unroll
    for (int k = 0; k < 2; ++k) { const int id = tid + k * NT, b = id >> 8, J = (id >> 2) & 63, q4 = id & 3;
        *reinterpret_cast<u32x4*>(HT + (size_t)b * SEQ + 32 * J + 8 * q4) = *reinterpret_cast<const u32x4*>(lds + OFF_X1 + (J * 4 + b) * ROWB + q4 * 16); }
    __syncthreads();
}
}
static_assert(hy::LDS_END <= LDS_BYTES, "hyena LDS map");

__device__ void ph_hyena_mfma(const Params& p, int l, int bid, int nb, char* lds) {
    for (int c = bid; c < HYW; c += nb) hy::hyena_unit(p, l, c, lds);
}
__device__ void ph_transpose(const bf16_t* __restrict__ src, int spitch, bf16_t* __restrict__ dst, int dpitch, int R, int C, int bid, int nb, bf16_t* tile) {
    const int TX = otid();
    const int tr = R / 64, tc = C / 64;
    for (int t = bid; t < tr * tc; t += nb) {
        const int r0 = (t / tc) * 64, c0 = (t % tc) * 64;
        { const int rr = TX >> 3, cc = (TX & 7) * 8; *(uint4*)(tile + rr * 72 + cc) = *(const uint4*)(src + (size_t)(r0 + rr) * spitch + c0 + cc); }
        __syncthreads();
        { const int dr = TX >> 3, dc = (TX & 7) * 8; unsigned w[4];
#pragma unroll
          for (int k = 0; k < 4; ++k) w[k] = (unsigned)tile[(dc + 2 * k) * 72 + dr] | ((unsigned)tile[(dc + 2 * k + 1) * 72 + dr] << 16);
          *(uint4*)(dst + (size_t)(c0 + dr) * dpitch + r0 + dc) = make_uint4(w[0], w[1], w[2], w[3]); }
        __syncthreads();
    }
}

#define LAS __attribute__((address_space(3)))
typedef unsigned v4u __attribute__((ext_vector_type(4)));
__device__ __forceinline__ unsigned pk2(float lo, float hi) { return (unsigned)f2bf(lo) | ((unsigned)f2bf(hi) << 16); }
__device__ __forceinline__ void transpose_item(const float* W, int K, int N, bf16_t* WT, float* scr, int item, int lane, const float* gs = nullptr) {
    const int nblk = N / 32, kb = item / nblk, nb_ = item % nblk, k0 = 64 * kb, n0 = 32 * nb_;
#pragma unroll 32
    for (int i = 0; i < 32; ++i) { const int kk = 2 * i + (lane >> 5); scr[kk * 33 + (lane & 31)] = W[(size_t)(k0 + kk) * N + n0 + (lane & 31)] * (gs ? gs[k0 + kk] : 1.f); }
    asm volatile("s_waitcnt lgkmcnt(0)" ::: "memory");
    const int c = lane & 7;
#pragma unroll
    for (int j = 0; j < 4; ++j) { const int n = (lane >> 3) + 8 * j; const float* sp = scr + (8 * c) * 33 + n;
        v4u o; o.x = pk2(sp[0 * 33], sp[1 * 33]); o.y = pk2(sp[2 * 33], sp[3 * 33]); o.z = pk2(sp[4 * 33], sp[5 * 33]); o.w = pk2(sp[6 * 33], sp[7 * 33]);
        *(v4u*)(WT + (size_t)(n0 + n) * K + k0 + 8 * c) = o; }
    asm volatile("s_waitcnt lgkmcnt(0)" ::: "memory");
}
__device__ void ph_prologue(const Params& p, int bid, int nb, float* sm) {
    const int tid = otid(), lane = tid & 63, wid = tid >> 6;
    if (bid < DEPTH * 24) {
        float* sil = sm; float* part = sm + 5 * DM;
        for (int i = tid; i < 5 * DM; i += NT) { const int r = i >> 11, k = i & 2047; sil[i] = silu_f(r < 4 ? p.c[r * DM + k] : p.c_ctx[k]); }
        __syncthreads();
        for (int u = bid; u < DEPTH * 24; u += nb) {
            const int l = u / 24, n0 = (u % 24) * 256;
            const float* W = p.w_ada + (size_t)l * DM * 6144 + n0 + lane * 4;
            float4 a[5];
#pragma unroll
            for (int r = 0; r < 5; ++r) a[r] = make_float4(0.f, 0.f, 0.f, 0.f);
#pragma unroll 8
            for (int kk = 0; kk < 256; ++kk) { const int k = wid * 256 + kk; const float4 w = *(const float4*)(W + (size_t)k * 6144);
#pragma unroll
                for (int r = 0; r < 5; ++r) { const float sv = sil[r * DM + k]; a[r].x += sv * w.x; a[r].y += sv * w.y; a[r].z += sv * w.z; a[r].w += sv * w.w; } }
#pragma unroll
            for (int r = 0; r < 5; ++r) *(float4*)(part + (wid * 5 + r) * 256 + lane * 4) = a[r];
            __syncthreads();
            for (int i = tid; i < 5 * 256; i += NT) { const int r = i >> 8, c = i & 255; float sacc = p.b_ada[l * 6144 + n0 + c];
#pragma unroll
                for (int w = 0; w < 8; ++w) sacc += part[(w * 5 + r) * 256 + c];
                WSP(float, WS_MOD)[(size_t)(l * 5 + r) * 6144 + n0 + c] = sacc; }
            __syncthreads();
        }
    }
    __syncthreads();
    float* scr = sm + wid * (64 * 33 + 16);
    constexpr int I_IN = (DM / 64) * (NIN / 32), I_OUT = (DM / 64) * (DM / 32), I_UQ = (512 / 64) * (1536 / 32), I_UKV = (256 / 64) * (2048 / 32), I_W3 = 2048 / 32, I_ALL = I_IN + I_OUT + I_UQ + I_UKV + I_W3;
    unsigned* qctr = (unsigned*)(p.ws + WS_CTL) + 3584;
    for (;;) {
        unsigned itu = 0u; if (lane == 0) itu = atomicAdd(qctr, 1u);
        const int it0 = (int)__builtin_amdgcn_readfirstlane(itu) * 8; if (it0 >= DEPTH * I_ALL) break;
      for (int it = it0; it < it0 + 8 && it < DEPTH * I_ALL; ++it) {
        const int l = it / I_ALL; int r = it % I_ALL;
        if (r < I_IN) { transpose_item(p.w_in + (size_t)l * DM * NIN, DM, NIN, WSP(bf16_t, WS_WINT) + (size_t)l * NINP * DM, scr, r, lane); continue; } r -= I_IN;
        if (r < I_OUT) { transpose_item(p.w_out + (size_t)l * DM * DM, DM, DM, WSP(bf16_t, WS_WOUTT) + (size_t)l * DM * DM, scr, r, lane); continue; } r -= I_OUT;
        if (r < I_UQ) { transpose_item(p.w_uq + (size_t)l * 512 * 1536, 512, 1536, WSP(bf16_t, WS_WUQT) + (size_t)l * 1536 * 512, scr, r, lane, p.q_norm_g + l * 512); continue; } r -= I_UQ;
        if (r < I_UKV) { transpose_item(p.w_ukv + (size_t)l * 256 * 2048, 256, 2048, WSP(bf16_t, WS_WUKVT) + (size_t)l * 2048 * 256, scr, r, lane, p.kv_norm_g + l * 256); continue; } r -= I_UKV;
        transpose_item(p.hf_w3 + (size_t)l * 64 * 2048, 64, 2048, WSP(bf16_t, WS_W3T) + (size_t)l * 2048 * 64, scr, r, lane);
      }
    }
    { float* Ws = sm; float* Ps = sm + 64 * 129;
      const int kq = tid >> 5, jq = tid & 31;
      for (int u = bid; u < DEPTH * 4 * 32; u += nb) {
          const int l = u >> 7, g = (u >> 5) & 3, k0 = (u & 31) * 64;
          __syncthreads();
          for (int i = tid; i < 64 * 128; i += NT) { const int r = i >> 7, cc = i & 127; Ws[r * 129 + cc] = p.w_in[((size_t)l * DM + k0 + r) * NIN + OFF_POOL + g * 128 + cc]; }
          for (int i = tid; i < 128 * 128 / 4; i += NT) *(float4*)&Ps[i * 4] = *(const float4*)(p.w_pool + (size_t)(l * 4 + g) * 128 * 128 + (size_t)i * 4);
          __syncthreads();
          float acc[4][4];
#pragma unroll
          for (int i = 0; i < 4; ++i)
#pragma unroll
              for (int j = 0; j < 4; ++j) acc[i][j] = 0.f;
#pragma unroll 4
          for (int cc = 0; cc < 128; ++cc) { const float4 bv = *(const float4*)&Ps[cc * 128 + jq * 4]; const float bb[4] = {bv.x, bv.y, bv.z, bv.w};
#pragma unroll
              for (int i = 0; i < 4; ++i) { const float av = Ws[(kq * 4 + i) * 129 + cc];
#pragma unroll
                  for (int j = 0; j < 4; ++j) acc[i][j] += av * bb[j]; } }
#pragma unroll
          for (int i = 0; i < 4; ++i) *(float4*)(WSP(float, WS_WP) + ((size_t)l * DM + k0 + kq * 4 + i) * 512 + g * 128 + jq * 4) = make_float4(acc[i][0], acc[i][1], acc[i][2], acc[i][3]);
      }
      __syncthreads(); }
    for (int i = bid * NT + tid; i < SEQ * 32; i += nb * NT) {
        const int t = i >> 5, pr = i & 31; const float inv = expf(-(float)(pr & 15) * (9.210340371976184f / 16.f));
        const float ang = (float)(pr < 16 ? (t >> 6) : (t & 63)) * inv;
        WSP(float, WS_ROPE)[2 * i] = fcos(ang); WSP(float, WS_ROPE)[2 * i + 1] = fsin(ang);
    }
    for (size_t i = (size_t)bid * NT + tid; i < (size_t)DEPTH * (NINP - NIN) * DM / 8; i += (size_t)nb * NT) {
        const size_t per = (size_t)(NINP - NIN) * DM / 8; const int l = (int)(i / per); const size_t o = i % per;
        *(v4u*)(WSP(bf16_t, WS_WINT) + ((size_t)l * NINP + NIN) * DM + o * 8) = (v4u){0u, 0u, 0u, 0u};
    }
    __syncthreads();
}


namespace hyc {
constexpr int KPAD = 664, ZP = 260, SLOT_F = 2 * KPAD + 16 * ZP;
__device__ __forceinline__ void conv4(const float* __restrict__ kp, const float* __restrict__ zb, int t0, float (&acc)[4]) {
#pragma unroll
    for (int i = 0; i < 4; ++i) acc[i] = 0.f;
#pragma unroll 2
    for (int s0 = 0; s0 < CTXL; s0 += 8) {
        const int m0 = t0 - s0 + 257; const float* wp = kp + (m0 + (m0 >> 2));
        float w[11], zz[8];
#pragma unroll
        for (int j = 0; j < 11; ++j) w[j] = wp[j + (j >= 3 ? 1 : 0) + (j >= 7 ? 1 : 0)];
#pragma unroll
        for (int uu = 0; uu < 8; ++uu) zz[uu] = zb[s0 + uu];
#pragma unroll
        for (int uu = 0; uu < 8; ++uu)
#pragma unroll
            for (int i = 0; i < 4; ++i) acc[i] += zz[uu] * w[i - uu + 7];
    }
}
__device__ __forceinline__ void sc4(const bf16_t* __restrict__ row, int t0, float w0, float w1, float w2, float bb, float (&out)[4]) {
    const uint2 a = *reinterpret_cast<const uint2*>(row); float in[6];
    in[0] = t0 > 0 ? bf2f(row[-1]) : 0.f; in[5] = t0 + 4 < CTXL ? bf2f(row[4]) : 0.f;
    in[1] = __uint_as_float(a.x << 16); in[2] = __uint_as_float(a.x & 0xffff0000u); in[3] = __uint_as_float(a.y << 16); in[4] = __uint_as_float(a.y & 0xffff0000u);
#pragma unroll
    for (int j = 0; j < 4; ++j) out[j] = w0 * in[j] + w1 * in[j + 1] + w2 * in[j + 2] + bb;
}
__device__ __forceinline__ void unit(const Params& p, int l, int c0, float* sm) {
    int tid_ = threadIdx.x; asm volatile("" : "+v"(tid_));
    const int tid = tid_, slot = tid >> 8, b = (tid >> 6) & 3, tg = tid & 63, t0 = 4 * tg, c = c0 + slot;
    float* base = sm + slot * SLOT_F; float* kap = base; float* zb = base + 2 * KPAD + b * ZP; float* z2b = zb + 4 * ZP; float* x1b = zb + 8 * ZP; float* x2b = zb + 12 * ZP;
    const bf16_t* UT = WSP(bf16_t, WS_UT); const size_t tok0 = (size_t)ROWS_L + b * CTXL + t0;
    const float* cw = p.hy_conv_w + (size_t)l * 3 * 1536; const float* cb = p.hy_conv_b + l * 1536;
    float v[4];
    sc4(UT + (size_t)c * ROWS + tok0, t0, cw[c], cw[1536 + c], cw[3072 + c], cb[c], v);
#pragma unroll
    for (int i = 0; i < 4; ++i) zb[t0 + i] = v[i];
    sc4(UT + (size_t)(512 + c) * ROWS + tok0, t0, cw[512 + c], cw[1536 + 512 + c], cw[3072 + 512 + c], cb[512 + c], v);
#pragma unroll
    for (int i = 0; i < 4; ++i) x1b[t0 + i] = v[i];
    sc4(UT + (size_t)(1024 + c) * ROWS + tok0, t0, cw[1024 + c], cw[1536 + 1024 + c], cw[3072 + 1024 + c], cb[1024 + c], v);
    { const uint2 ga = *reinterpret_cast<const uint2*>(UT + (size_t)(1536 + c) * ROWS + tok0);
      const float g[4] = {__uint_as_float(ga.x << 16), __uint_as_float(ga.x & 0xffff0000u), __uint_as_float(ga.y << 16), __uint_as_float(ga.y & 0xffff0000u)};
#pragma unroll
      for (int i = 0; i < 4; ++i) x2b[t0 + i] = v[i] * (g[i] / (1.f + __expf(-g[i]))); }
    { const float* KC = WSP(float, WS_KC) + ((size_t)l * 2 * 512 + c) * 512;
#pragma unroll
      for (int k = 0; k < 4; ++k) { const int idx = (tid & 255) + 256 * k, o = idx >> 9, e = idx & 511, m = e + 8; kap[o * KPAD + m + (m >> 2)] = KC[(size_t)o * 512 * 512 + e]; } }
    __syncthreads();
    float acc[4];
    conv4(kap, zb, t0, acc);
#pragma unroll
    for (int i = 0; i < 4; ++i) z2b[t0 + i] = x1b[t0 + i] * acc[i];
    __syncthreads();
    conv4(kap + KPAD, z2b, t0, acc);
    uint2 o2; o2.x = (unsigned)f2bf(acc[0] * x2b[t0]) | ((unsigned)f2bf(acc[1] * x2b[t0 + 1]) << 16); o2.y = (unsigned)f2bf(acc[2] * x2b[t0 + 2]) | ((unsigned)f2bf(acc[3] * x2b[t0 + 3]) << 16);
    *reinterpret_cast<uint2*>(WSP(bf16_t, WS_HT) + (size_t)c * ROWS + tok0) = o2;
    __syncthreads();
}
}
__device__ void ph_hyena_ctx(const Params& p, int l, int bid, int nb, float* sm) {
    if (l == DEPTH - 1) return;
    for (int u = nb - 1 - bid; u < HYW / 2; u += nb) hyc::unit(p, l, 2 * u, sm);
}
__device__ void ph_kc(const Params& p, int bid, int nb) {
    const int TX = otid();
    const int lane = TX & 63, wid = TX >> 6;
    for (int idx = bid * 8 + wid; idx < DEPTH * 1024; idx += nb * 8) {
        const int l = idx >> 10, o = (idx >> 9) & 1, c = idx & 511, L = CTXL;
        const float* F = WSP(float, WS_FC) + (size_t)l * 2 * 2 * CTXL * 512;
        float a[4], bq[4], s = 0;
#pragma unroll
        for (int i = 0; i < 4; ++i) { const int pos = lane + 64 * i;
            a[i] = F[(((size_t)o * 2 + 0) * L + pos) * 512 + c]; bq[i] = F[(((size_t)o * 2 + 1) * L + pos) * 512 + c];
            s += a[i] * a[i]; if (pos >= 1) s += bq[i] * bq[i]; }
        s = wave_sum(s);
        const float sc = rsqrtf(s + EPS);
        float* KC = WSP(float, WS_KC) + (size_t)idx * 512;
#pragma unroll
        for (int i = 0; i < 4; ++i) { const int pos = lane + 64 * i;
            KC[256 + pos] = sc * a[i] + (pos == 0 ? p.hy_bias[(l * 2 + o) * 512 + c] : 0.f);
            if (pos >= 1) KC[256 - pos] = sc * bq[i]; else KC[0] = 0.f; }
    }
}

#define XB_TMO      128
#define XB_XCNT(j)  (256  + 64 * (j))
#define XB_XSUB(j)  (1280 + 64 * (j))
#define XB_XGEN(j)  (2304 + 64 * (j))
#define XB_TOP      3328
#define XB_TOPGEN   3392
#define XCD_BAR_WORDS 3456
#define XB_SPIN_CAP (1u << 18)
__device__ __forceinline__ unsigned xb_ld(unsigned* p)              { return __hip_atomic_load(p, __ATOMIC_RELAXED, __HIP_MEMORY_SCOPE_AGENT); }
__device__ __forceinline__ unsigned xb_add(unsigned* p, unsigned v) { return __hip_atomic_fetch_add(p, v, __ATOMIC_RELAXED, __HIP_MEMORY_SCOPE_AGENT); }
__device__ __forceinline__ unsigned xb_xcc_id() { return (unsigned)__builtin_amdgcn_s_getreg((3 << 11) | 20) & 0xFu; }
#define XB_SPIN(cond, bar) do { unsigned _sp = 0; while (cond) { __builtin_amdgcn_s_sleep(1); \
    if ((++_sp & 255u) == 0u) { if (xb_ld(&(bar)[XB_TMO])) break; if (_sp > XB_SPIN_CAP) { atomicAdd(&(bar)[XB_TMO], 1u); break; } } } } while (0)
struct XcdBarrier { unsigned* bar; unsigned x; volatile LAS unsigned* st; };
__device__ __forceinline__ XcdBarrier xcd_barrier_post(unsigned* bar, volatile LAS unsigned* st) {
    XcdBarrier b; b.bar = bar; b.x = xb_xcc_id(); b.st = st;
    if (threadIdx.x == 0) (void)xb_add(&bar[XB_XCNT(b.x)], 1u);
    return b;
}
__device__ __forceinline__ void xcd_barrier_complete(unsigned* bar, unsigned x, unsigned& nloc, unsigned& nx) {
    const unsigned G = gridDim.x * gridDim.y * gridDim.z;
    unsigned sum, cnt, mine, sp = 0u;
    for (;;) {
        sum = 0u; cnt = 0u; mine = 0u;
#pragma unroll
        for (unsigned j = 0; j < 16; ++j) { const unsigned c = xb_ld(&bar[XB_XCNT(j)]); sum += c; cnt += (c > 0u) ? 1u : 0u; mine = (j == x) ? c : mine; }
        if (sum == G) break;
        __builtin_amdgcn_s_sleep(1);
        if ((++sp & 255u) == 0u) { if (xb_ld(&bar[XB_TMO])) break; if (sp > XB_SPIN_CAP) { atomicAdd(&bar[XB_TMO], 1u); break; } }
    }
    nloc = mine > 0u ? mine : 1u; nx = cnt > 0u ? cnt : 1u;
}
__device__ __forceinline__ void xcd_barrier(const XcdBarrier& b) {
    asm volatile("s_waitcnt vmcnt(0)" ::: "memory");
    __syncthreads();
    if (threadIdx.x == 0) {
        unsigned* bar = b.bar;
        __builtin_amdgcn_s_waitcnt(0);
        unsigned nloc = b.st[0], nx = b.st[1];
        if (nloc == 0u) { xcd_barrier_complete(bar, b.x, nloc, nx); b.st[0] = nloc; b.st[1] = nx; }
        const unsigned old = xb_add(&bar[XB_XSUB(b.x)], 1u);
        const unsigned gen = old / nloc;
        if (old + 1u == (gen + 1u) * nloc) {
            __builtin_amdgcn_fence(__ATOMIC_RELEASE, "agent");
            asm volatile("s_waitcnt vmcnt(0)" ::: "memory");
            const unsigned og = xb_add(&bar[XB_TOP], 1u);
            const unsigned tg = og / nx;
            if (og + 1u == (tg + 1u) * nx) xb_add(&bar[XB_TOPGEN], 1u);
            else XB_SPIN(xb_ld(&bar[XB_TOPGEN]) == tg, bar);
            __builtin_amdgcn_fence(__ATOMIC_ACQUIRE, "agent");
            xb_add(&bar[XB_XGEN(b.x)], 1u);
            asm volatile("s_waitcnt vmcnt(0)" ::: "memory");
        } else {
            XB_SPIN(xb_ld(&bar[XB_XGEN(b.x)]) == gen, bar);
            __builtin_amdgcn_fence(__ATOMIC_ACQUIRE, "agent");
            asm volatile("s_waitcnt vmcnt(0)" ::: "memory");
        }
    }
    __syncthreads();
}

__device__ void ph_wp_transpose(const Params& p, int bid, int nb, float* sm) {
    const int tid = otid(), lane = tid & 63, wid = tid >> 6;
    float* scr = sm + wid * (64 * 33 + 16);
    constexpr int I_WP = (DM / 64) * (512 / 32);
    for (int it = bid * 8 + wid; it < DEPTH * I_WP; it += nb * 8) { const int l = it / I_WP, r = it % I_WP;
        transpose_item(WSP(float, WS_WP) + (size_t)l * DM * 512, DM, 512, WSP(bf16_t, WS_WINT) + ((size_t)l * NINP + OFF_POOL) * DM, scr, r, lane); }
    __syncthreads();
}
template <int HALF> __device__ __forceinline__ void pool_chunk(const bf16_t* __restrict__ Us, int t0, int L, float ps, bf16_t* __restrict__ Ms) {
    constexpr int NV = 16 + 2 * HALF - 1;
    float v[NV];
#pragma unroll
    for (int i = 0; i < NV; ++i) { const int sidx = t0 - HALF + i; v[i] = (sidx >= 0 && sidx < L) ? bf2f(Us[(size_t)sidx * NIN]) : 0.f; }
    float g[16];
#pragma unroll
    for (int tt = 0; tt < 16; ++tt) g[tt] = bf2f(Us[(size_t)(t0 + tt) * NIN + (OFF_POOL_G - OFF_POOL)]);
    float sum = 0.f;
#pragma unroll
    for (int i = 0; i < 2 * HALF; ++i) sum += v[i];
#pragma unroll
    for (int tt = 0; tt < 16; ++tt) { const int t = t0 + tt, lo = max(t - HALF, 0), hi = min(t + HALF, L);
        const float y = sum / (float)(hi - lo) - v[tt + HALF];
        Ms[(size_t)t * DM] = f2bf(y * ps * silu_f(g[tt]));
        if (tt < 15) sum += v[tt + 2 * HALF] - v[tt]; }
}
__device__ void ph_poolwin(const Params& p, int l, int bid, int nb) {
    const int TX = otid();
    const bf16_t* U = WSP(bf16_t, WS_U); bf16_t* MIX = WSP(bf16_t, WS_MIX);
    for (int idx = bid * NT + TX; idx < (ROWS / 16) * 512; idx += nb * NT) {
        const int j = idx & 511, row0 = (idx >> 9) * 16; const RowInfo r = rowinfo(row0);
        const bf16_t* Us = U + (size_t)(row0 - r.t) * NIN + OFF_POOL + j; bf16_t* Ms = MIX + (size_t)(row0 - r.t) * DM + 1536 + j;
        const float ps = p.pool_scale[l * 512 + j];
        switch (j >> 7) { case 0: pool_chunk<1>(Us, r.t, r.L, ps, Ms); break; case 1: pool_chunk<2>(Us, r.t, r.L, ps, Ms); break;
                          case 2: pool_chunk<4>(Us, r.t, r.L, ps, Ms); break; default: pool_chunk<8>(Us, r.t, r.L, ps, Ms); break; }
    }
}


__device__ void ph_gg(const Params& p, int bid, int nb) {
    const int TX = otid();
    for (int i = bid * NT + TX; i < DEPTH * 5 * DM; i += nb * NT) { const int k = i & 2047, lm = i >> 11, l = lm / 5;
        WSP(float, WS_GG)[i] = p.norm_g[l * DM + k] * (1.f + WSP(float, WS_MOD)[(size_t)lm * 6144 + 2048 + k]); }
}
__device__ void ph_bias(const Params& p, int bid, int nb, float* sm) {
    const int TX = otid();
    const int tid = TX, lane = tid & 63, wid = tid >> 6;
    for (int l = 0; l < DEPTH; ++l) {
        __syncthreads();
        for (int i = tid; i < 5 * DM; i += NT) sm[i] = WSP(float, WS_MOD)[(size_t)(l * 5 + (i >> 11)) * 6144 + (i & 2047)];
        __syncthreads();
        for (int n = bid * 8 + wid; n < NIN; n += nb * 8) {
            const bf16_t* wr_ = WSP(bf16_t, WS_WINT) + ((size_t)l * NINP + n) * DM;
            float a[5] = {0.f, 0.f, 0.f, 0.f, 0.f};
#pragma unroll
            for (int i = 0; i < 4; ++i) { const int k0 = (i * 64 + lane) * 8; const uint4 wv = *(const uint4*)(wr_ + k0);
                const unsigned ww[4] = {wv.x, wv.y, wv.z, wv.w};
#pragma unroll
                for (int r = 0; r < 5; ++r) { const float4 s0 = *(const float4*)&sm[r * DM + k0], s1 = *(const float4*)&sm[r * DM + k0 + 4];
                    a[r] += __uint_as_float(ww[0] << 16) * s0.x + __uint_as_float(ww[0] & 0xffff0000u) * s0.y + __uint_as_float(ww[1] << 16) * s0.z + __uint_as_float(ww[1] & 0xffff0000u) * s0.w
                          + __uint_as_float(ww[2] << 16) * s1.x + __uint_as_float(ww[2] & 0xffff0000u) * s1.y + __uint_as_float(ww[3] << 16) * s1.z + __uint_as_float(ww[3] & 0xffff0000u) * s1.w; } }
#pragma unroll
            for (int r = 0; r < 5; ++r) { const float t = wave_sum(a[r]); if (lane == 0) WSP(float, WS_BIAS)[(size_t)(l * 5 + r) * NINP + n] = t; }
        }
    }
    __syncthreads();
}
__device__ void ph_norm0(const Params& p, int bid, int nb) {
    const int TX = otid();
    const int lane = TX & 63, wid = TX >> 6;
    for (int row = bid * 8 + wid; row < ROWS; row += nb * 8) {
        const RowInfo r = rowinfo(row);
        const float* xr = xin_row(p, 0, row); const float* gg = WSP(float, WS_GG) + (size_t)r.mr * DM; bf16_t* xg = WSP(bf16_t, WS_HA) + (size_t)row * DM;
        float ss = 0.f;
#pragma unroll 2
        for (int j = 0; j < 8; ++j) { const int k = (j * 64 + lane) * 4; const float4 v = *(const float4*)(xr + k), g = *(const float4*)(gg + k);
            ss += v.x * v.x + v.y * v.y + v.z * v.z + v.w * v.w;
            uint2 w; w.x = (unsigned)f2bf(v.x * g.x) | ((unsigned)f2bf(v.y * g.y) << 16); w.y = (unsigned)f2bf(v.z * g.z) | ((unsigned)f2bf(v.w * g.w) << 16); *(uint2*)(xg + k) = w; }
        ss = wave_sum(ss);
        if (lane < 32) WSP(float, WS_XSS)[(size_t)row * 32 + lane] = lane == 0 ? ss : 0.f;
    }
}

enum { PH_ADALN = 0, PH_1, PH_2, PH_3, PH_4, PH_5, PH_6, PH_7, PH_FINAL, PH_PRO_B, PH_PRO_C };
__device__ __forceinline__ void run_phase(const Params& pin, int ph, int l, int bid, int nb, float* sm) {
    asm volatile("" : "+s"(bid), "+s"(nb), "+s"(l));
#if defined(__HIP_DEVICE_COMPILE__)
    const __attribute__((address_space(4))) Params* pk = (const __attribute__((address_space(4))) Params*)__builtin_amdgcn_kernarg_segment_ptr();
    asm volatile("" : "+s"(pk));
    const Params p = *pk; (void)pin;
#else
    const Params p = pin;
#endif
    switch (ph) {
    case PH_ADALN: ph_prologue(p, bid, nb, sm); ph_h2(p, bid, nb, sm); ph_filter_ctx(p, bid, nb, sm); break;
    case PH_PRO_B: ph_wp_transpose(p, bid, nb, sm); ph_rho_mfma(p, bid, nb, sm); ph_kc(p, bid, nb); ph_gg(p, bid, nb); break;
    case PH_PRO_C: ph_bias(p, bid, nb, sm); ph_norm0(p, bid, nb); break;
    case PH_1: break;
    case PH_2:
        { pg8::Gemm g{WSP(bf16_t, WS_HA), WSP(bf16_t, WS_WINT) + (size_t)l * NINP * DM, ROWS, NINP, DM, DM}; pg8::StaticOrder S; S.init(ROWS, NINP, nb, bid);
          pg8::EpiU E{WSP(bf16_t, WS_U), WSP(bf16_t, WS_UT), WSP(float, WS_RS), NIN, NIN, ROWS, WSP(float, WS_XSS), WSP(float, WS_BIAS) + (size_t)l * 5 * NINP};
          pg8::gemm_phase<pg8::EpiU, pg8::StaticOrder, true, true>((PG8_LAS unsigned char*)sm, g, S, E); } break;
    case PH_3: break;
    case PH_4:
        { pg8::Gemm g{WSP(bf16_t, WS_U) + OFF_Q, WSP(bf16_t, WS_WUQT) + (size_t)l * 1536 * 512, ROWS, 1536, 512, NIN}; pg8::StaticOrder S; S.init(ROWS, 1536, nb, bid);
          pg8::EpiQ E{WSP(bf16_t, WS_Q), WSP(float, WS_RS), WSP(float, WS_ROPE)};
          pg8::gemm_phase<pg8::EpiQ, pg8::StaticOrder, true, true>((PG8_LAS unsigned char*)sm, g, S, E); }
        { pg8::Gemm g{WSP(bf16_t, WS_U) + OFF_KV, WSP(bf16_t, WS_WUKVT) + (size_t)l * 2048 * 256, ROWS, 2048, 256, NIN}; pg8::StaticOrder S; S.init(ROWS, 2048, nb, bid);
          pg8::EpiKV E{WSP(bf16_t, WS_KB), WSP(bf16_t, WS_VB), WSP(float, WS_RS)};
          pg8::gemm_phase<pg8::EpiKV, pg8::StaticOrder, true, true>((PG8_LAS unsigned char*)sm, g, S, E); }
        ph_krope(p, bid, nb);
        __syncthreads();
        ph_hyena_mfma(p, l, bid, nb, (char*)sm);
        ph_hyena_ctx(p, l, bid, nb, sm); break;
    case PH_5: break;
    case PH_6: ph_attn_mfma(p, l, bid, nb, (char*)sm); ph_poolwin(p, l, bid, nb);
        ph_transpose(WSP(bf16_t, WS_HT), ROWS, WSP(bf16_t, WS_MIX), DM, 512, ROWS, bid, nb, (bf16_t*)sm); break;
    case PH_7: { const int Mrows = l == DEPTH - 1 ? ROWS_L : ROWS;
          pg8::Gemm g{WSP(bf16_t, WS_MIX), WSP(bf16_t, WS_WOUTT) + (size_t)l * DM * DM, Mrows, DM, DM, DM}; pg8::StaticOrder S; S.init(Mrows, DM, nb, bid);
          pg8::EpiResid E{l == 0 ? p.x : WSP(float, WS_XW), l == 0 ? p.ctx : WSP(float, WS_XW) + (size_t)ROWS_L * DM, WSP(float, WS_XW), WSP(float, WS_MOD) + (size_t)l * 5 * 6144 + 4096,
                          l == DEPTH - 1 ? (const float*)nullptr : WSP(float, WS_GG) + (size_t)(l + 1) * 5 * DM, WSP(bf16_t, WS_HA), WSP(float, WS_XSS)};
          pg8::gemm_phase<pg8::EpiResid, pg8::StaticOrder, true, true>((PG8_LAS unsigned char*)sm, g, S, E); } break;
    case PH_FINAL: ph_final(p, bid, nb); break;
    }
}

#if ONE_LAUNCH
__global__ void __launch_bounds__(NT, 2) mega_fwd(Params p) {
    extern __shared__ __attribute__((aligned(16))) unsigned char lds[];
    cg::grid_group grid = cg::this_grid();
    float* sm = (float*)lds; const int bid = blockIdx.x, nb = gridDim.x;
    if (threadIdx.x < 16) ((LAS unsigned*)(lds + LDS_BYTES - 64))[threadIdx.x] = 0u;
    __syncthreads();
    const XcdBarrier bar = xcd_barrier_post((unsigned*)(p.ws + WS_CTL), (volatile LAS unsigned*)(lds + LDS_BYTES - 64));
#define SEAM() xcd_barrier(bar)
#define RUNP(PH, K) do { int nrep_ = (REP_PH == (K)) ? 2 : 1; asm volatile("" : "+s"(nrep_)); _Pragma("unroll 1") for (int rep_ = 0; rep_ < nrep_; ++rep_) run_phase(p, PH, l, bid, nb, sm); } while (0)
    run_phase(p, PH_ADALN, 0, bid, nb, sm);
    grid.sync();
    run_phase(p, PH_PRO_B, 0, bid, nb, sm);
    SEAM();
    run_phase(p, PH_PRO_C, 0, bid, nb, sm);
#pragma unroll 1
    for (int l = 0; l < DEPTH; ++l) {
        SEAM(); RUNP(PH_2, 2);
        SEAM(); RUNP(PH_4, 4);
        SEAM(); RUNP(PH_6, 6);
        SEAM(); RUNP(PH_7, 7);
    }
    SEAM();
    run_phase(p, PH_FINAL, 0, bid, nb, sm);
#undef SEAM
}
#else
__global__ void __launch_bounds__(NT) k_phase(Params p, int ph, int l) {
    extern __shared__ __attribute__((aligned(16))) unsigned char lds[];
    run_phase(p, ph, l, blockIdx.x, gridDim.x, (float*)lds);
}
#endif

extern "C" void kernel_launch(void* const* d_in, const int* in_sizes, int n_in, void* d_out, int out_size, void* d_ws, size_t ws_size, hipStream_t stream) {
    if (n_in != 25 || ws_size < WS_END) { fprintf(stderr, "kernel_launch: bad inputs (n_in %d, ws %zu < %zu)\n", n_in, ws_size, (size_t)WS_END); return; }
    Params p{};
    const float** pp = (const float**)&p;
    for (int i = 0; i < 25; ++i) pp[i] = (const float*)d_in[i];
    p.out = (float*)d_out; p.ws = (unsigned char*)d_ws;
#if ONE_LAUNCH
    static int grid = 0;
    if (!grid) {
        int dev = 0, cus = 0, per_cu = 0;
        hipGetDevice(&dev); hipDeviceGetAttribute(&cus, hipDeviceAttributeMultiprocessorCount, dev);
        hipFuncSetAttribute((const void*)mega_fwd, hipFuncAttributeMaxDynamicSharedMemorySize, LDS_BYTES);
        hipOccupancyMaxActiveBlocksPerMultiprocessor(&per_cu, (const void*)mega_fwd, NT, LDS_BYTES);
        if (per_cu < 1) per_cu = 1;
        grid = cus * 1;
    }
    (void)hipMemsetAsync((char*)d_ws + WS_CTL, 0, CTL_BYTES, stream);
    void* args[] = {&p};
    hipError_t e = hipLaunchCooperativeKernel((const void*)mega_fwd, dim3(grid), dim3(NT), args, LDS_BYTES, stream);
    if (e != hipSuccess) fprintf(stderr, "cooperative launch failed: %s (grid %d)\n", hipGetErrorString(e), grid);
#else
    static int init = 0;
    if (!init) { hipFuncSetAttribute((const void*)k_phase, hipFuncAttributeMaxDynamicSharedMemorySize, LDS_BYTES); init = 1; }
    const int G = 1024;
    k_phase<<<G, NT, LDS_BYTES, stream>>>(p, PH_ADALN, 0);
    k_phase<<<G, NT, LDS_BYTES, stream>>>(p, PH_PRO_B, 0);
    for (int l = 0; l < DEPTH; ++l)
        for (int ph = PH_1; ph <= PH_7; ++ph) k_phase<<<G, NT, LDS_BYTES, stream>>>(p, ph, l);
    k_phase<<<G, NT, LDS_BYTES, stream>>>(p, PH_FINAL, 0);
#endif
}
```

```cpp
#include <hip/hip_runtime.h>
#include <hip/hip_cooperative_groups.h>
#include <cstdio>
#include <cstdint>
namespace cg = cooperative_groups;

#ifndef ONE_LAUNCH
#define ONE_LAUNCH 1
#endif
#ifndef REP_PH
#define REP_PH -1
#endif

constexpr int DM = 2048, NB = 4, SEQ = 2048, DEPTH = 4, CTXL = 256;
constexpr int HYW = 512, NH = 8, QRANK = 512, KVRANK = 256, POOLW = 512;
constexpr int OFF_HY_G = 1536, OFF_Q = 2048, OFF_KV = 2560, OFF_KR = 2816, OFF_MLA_G = 2880, OFF_POOL = 3904, OFF_POOL_G = 4416, NIN = 4928;
constexpr int ROWS_L = NB * SEQ, ROWS_C = NB * CTXL, ROWS = ROWS_L + ROWS_C;
constexpr int LK = SEQ + CTXL;
constexpr float EPS = 1e-6f;
constexpr float ATTN_SCALE = 0.07216878364870322f;
constexpr int NT = 512;
constexpr int NINP = 5120;

typedef unsigned short bf16_t;
typedef bf16_t act_t;

struct Params {
    const float *x, *c, *ctx, *c_ctx, *norm_g, *w_ada, *b_ada, *w_in, *hy_conv_w, *hy_conv_b, *hf_w1, *hf_b1, *hf_freq, *hf_w2, *hf_b2, *hf_w3, *hy_bias,
        *q_norm_g, *w_uq, *kv_norm_g, *w_ukv, *w_pool, *pool_scale, *w_out, *final_norm_g;
    float* out; unsigned char* ws;
};

constexpr size_t al256(size_t x) { return (x + 255) / 256 * 256; }
constexpr size_t WS_MOD = 0;
constexpr size_t WS_FSCL = WS_MOD + al256((size_t)4 * 5 * 6144 * 4);
constexpr size_t WS_H2L = WS_FSCL + al256((size_t)4 * 2 * 512 * 4);
constexpr size_t WS_FC = WS_H2L + al256((size_t)(4 * 2048 + 1) * 64 * 4);
constexpr size_t WS_HA = WS_FC + al256((size_t)4 * 2 * 2 * 256 * 512 * 4);
constexpr size_t WS_KVRAW = WS_HA;
constexpr size_t WS_U = WS_HA + al256((size_t)ROWS * 2048 * sizeof(act_t));
constexpr size_t WS_QN = WS_U + al256((size_t)ROWS * NIN * sizeof(act_t));
constexpr size_t WS_KVN = WS_QN + al256((size_t)ROWS * 512 * sizeof(act_t));
constexpr size_t WS_QRAW = WS_KVN + al256((size_t)ROWS * 256 * sizeof(act_t));
constexpr size_t WS_Q = WS_QRAW + al256((size_t)ROWS * 1536 * sizeof(act_t));
constexpr size_t WS_KB = WS_Q + al256((size_t)NB * NH * LK * 192 * sizeof(act_t));
constexpr size_t WS_VB = WS_KB + al256((size_t)NB * NH * LK * 192 * sizeof(act_t));
constexpr size_t WS_HC = WS_VB + al256((size_t)NB * NH * LK * 128 * sizeof(act_t));
constexpr size_t WS_Z2 = WS_HC + al256((size_t)ROWS * 1536 * sizeof(act_t));
constexpr size_t WS_PD = WS_Z2 + al256((size_t)ROWS * 512 * sizeof(act_t));
constexpr size_t WS_PY = WS_PD + al256((size_t)ROWS * 512 * sizeof(act_t));
constexpr size_t WS_MIX = WS_PY + al256((size_t)ROWS * 512 * sizeof(act_t));
constexpr size_t WS_XW = WS_MIX + al256((size_t)ROWS * 2048 * sizeof(act_t));
constexpr size_t WS_WINT = WS_XW + al256((size_t)ROWS * 2048 * 4);
constexpr size_t WS_WOUTT = WS_WINT + al256((size_t)DEPTH * NINP * DM * 2);
constexpr size_t WS_WUQT = WS_WOUTT + al256((size_t)DEPTH * DM * DM * 2);
constexpr size_t WS_WUKVT = WS_WUQT + al256((size_t)DEPTH * 1536 * 512 * 2);
constexpr size_t WS_WP = WS_WUKVT + al256((size_t)DEPTH * 2048 * 256 * 2);
constexpr size_t WS_UT = WS_WP + al256((size_t)DEPTH * 2048 * 512 * 4);
constexpr size_t WS_HT = WS_UT + al256((size_t)2048 * ROWS * 2);
constexpr size_t WS_RHO = WS_HT + al256((size_t)512 * ROWS * 2);
constexpr size_t WS_RS = WS_RHO + al256((size_t)DEPTH * 2 * 512 * 4096 * 2);
constexpr size_t WS_ROPE = WS_RS + al256((size_t)ROWS * 12 * 4);
constexpr size_t WS_KC = WS_ROPE + al256((size_t)SEQ * 32 * 2 * 4);
constexpr size_t WS_H2B = WS_KC + al256((size_t)DEPTH * 2 * 512 * 512 * 4);
constexpr size_t WS_W3T = WS_H2B + al256((size_t)DEPTH * SEQ * 64 * 2);
constexpr size_t WS_GG = WS_W3T + al256((size_t)DEPTH * 2048 * 64 * 2);
constexpr size_t WS_BIAS = WS_GG + al256((size_t)DEPTH * 5 * DM * 4);
constexpr size_t WS_XSS = WS_BIAS + al256((size_t)DEPTH * 5 * NINP * 4);
constexpr size_t WS_KR = WS_XSS + al256((size_t)ROWS * 32 * 4);
constexpr size_t WS_CTL = WS_KR + al256((size_t)NB * LK * 64 * 2);
constexpr size_t CTL_BYTES = 16384;
constexpr size_t WS_END = WS_CTL + CTL_BYTES;

constexpr int LDS_BYTES = 147456;

__device__ __forceinline__ float ldf(const float* p) { return *p; }
__device__ __forceinline__ void stf(float* p, float v) { *p = v; }
__device__ __forceinline__ float bf2f(bf16_t v) { return __uint_as_float((unsigned)v << 16); }
__device__ __forceinline__ bf16_t f2bf(float f) { const unsigned u = __float_as_uint(f); return (bf16_t)((u + 0x7fffu + ((u >> 16) & 1u)) >> 16); }
__device__ __forceinline__ float ldf(const bf16_t* p) { return bf2f(*p); }
__device__ __forceinline__ void stf(bf16_t* p, float v) { *p = f2bf(v); }
__device__ __forceinline__ float fsin(float x) { return __builtin_amdgcn_sinf(x * 0.15915494309189535f); }
__device__ __forceinline__ float fcos(float x) { return __builtin_amdgcn_cosf(x * 0.15915494309189535f); }
__device__ __forceinline__ float silu_f(float x) { return x / (1.f + expf(-x)); }
__device__ __forceinline__ float wave_sum(float v) {
    int lane = (int)__builtin_amdgcn_mbcnt_hi(~0u, __builtin_amdgcn_mbcnt_lo(~0u, 0u)); asm volatile("" : "+v"(lane));
#pragma unroll
    for (int o = 32; o > 0; o >>= 1) v += __int_as_float(__builtin_amdgcn_ds_bpermute((lane ^ o) << 2, __float_as_int(v)));
    return v;
}
struct RowInfo { int b, t, L, n, mr; };
__device__ __forceinline__ RowInfo rowinfo(int row) {
    RowInfo r;
    if (row < ROWS_L) { r.b = row >> 11; r.t = row & 2047; r.L = SEQ; r.n = r.t; r.mr = r.b; }
    else { const int q = row - ROWS_L; r.b = q >> 8; r.t = q & 255; r.L = CTXL; r.n = SEQ + r.t; r.mr = 4; }
    return r;
}
__device__ __forceinline__ const float* xin_row(const Params& p, int l, int row) {
    if (l == 0) return row < ROWS_L ? p.x + (size_t)row * DM : p.ctx + (size_t)(row - ROWS_L) * DM;
    return (const float*)(p.ws + WS_XW) + (size_t)row * DM;
}
#define WSP(T, off) ((T*)(p.ws + (off)))
__device__ __forceinline__ int otid() { int t = threadIdx.x; asm volatile("" : "+v"(t)); return t; }

__device__ void ph_adaln(const Params& p, int bid, int nb, float* sm) {
    const int TX = otid();
    for (int i = TX; i < 5 * DM; i += NT) { const int r = i >> 11, k = i & 2047; sm[i] = silu_f(r < 4 ? p.c[r * DM + k] : p.c_ctx[k]); }
    __syncthreads();
    float* MOD = WSP(float, WS_MOD);
    for (int idx = bid * NT + TX; idx < DEPTH * 6144; idx += nb * NT) {
        const int l = idx / 6144, n = idx % 6144;
        const float* W = p.w_ada + (size_t)l * DM * 6144 + n;
        float a0 = 0, a1 = 0, a2 = 0, a3 = 0, a4 = 0;
        for (int k = 0; k < DM; ++k) { const float w = W[(size_t)k * 6144]; a0 += sm[k] * w; a1 += sm[2048 + k] * w; a2 += sm[4096 + k] * w; a3 += sm[6144 + k] * w; a4 += sm[8192 + k] * w; }
        const float bb = p.b_ada[l * 6144 + n];
        MOD[(l * 5 + 0) * 6144 + n] = a0 + bb; MOD[(l * 5 + 1) * 6144 + n] = a1 + bb; MOD[(l * 5 + 2) * 6144 + n] = a2 + bb;
        MOD[(l * 5 + 3) * 6144 + n] = a3 + bb; MOD[(l * 5 + 4) * 6144 + n] = a4 + bb;
    }
    __syncthreads();
}

__device__ __forceinline__ float filt_feat(int idx, float t, float wpos) {
    if (idx == 0) return t;
    const int i = (idx - 1) & 15; const float band = 1e-4f + (float)i * ((15.f - 1e-4f) / 15.f); const float a = band * wpos;
    return (idx <= 16) ? fcos(a) : -fsin(a);
}
constexpr float HY_DA = -3.0701134573253944f, HY_DB = -15.350567286626973f;
__device__ void ph_filter_ctx(const Params& p, int bid, int nb, float* sm) {
    const int TX = otid();
    float* feats = sm; float* h1 = sm + 64; float* h2 = sm + 128;
    const int tid = TX;
    for (int u = bid; u < DEPTH * CTXL; u += nb) {
        const int l = u >> 8, pos = u & 255, L = CTXL;
        const float t = (float)pos / (float)(L - 1), wpos = (6.283185307179586f / (float)L) * (float)pos;
        if (tid < 33) feats[tid] = filt_feat(tid, t, wpos);
        __syncthreads();
        if (tid < 64) { float s = p.hf_b1[l * 64 + tid];
#pragma unroll 4
            for (int e = 0; e < 33; ++e) s += feats[e] * p.hf_w1[(l * 33 + e) * 64 + tid]; h1[tid] = fsin(p.hf_freq[l * 64 + tid] * s); }
        __syncthreads();
        if (tid < 64) { float s = p.hf_b2[l * 64 + tid];
#pragma unroll 4
            for (int i = 0; i < 64; ++i) s += h1[i] * p.hf_w2[(l * 64 + i) * 64 + tid]; h2[tid] = fsin(p.hf_freq[l * 64 + tid] * s); }
        __syncthreads();
        float* F = WSP(float, WS_FC) + (size_t)l * 2 * 2 * CTXL * 512;
        for (int n = tid; n < 2048; n += NT) {
            float s = 0;
#pragma unroll 8
            for (int j = 0; j < 64; ++j) s += h2[j] * p.hf_w3[((size_t)l * 64 + j) * 2048 + n];
            const int o = n >> 10, d = (n >> 9) & 1, c = n & 511;
            const float delta = fabsf(HY_DA + (float)c * ((HY_DB - HY_DA) / 511.f));
            F[(((size_t)o * 2 + d) * L + pos) * 512 + c] = s * expf(-t * delta);
        }
        __syncthreads();
    }
}
__device__ void ph_fscale_ctx(const Params& p, int bid, int nb) {
    const int TX = otid();
    const int lane = TX & 63, wid = TX >> 6;
    float* FS = WSP(float, WS_FSCL);
    for (int idx = bid * 8 + wid; idx < DEPTH * 1024; idx += nb * 8) {
        const int l = idx >> 10, o = (idx >> 9) & 1, c = idx & 511, L = CTXL;
        const float* F = WSP(float, WS_FC) + (size_t)l * 2 * 2 * CTXL * 512;
        float s = 0;
#pragma unroll
        for (int i = 0; i < 4; ++i) { const int pos = lane + 64 * i;
            const float a = F[(((size_t)o * 2 + 0) * L + pos) * 512 + c]; s += a * a;
            if (pos >= 1) { const float b2 = F[(((size_t)o * 2 + 1) * L + pos) * 512 + c]; s += b2 * b2; } }
        s = wave_sum(s);
        if (lane == 0) FS[idx] = rsqrtf(s + EPS);
    }
}
__device__ void ph_h2(const Params& p, int bid, int nb, float* sm) {
    const int TX = otid();
    const int lane = TX & 63, wid = TX >> 6;
    float* fe = sm + wid * 128; float* h1s = fe + 64;
    for (int u = bid * 8 + wid; u < DEPTH * SEQ; u += nb * 8) {
        const int l = u >> 11, pos = u & 2047;
        const float t = (float)pos / (float)(SEQ - 1), wpos = (6.283185307179586f / (float)SEQ) * (float)pos;
        fe[lane] = lane < 33 ? filt_feat(lane, t, wpos) : 0.f;
        const float fq = p.hf_freq[l * 64 + lane];
        float s = p.hf_b1[l * 64 + lane];
#pragma unroll 3
        for (int e = 0; e < 33; ++e) s += fe[e] * p.hf_w1[(l * 33 + e) * 64 + lane];
        h1s[lane] = fsin(fq * s);
        float s2 = p.hf_b2[l * 64 + lane];
#pragma unroll 4
        for (int i = 0; i < 64; ++i) s2 += h1s[i] * p.hf_w2[(l * 64 + i) * 64 + lane];
        WSP(bf16_t, WS_H2B)[((size_t)l * SEQ + pos) * 64 + lane] = f2bf(fsin(fq * s2));
    }
}
__device__ void ph_rho_mfma(const Params& p, int bid, int nb, float* sm) {
    using bf16x8 = __attribute__((ext_vector_type(8))) short; using f32x16 = __attribute__((ext_vector_type(16))) float;
    const int TX = otid();
    const int tid = TX, lane = tid & 63, wid = tid >> 6, n = lane & 31, h = lane >> 5, dir = n >> 4, ci = n & 15;
    float* red = sm; float* scl = sm + 512;
    for (int u = bid; u < DEPTH * 2 * 32; u += nb) {
        const int l = u >> 6, o = (u >> 5) & 1, c = (u & 31) * 16 + ci;
        const bf16_t* wrow = WSP(bf16_t, WS_W3T) + ((size_t)l * 2048 + o * 1024 + dir * 512 + c) * 64 + 8 * h;
        bf16x8 bfr[4];
#pragma unroll
        for (int ks = 0; ks < 4; ++ks) bfr[ks] = *reinterpret_cast<const bf16x8*>(wrow + 16 * ks);
        const bf16_t* hb = WSP(bf16_t, WS_H2B) + ((size_t)l * SEQ + wid * 256 + n) * 64 + 8 * h;
        f32x16 acc[8];
#pragma unroll
        for (int blk = 0; blk < 8; ++blk) { acc[blk] = f32x16{};
#pragma unroll
            for (int ks = 0; ks < 4; ++ks) acc[blk] = __builtin_amdgcn_mfma_f32_32x32x16_bf16(*reinterpret_cast<const bf16x8*>(hb + (size_t)blk * 32 * 64 + 16 * ks), bfr[ks], acc[blk], 0, 0, 0); }
        const float delta = fabsf(HY_DA + (float)c * ((HY_DB - HY_DA) / 511.f)) * (-1.f / (float)(SEQ - 1));
        int ppb = wid * 256 + 4 * h; asm volatile("" : "+v"(ppb));
        float ss = 0.f;
#pragma unroll
        for (int blk = 0; blk < 8; ++blk)
#pragma unroll
            for (int r = 0; r < 16; ++r) { const int pp = ppb + blk * 32 + (r & 3) + 8 * (r >> 2);
                float v = acc[blk][r] * __expf((float)pp * delta); if (dir == 1 && pp == 0) v = 0.f;
                acc[blk][r] = v; ss += v * v; }
        __syncthreads();
        red[tid] = ss; __syncthreads();
        if (tid < 16) { float t2 = 0.f;
            for (int w = 0; w < 8; ++w) t2 += (red[w * 64 + tid] + red[w * 64 + 16 + tid]) + (red[w * 64 + 32 + tid] + red[w * 64 + 48 + tid]);
            scl[tid] = rsqrtf(t2 + EPS); }
        __syncthreads();
        const float sc = scl[ci], bias = p.hy_bias[(l * 2 + o) * 512 + c];
        bf16_t* R = WSP(bf16_t, WS_RHO) + (((size_t)l * 2 + o) * 512 + c) * 4096 + 2048;
        if (dir == 0) { bf16_t* Rb = R - (wid * 256 + 4 * h);
            if (wid == 0 && h == 0) { acc[0][0] += bias / sc; R[-2048] = 0; }
#pragma unroll
            for (int blk = 0; blk < 8; ++blk)
#pragma unroll
                for (int r = 0; r < 16; ++r) Rb[-(blk * 32 + (r & 3) + 8 * (r >> 2))] = f2bf(acc[blk][r] * sc);
        } else { bf16_t* Rb = R + (wid * 256 + 4 * h);
#pragma unroll
            for (int blk = 0; blk < 8; ++blk)
#pragma unroll
                for (int r = 0; r < 16; ++r) { if (!(blk == 0 && r == 0 && wid == 0 && h == 0)) Rb[blk * 32 + (r & 3) + 8 * (r >> 2)] = f2bf(acc[blk][r] * sc); }
        }
    }
    __syncthreads();
}

__device__ void ph_norm(const Params& p, int l, int bid, int nb) {
    const int TX = otid();
    const int lane = TX & 63, wid = TX >> 6, nw = NT >> 6;
    const float* MOD = WSP(float, WS_MOD); act_t* HA = WSP(act_t, WS_HA);
    for (int row = bid * nw + wid; row < ROWS; row += nb * nw) {
        const RowInfo r = rowinfo(row);
        const float* xr = xin_row(p, l, row);
        float ss = 0;
#pragma unroll 2
        for (int j = 0; j < 8; ++j) { const float4 v = *(const float4*)(xr + (j * 64 + lane) * 4); ss += v.x * v.x + v.y * v.y + v.z * v.z + v.w * v.w; }
        ss = wave_sum(ss);
        const float rstd = rsqrtf(ss * (1.f / DM) + EPS);
        const float* g = p.norm_g + l * DM; const float* sh = MOD + (size_t)(l * 5 + r.mr) * 6144; const float* sc = sh + 2048;
#pragma unroll 1
        for (int j = 0; j < 8; ++j) {
            const int k = (j * 64 + lane) * 4;
            const float4 v = *(const float4*)(xr + k);
            const float e[4] = {v.x, v.y, v.z, v.w};
#pragma unroll
            for (int q = 0; q < 4; ++q) stf(HA + (size_t)row * DM + k + q, e[q] * rstd * g[k + q] * (1.f + sc[k + q]) + sh[k + q]);
        }
    }
}

template <int EPI>
__device__ void gemm_naive(const Params& p, int l, const act_t* A, int lda, const float* B, int ldb, act_t* C, int ldc, int M, int N, int K, int bid, int nb, float* sm) {
    const int TX = otid();
    float* As = sm; float* Bs = sm + 16 * 132;
    const int tid = TX, tx = tid & 15, ty = tid >> 4;
    const int tilesN = N / 64, tiles = (M / 128) * tilesN;
    for (int tile = bid; tile < tiles; tile += nb) {
        const int m0 = (tile / tilesN) * 128, n0 = (tile % tilesN) * 64;
        float acc[4][4];
#pragma unroll
        for (int i = 0; i < 4; ++i)
#pragma unroll
            for (int j = 0; j < 4; ++j) acc[i][j] = 0.f;
        for (int k0 = 0; k0 < K; k0 += 16) {
            { const int r = tid >> 2, kq = (tid & 3) * 4; const act_t* ap = A + (size_t)(m0 + r) * lda + k0 + kq;
              As[(kq + 0) * 132 + r] = ldf(ap); As[(kq + 1) * 132 + r] = ldf(ap + 1); As[(kq + 2) * 132 + r] = ldf(ap + 2); As[(kq + 3) * 132 + r] = ldf(ap + 3); }
            { const int kk = tid >> 5, nn = (tid & 31) * 2; const float* bp = B + (size_t)(k0 + kk) * ldb + n0 + nn; Bs[kk * 64 + nn] = bp[0]; Bs[kk * 64 + nn + 1] = bp[1]; }
            __syncthreads();
#pragma unroll
            for (int kk = 0; kk < 16; ++kk) {
                const float4 a = *(const float4*)&As[kk * 132 + ty * 4]; const float4 b = *(const float4*)&Bs[kk * 64 + tx * 4];
                const float av[4] = {a.x, a.y, a.z, a.w}, bv[4] = {b.x, b.y, b.z, b.w};
#pragma unroll
                for (int i = 0; i < 4; ++i)
#pragma unroll
                    for (int j = 0; j < 4; ++j) acc[i][j] += av[i] * bv[j];
            }
            __syncthreads();
        }
#pragma unroll
        for (int i = 0; i < 4; ++i) {
            const int m = m0 + ty * 4 + i;
            if (EPI == 0) {
#pragma unroll
                for (int j = 0; j < 4; ++j) stf(C + (size_t)m * ldc + n0 + tx * 4 + j, acc[i][j]);
            } else {
                const RowInfo r = rowinfo(m);
                const float* xr = xin_row(p, l, m);
                const float* gate = WSP(float, WS_MOD) + (size_t)(l * 5 + r.mr) * 6144 + 4096;
                float* XW = WSP(float, WS_XW) + (size_t)m * DM;
#pragma unroll
                for (int j = 0; j < 4; ++j) { const int n = n0 + tx * 4 + j; XW[n] = xr[n] + gate[n] * acc[i][j]; }
            }
        }
    }
}

__device__ void ph_rstd(const Params& p, int bid, int nb) {
    const int TX = otid();
    const int lane = TX & 63, wid = TX >> 6;
    const bf16_t* U = WSP(bf16_t, WS_U); float* RS = WSP(float, WS_RS);
    for (int row = bid * 8 + wid; row < ROWS; row += nb * 8) {
        const bf16_t* ur = U + (size_t)row * NIN;
        const uint4 a = *(const uint4*)(ur + OFF_Q + lane * 8); const uint2 k = *(const uint2*)(ur + OFF_KV + lane * 4);
        const unsigned w[4] = {a.x, a.y, a.z, a.w}; float sq = 0.f, sk = 0.f;
#pragma unroll
        for (int i = 0; i < 4; ++i) { const float lo = __uint_as_float(w[i] << 16), hi = __uint_as_float(w[i] & 0xffff0000u); sq += lo * lo + hi * hi; }
        { const float lo0 = __uint_as_float(k.x << 16), hi0 = __uint_as_float(k.x & 0xffff0000u), lo1 = __uint_as_float(k.y << 16), hi1 = __uint_as_float(k.y & 0xffff0000u); sk = lo0 * lo0 + hi0 * hi0 + lo1 * lo1 + hi1 * hi1; }
        sq = wave_sum(sq); sk = wave_sum(sk);
        if (lane == 0) { RS[2 * row] = rsqrtf(sq * (1.f / QRANK) + EPS); RS[2 * row + 1] = rsqrtf(sk * (1.f / KVRANK) + EPS); }
    }
}
__device__ void ph_krope(const Params& p, int bid, int nb) {
    const int TX = otid();
    const bf16_t* U = WSP(bf16_t, WS_U); bf16_t* KB = WSP(bf16_t, WS_KB); const float* ROPE = WSP(float, WS_ROPE);
    for (int idx = bid * NT + TX; idx < ROWS * 8; idx += nb * NT) {
        const int row = idx >> 3, ch = idx & 7; const RowInfo r = rowinfo(row);
        const uint4 a = *(const uint4*)(U + (size_t)row * NIN + OFF_KR + ch * 8);
        const unsigned w[4] = {a.x, a.y, a.z, a.w}; unsigned o[4];
#pragma unroll
        for (int i = 0; i < 4; ++i) { float x0 = __uint_as_float(w[i] << 16), x1 = __uint_as_float(w[i] & 0xffff0000u);
            if (row < ROWS_L) { const float cs = ROPE[((size_t)r.t * 32 + ch * 4 + i) * 2], sn = ROPE[((size_t)r.t * 32 + ch * 4 + i) * 2 + 1]; const float y0 = x0 * cs - x1 * sn, y1 = x0 * sn + x1 * cs; x0 = y0; x1 = y1; }
            o[i] = (unsigned)f2bf(x0) | ((unsigned)f2bf(x1) << 16); }
#pragma unroll
        for (int h = 0; h < 8; ++h) *(uint4*)(KB + ((size_t)(r.b * NH + h) * LK + r.n) * 192 + 128 + ch * 8) = make_uint4(o[0], o[1], o[2], o[3]);
    }
}
__device__ void ph_shortconv(const Params& p, int l, int bid, int nb) {
    const int TX = otid();
    const act_t* U = WSP(act_t, WS_U); act_t* HC = WSP(act_t, WS_HC);
    const float* w = p.hy_conv_w + (size_t)l * 3 * 1536; const float* bb = p.hy_conv_b + l * 1536;
    for (size_t idx = (size_t)bid * NT + TX; idx < (size_t)ROWS_C * 1536; idx += (size_t)nb * NT) {
        const int row = ROWS_L + (int)(idx / 1536), c = (int)(idx % 1536);
        const RowInfo r = rowinfo(row);
        const float cur = ldf(U + (size_t)row * NIN + c);
        const float prev = r.t > 0 ? ldf(U + (size_t)(row - 1) * NIN + c) : 0.f;
        const float next = r.t < r.L - 1 ? ldf(U + (size_t)(row + 1) * NIN + c) : 0.f;
        stf(HC + (size_t)row * 1536 + c, prev * w[c] + cur * w[1536 + c] + next * w[3072 + c] + bb[c]);
    }
}
__device__ void ph_pooldiff(const Params& p, int bid, int nb) {
    const int TX = otid();
    const act_t* U = WSP(act_t, WS_U); act_t* PD = WSP(act_t, WS_PD);
    for (size_t idx = (size_t)bid * NT + TX; idx < (size_t)ROWS * 512; idx += (size_t)nb * NT) {
        const int row = (int)(idx >> 9), j = (int)(idx & 511);
        const RowInfo r = rowinfo(row);
        const int half = 1 << (j >> 7);
        const int lo = max(r.t - half, 0), hi = min(r.t + half, r.L);
        float s = 0;
        for (int q = lo; q < hi; ++q) s += ldf(U + (size_t)(row - r.t + q) * NIN + OFF_POOL + j);
        stf(PD + idx, s / (float)(hi - lo) - ldf(U + (size_t)row * NIN + OFF_POOL + j));
    }
}
__device__ void ph_poolgate(const Params& p, int l, int bid, int nb) {
    const int TX = otid();
    const act_t* U = WSP(act_t, WS_U); const act_t* PY = WSP(act_t, WS_PY); act_t* MIX = WSP(act_t, WS_MIX);
    for (size_t idx = (size_t)bid * NT + TX; idx < (size_t)ROWS * 512; idx += (size_t)nb * NT) {
        const int row = (int)(idx >> 9), j = (int)(idx & 511);
        stf(MIX + (size_t)row * DM + 1536 + j, ldf(PY + idx) * p.pool_scale[l * 512 + j] * silu_f(ldf(U + (size_t)row * NIN + OFF_POOL_G + j)));
    }
}
__device__ void ph_conv(const Params& p, int l, int order, int bid, int nb, float* sm) {
    const int TX = otid();
    float* Zs = sm; float* Ks = sm + 4096;
    const int tid = TX, c = tid & 63, tg = tid >> 6;
    const act_t* U = WSP(act_t, WS_U); const act_t* HC = WSP(act_t, WS_HC); act_t* Z2 = WSP(act_t, WS_Z2); act_t* MIX = WSP(act_t, WS_MIX);
    const act_t* zsrc = order == 0 ? HC : Z2; const int zld = order == 0 ? 1536 : 512;
    const int nlat = NB * (SEQ / 64) * 8, nctx = (l < DEPTH - 1) ? NB * (CTXL / 64) * 8 : 0;
    for (int u = nlat + bid; u < nlat + nctx; u += nb) {
        int Lidx, b, T0, c0, L, rowbase;
        if (u < nlat) { Lidx = 0; L = SEQ; b = u >> 8; T0 = ((u >> 3) & 31) * 64; c0 = (u & 7) * 64; rowbase = b * SEQ; }
        else { const int v = u - nlat; Lidx = 1; L = CTXL; b = v >> 5; T0 = ((v >> 3) & 3) * 64; c0 = (v & 7) * 64; rowbase = ROWS_L + b * CTXL; }
        const float* F = WSP(float, WS_FC) + ((size_t)l * 2 + order) * 2 * CTXL * 512;
        float acc[8];
#pragma unroll
        for (int i = 0; i < 8; ++i) acc[i] = 0.f;
        for (int S0 = 0; S0 < L; S0 += 64) {
            for (int i = tid; i < 4096; i += NT) { const int ss = i >> 6, cc = i & 63; Zs[i] = ldf(zsrc + (size_t)(rowbase + S0 + ss) * zld + c0 + cc); }
            for (int i = tid; i < 127 * 64; i += NT) { const int j = i >> 6, cc = i & 63; const int n = T0 - S0 + j - 63;
                Ks[i] = n >= 0 ? F[((size_t)0 * L + n) * 512 + c0 + cc] : F[((size_t)1 * L + (-n)) * 512 + c0 + cc]; }
            __syncthreads();
            for (int ss = 0; ss < 64; ++ss) { const float z = Zs[ss * 64 + c];
#pragma unroll
                for (int i = 0; i < 8; ++i) acc[i] += z * Ks[(tg * 8 + i - ss + 63) * 64 + c]; }
            __syncthreads();
        }
        const float scl = WSP(float, WS_FSCL)[(l * 2 + order) * 512 + c0 + c], bias = p.hy_bias[(l * 2 + order) * 512 + c0 + c]; (void)Lidx;
#pragma unroll
        for (int i = 0; i < 8; ++i) {
            const int row = rowbase + T0 + tg * 8 + i;
            const float zt = ldf(zsrc + (size_t)row * zld + c0 + c);
            const float y = scl * acc[i] + bias * zt;
            if (order == 0) stf(Z2 + (size_t)row * 512 + c0 + c, ldf(HC + (size_t)row * 1536 + 512 + c0 + c) * y);
            else stf(MIX + (size_t)row * DM + c0 + c, ldf(HC + (size_t)row * 1536 + 1024 + c0 + c) * y * silu_f(ldf(U + (size_t)row * NIN + OFF_HY_G + c0 + c)));
        }
    }
}

__device__ void ph_final(const Params& p, int bid, int nb) {
    const int TX = otid();
    const int lane = TX & 63, wid = TX >> 6, nw = NT >> 6;
    for (int row = bid * nw + wid; row < ROWS_L; row += nb * nw) {
        const float* xr = WSP(float, WS_XW) + (size_t)row * DM;
        float ss = lane < 32 ? WSP(float, WS_XSS)[(size_t)row * 32 + lane] : 0.f;
        ss = wave_sum(ss);
        const float rstd = rsqrtf(ss * (1.f / DM) + EPS);
#pragma unroll 2
        for (int j = 0; j < 8; ++j) { const int k = (j * 64 + lane) * 4; const float4 v = *(const float4*)(xr + k); const float4 g = *(const float4*)(p.final_norm_g + k);
            *(float4*)(p.out + (size_t)row * DM + k) = make_float4(v.x * rstd * g.x, v.y * rstd * g.y, v.z * rstd * g.z, v.w * rstd * g.w); }
    }
}

namespace pg8 {
#define PG8_LAS __attribute__((address_space(3)))
typedef unsigned short bf16_t;
typedef short bf16x8 __attribute__((ext_vector_type(8)));
typedef float f32x4 __attribute__((ext_vector_type(4)));
typedef unsigned u32x4 __attribute__((ext_vector_type(4)));
constexpr int BM = 256, BK = 64, HALF = 128, HTB = HALF * BK * 2  , STAGE_BYTES = 8 * HTB, NXCD = 8, WGM = 8;

__host__ __device__ __forceinline__ int lds_byte(int r, int c) { const int st = (r >> 4) * 2 + (c >> 5), rr = r & 15, cc = c & 31, ob = rr * 64 + cc * 2; return st * 1024 + (ob ^ (((ob >> 9) & 1) << 5)); }
__host__ __device__ __forceinline__ void stage_rc(int b, int& R, int& C) { const int st = b / 1024, sb = b % 1024, swz = sb ^ (((sb >> 9) & 1) << 5); R = (st >> 1) * 16 + swz / 64; C = (st & 1) * 32 + (swz % 64) / 2; }
__host__ __device__ __forceinline__ int perm32(int rho) { const int n = rho >> 4, i = rho & 15; return 8 * (i >> 2) + 4 * n + (i & 3); }

struct Unit { int pm, pn; };
struct Gemm { const bf16_t* A; const bf16_t* Bt; int M, N, K, lda; };

struct StaticOrder {
    int nM, nN, nwg, G, c;
    __host__ __device__ void init(int M, int N, int G_, int c_) { nM = M / BM; nN = N / BM; nwg = nM * nN; G = G_; c = c_; }
    __host__ __device__ bool next(int i, Unit& u) const {
        const long L = (long)i * G + c; if (L >= nwg) return false;
        int wgid = (int)L; { const int q = nwg / NXCD, r = nwg % NXCD, xcd = wgid % NXCD, off = wgid / NXCD; wgid = (xcd < r ? xcd * (q + 1) : r * (q + 1) + (xcd - r) * q) + off; }
        const int nig = WGM * nN, gid = wgid / nig, fm = gid * WGM, gsz = (nM - fm) < WGM ? (nM - fm) : WGM;
        u.pm = fm + ((wgid % nig) % gsz); u.pn = (wgid % nig) / gsz; return true;
    }
    __device__ __forceinline__ void a_ready(const Unit&) const {}
    __device__ __forceinline__ void done(const Unit&) const {}
};

__device__ __forceinline__ unsigned cvt_pk_bf16(float lo, float hi) { unsigned r; asm volatile("v_cvt_pk_bf16_f32 %0, %1, %2" : "=v"(r) : "v"(lo), "v"(hi)); return r; }

typedef unsigned u32x4_t __attribute__((ext_vector_type(4)));
struct EpiStoreBf16 {
    static constexpr bool PERM = true, AFTER_DRAIN = false;
    bf16_t* O; int ldc; int ncols;
    __device__ __forceinline__ void operator()(const f32x4 (&acc)[2][2][4][2], const Unit& u, int wr, int wc, int fr, int fq) const {
        const int row0 = u.pm * BM + wr * 64 + fr, col0 = u.pn * BM + wc * 32 + 8 * fq;
#pragma unroll
        for (int ai = 0; ai < 2; ++ai)
#pragma unroll
            for (int m = 0; m < 4; ++m) { bf16_t* rowp = O + (size_t)(row0 + ai * HALF + m * 16) * ldc + col0;
#pragma unroll
                for (int bj = 0; bj < 2; ++bj) { if (col0 + bj * HALF < ncols) { const f32x4 v0 = acc[ai][bj][m][0], v1 = acc[ai][bj][m][1];
                    u32x4_t w; w.x = cvt_pk_bf16(v0[0], v0[1]); w.y = cvt_pk_bf16(v0[2], v0[3]); w.z = cvt_pk_bf16(v1[0], v1[1]); w.w = cvt_pk_bf16(v1[2], v1[3]);
                    *(u32x4_t*)(rowp + bj * HALF) = w; } } }
    }
};


struct EpiU {
    static constexpr bool PERM = true, AFTER_DRAIN = false;
    bf16_t* U; bf16_t* UT; float* SSP; int ldc, ncols, rows; const float* XSS; const float* BIAS; bf16_t* KR; const float* ROPE;
    __device__ __forceinline__ void operator()(const f32x4 (&accin)[2][2][4][2], const Unit& u, int wr, int wc, int fr, int fq) const {
        const int row0 = u.pm * BM + wr * 64 + fr, col0 = u.pn * BM + wc * 32 + 8 * fq;
        f32x4 acc[2][2][4][2];
        const float* bp = BIAS + (size_t)(u.pm < 32 ? (u.pm >> 3) : 4) * 5120 + col0;
        const f32x4 bb[2][2] = {{*(const f32x4*)bp, *(const f32x4*)(bp + 4)}, {*(const f32x4*)(bp + HALF), *(const f32x4*)(bp + HALF + 4)}};
#pragma unroll
        for (int ai = 0; ai < 2; ++ai)
#pragma unroll
            for (int m = 0; m < 4; ++m) { const int row = row0 + ai * HALF + m * 16;
                const f32x4 s0 = *(const f32x4*)(XSS + (size_t)row * 32 + fq * 8), s1 = *(const f32x4*)(XSS + (size_t)row * 32 + fq * 8 + 4);
                float ps = ((s0[0] + s0[1]) + (s0[2] + s0[3])) + ((s1[0] + s1[1]) + (s1[2] + s1[3]));
                ps += __shfl_xor(ps, 16); ps += __shfl_xor(ps, 32);
                const float rstd = rsqrtf(ps * (1.f / 2048.f) + 1e-6f);
#pragma unroll
                for (int bj = 0; bj < 2; ++bj) { acc[ai][bj][m][0] = accin[ai][bj][m][0] * rstd + bb[bj][0]; acc[ai][bj][m][1] = accin[ai][bj][m][1] * rstd + bb[bj][1]; } }
        if (u.pn < 8) {
#pragma unroll
            for (int ai = 0; ai < 2; ++ai)
#pragma unroll
                for (int m = 0; m < 4; ++m) { bf16_t* cp = UT + (size_t)col0 * rows + row0 + ai * HALF + m * 16;
#pragma unroll
                    for (int bj = 0; bj < 2; ++bj)
#pragma unroll
                        for (int n = 0; n < 2; ++n) { const f32x4 v = acc[ai][bj][m][n]; const unsigned w0 = cvt_pk_bf16(v[0], v[1]), w1 = cvt_pk_bf16(v[2], v[3]);
                            bf16_t* q = cp + (size_t)(bj * HALF + 4 * n) * rows;
                            q[0] = (bf16_t)(w0 & 0xffffu); q[rows] = (bf16_t)(w0 >> 16); q[2 * (size_t)rows] = (bf16_t)(w1 & 0xffffu); q[3 * (size_t)rows] = (bf16_t)(w1 >> 16); } }
            return;
        }
        const bool stat = u.pn <= 10;
        if (u.pn == 11 && col0 - 2816 < 64) {
#pragma unroll
            for (int ai = 0; ai < 2; ++ai)
#pragma unroll
                for (int m = 0; m < 4; ++m) { const int row = row0 + ai * HALF + m * 16; const bool lat = row < 8192;
                    const int b = lat ? (row >> 11) : ((row - 8192) >> 8), n = lat ? (row & 2047) : 2048 + ((row - 8192) & 255), d = col0 - 2816;
                    f32x4 v0 = acc[ai][0][m][0], v1 = acc[ai][0][m][1];
                    if (lat) { const float* rp = ROPE + ((size_t)n * 32 + (d >> 1)) * 2; const f32x4 r0 = *(const f32x4*)rp, r1 = *(const f32x4*)(rp + 4); const f32x4 a0 = v0, a1 = v1;
                        v0[0] = a0[0] * r0[0] - a0[1] * r0[1]; v0[1] = a0[0] * r0[1] + a0[1] * r0[0]; v0[2] = a0[2] * r0[2] - a0[3] * r0[3]; v0[3] = a0[2] * r0[3] + a0[3] * r0[2];
                        v1[0] = a1[0] * r1[0] - a1[1] * r1[1]; v1[1] = a1[0] * r1[1] + a1[1] * r1[0]; v1[2] = a1[2] * r1[2] - a1[3] * r1[3]; v1[3] = a1[2] * r1[3] + a1[3] * r1[2]; }
                    u32x4_t w; w.x = cvt_pk_bf16(v0[0], v0[1]); w.y = cvt_pk_bf16(v0[2], v0[3]); w.z = cvt_pk_bf16(v1[0], v1[1]); w.w = cvt_pk_bf16(v1[2], v1[3]);
                    *(u32x4_t*)(KR + ((size_t)b * 2304 + n) * 64 + d) = w; }
        }
#pragma unroll
        for (int ai = 0; ai < 2; ++ai)
#pragma unroll
            for (int m = 0; m < 4; ++m) { const int row = row0 + ai * HALF + m * 16; bf16_t* rowp = U + (size_t)row * ldc + col0; float ss = 0.f;
#pragma unroll
                for (int bj = 0; bj < 2; ++bj) { if (col0 + bj * HALF < ncols) { const f32x4 v0 = acc[ai][bj][m][0], v1 = acc[ai][bj][m][1];
                    ss += (v0[0] * v0[0] + v0[1] * v0[1]) + (v0[2] * v0[2] + v0[3] * v0[3]) + (v1[0] * v1[0] + v1[1] * v1[1]) + (v1[2] * v1[2] + v1[3] * v1[3]);
                    u32x4_t w; w.x = cvt_pk_bf16(v0[0], v0[1]); w.y = cvt_pk_bf16(v0[2], v0[3]); w.z = cvt_pk_bf16(v1[0], v1[1]); w.w = cvt_pk_bf16(v1[2], v1[3]);
                    *(u32x4_t*)(rowp + bj * HALF) = w; } }
                if (stat) { ss += __shfl_xor(ss, 16); ss += __shfl_xor(ss, 32);
                    if (fq == 0) SSP[(size_t)row * 12 + (u.pn - 8) * 4 + wc] = ss; } }
    }
};
struct EpiQ {
    static constexpr bool PERM = true, AFTER_DRAIN = false;
    bf16_t* Q; const float* RS; const float* ROPE;
    __device__ __forceinline__ void operator()(const f32x4 (&acc)[2][2][4][2], const Unit& u, int wr, int wc, int fr, int fq) const {
        const int row0 = u.pm * BM + wr * 64 + fr, col0 = u.pn * BM + wc * 32 + 8 * fq;
#pragma unroll
        for (int ai = 0; ai < 2; ++ai)
#pragma unroll
            for (int m = 0; m < 4; ++m) { const int row = row0 + ai * HALF + m * 16; const bool lat = row < 8192;
                const int b = lat ? (row >> 11) : ((row - 8192) >> 8), n = lat ? (row & 2047) : 2048 + ((row - 8192) & 255);
                const float* sp = RS + (size_t)row * 12; const float rs = rsqrtf((((sp[0] + sp[1]) + (sp[2] + sp[3])) + ((sp[4] + sp[5]) + (sp[6] + sp[7]))) * (1.f / 512.f) + 1e-6f);
#pragma unroll
                for (int bj = 0; bj < 2; ++bj) { const int col = col0 + bj * HALF, h = col / 192, d = col - h * 192;
                    f32x4 v0 = acc[ai][bj][m][0] * rs, v1 = acc[ai][bj][m][1] * rs;
                    if (d >= 128 && lat) { const float* rp = ROPE + ((size_t)n * 32 + ((d - 128) >> 1)) * 2; const f32x4 r0 = *(const f32x4*)rp, r1 = *(const f32x4*)(rp + 4);
                        const f32x4 a0 = v0, a1 = v1;
                        v0[0] = a0[0] * r0[0] - a0[1] * r0[1]; v0[1] = a0[0] * r0[1] + a0[1] * r0[0]; v0[2] = a0[2] * r0[2] - a0[3] * r0[3]; v0[3] = a0[2] * r0[3] + a0[3] * r0[2];
                        v1[0] = a1[0] * r1[0] - a1[1] * r1[1]; v1[1] = a1[0] * r1[1] + a1[1] * r1[0]; v1[2] = a1[2] * r1[2] - a1[3] * r1[3]; v1[3] = a1[2] * r1[3] + a1[3] * r1[2]; }
                    u32x4_t w; w.x = cvt_pk_bf16(v0[0], v0[1]); w.y = cvt_pk_bf16(v0[2], v0[3]); w.z = cvt_pk_bf16(v1[0], v1[1]); w.w = cvt_pk_bf16(v1[2], v1[3]);
                    *(u32x4_t*)(Q + ((size_t)(b * 8 + h) * 2304 + n) * 192 + d) = w; } }
    }
};
struct EpiKV {
    static constexpr bool PERM = true, AFTER_DRAIN = false;
    bf16_t* KB; bf16_t* VB; const float* RS;
    __device__ __forceinline__ void operator()(const f32x4 (&acc)[2][2][4][2], const Unit& u, int wr, int wc, int fr, int fq) const {
        const int row0 = u.pm * BM + wr * 64 + fr, col0 = u.pn * BM + wc * 32 + 8 * fq;
#pragma unroll
        for (int ai = 0; ai < 2; ++ai)
#pragma unroll
            for (int m = 0; m < 4; ++m) { const int row = row0 + ai * HALF + m * 16; const bool lat = row < 8192;
                const int b = lat ? (row >> 11) : ((row - 8192) >> 8), n = lat ? (row & 2047) : 2048 + ((row - 8192) & 255);
                const float* sp = RS + (size_t)row * 12 + 8; const float rs = rsqrtf(((sp[0] + sp[1]) + (sp[2] + sp[3])) * (1.f / 256.f) + 1e-6f);
#pragma unroll
                for (int bj = 0; bj < 2; ++bj) { const int col = col0 + bj * HALF, h = col >> 8, d = col & 255;
                    const f32x4 v0 = acc[ai][bj][m][0] * rs, v1 = acc[ai][bj][m][1] * rs;
                    u32x4_t w; w.x = cvt_pk_bf16(v0[0], v0[1]); w.y = cvt_pk_bf16(v0[2], v0[3]); w.z = cvt_pk_bf16(v1[0], v1[1]); w.w = cvt_pk_bf16(v1[2], v1[3]);
                    const size_t pos = (size_t)(b * 8 + h) * 2304 + n;
                    if (d < 128) *(u32x4_t*)(KB + pos * 192 + d) = w; else *(u32x4_t*)(VB + pos * 128 + (d - 128)) = w; } }
    }
};
struct EpiResid {
    static constexpr bool PERM = true, AFTER_DRAIN = false;
    const float* xl; const float* xc; float* XW; const float* gate;
    const float* GG; bf16_t* XG; float* XSS;
    __device__ __forceinline__ void operator()(const f32x4 (&acc)[2][2][4][2], const Unit& u, int wr, int wc, int fr, int fq) const {
        const int col0 = u.pn * BM + wc * 32 + 8 * fq, mr = u.pm < 32 ? (u.pm >> 3) : 4;
        f32x4 gt[2][2], gg[2][2];
#pragma unroll
        for (int bj = 0; bj < 2; ++bj)
#pragma unroll
            for (int n = 0; n < 2; ++n) { const int c = col0 + bj * HALF + n * 4; gt[bj][n] = *(const f32x4*)(gate + (size_t)mr * 6144 + c);
                gg[bj][n] = GG ? *(const f32x4*)(GG + (size_t)mr * 2048 + c) : (f32x4){0.f, 0.f, 0.f, 0.f}; }
#pragma unroll
        for (int ai = 0; ai < 2; ++ai)
#pragma unroll
            for (int m = 0; m < 4; ++m) { const int row = u.pm * BM + ai * HALF + wr * 64 + m * 16 + fr;
                const float* xr = row < 8192 ? xl + (size_t)row * 2048 : xc + (size_t)(row - 8192) * 2048;
                float* o = XW + (size_t)row * 2048; float ss = 0.f;
#pragma unroll
                for (int bj = 0; bj < 2; ++bj) { const int c = col0 + bj * HALF;
                    const f32x4 x0 = *(const f32x4*)(xr + c), x1 = *(const f32x4*)(xr + c + 4);
                    const f32x4 n0 = x0 + gt[bj][0] * acc[ai][bj][m][0], n1 = x1 + gt[bj][1] * acc[ai][bj][m][1];
                    *(f32x4*)(o + c) = n0; *(f32x4*)(o + c + 4) = n1;
                    ss += ((n0[0] * n0[0] + n0[1] * n0[1]) + (n0[2] * n0[2] + n0[3] * n0[3])) + ((n1[0] * n1[0] + n1[1] * n1[1]) + (n1[2] * n1[2] + n1[3] * n1[3]));
                    if (GG) { const f32x4 q0 = n0 * gg[bj][0], q1 = n1 * gg[bj][1]; u32x4_t w; w.x = cvt_pk_bf16(q0[0], q0[1]); w.y = cvt_pk_bf16(q0[2], q0[3]); w.z = cvt_pk_bf16(q1[0], q1[1]); w.w = cvt_pk_bf16(q1[2], q1[3]);
                        *(u32x4_t*)(XG + (size_t)row * 2048 + c) = w; } }
                ss += __shfl_xor(ss, 16); ss += __shfl_xor(ss, 32);
                if (fq == 0) XSS[(size_t)row * 32 + u.pn * 4 + wc] = ss; }
    }
};

template <class Epi, class Sched, bool ALIGN_EPI = false, bool SP2 = false>
__device__ __forceinline__ void gemm_phase(PG8_LAS unsigned char* lds, const Gemm g, const Sched& S, const Epi& E) {
    int tid_ = threadIdx.x; asm volatile("" : "+v"(tid_));
    const int tid = tid_, wid = __builtin_amdgcn_readfirstlane(tid >> 6), lane = tid & 63, wr = wid >> 2, wc = wid & 3, fr = lane & 15, fq = lane >> 4;
    const int K = g.K, nt = K / BK;
    unsigned voffA[2], voffB[2];
#pragma unroll
    for (int i = 0; i < 2; ++i) { int R, C; stage_rc(tid * 16 + i * 8192, R, C); const int Rb = Epi::PERM ? ((R & ~31) + perm32(R & 31)) : R;
        voffA[i] = (unsigned)(R * g.lda + C) * 2u; voffB[i] = (unsigned)(Rb * K + C) * 2u; }
    const size_t kstep = (size_t)(BK * 2);
    const size_t hstep = (size_t)HALF * K * 2;
    const size_t tstep = 2 * hstep;
    const size_t hstepA = (size_t)HALF * g.lda * 2, tstepA = 2 * hstepA;
    const unsigned ldsw = (unsigned)wid * 1024u;
    const int aoff = lds_byte(wr * 64 + fr, fq * 8), boff = lds_byte(wc * 32 + fr, fq * 8);
#define PG8_SA(b, h) (((b) * 2 + (h)) * HTB)
#define PG8_SB(b, h) ((4 + (b) * 2 + (h)) * HTB)
#define PG8_STAGE(bufoff, gbase, voff) do { _Pragma("unroll") for (int _i = 0; _i < 2; ++_i) \
        __builtin_amdgcn_global_load_lds((const unsigned*)((const char*)(gbase) + (voff)[_i]), (PG8_LAS unsigned*)(lds + (bufoff) + ldsw + _i * 8192), 16, 0, 0); } while (0)
#define PG8_LDA(dst, b, h) do { _Pragma("unroll") for (int m = 0; m < 4; ++m) _Pragma("unroll") for (int k = 0; k < 2; ++k) dst[m][k] = *(const PG8_LAS bf16x8*)(lds + PG8_SA(b, h) + aoff + m * 2048 + k * 1024); } while (0)
#define PG8_LDB(dst, b, h) do { _Pragma("unroll") for (int n = 0; n < 2; ++n) _Pragma("unroll") for (int k = 0; k < 2; ++k) dst[n][k] = *(const PG8_LAS bf16x8*)(lds + PG8_SB(b, h) + boff + n * 2048 + k * 1024); } while (0)
#define PG8_MMA(ai, bj, At, Bt) do { __builtin_amdgcn_s_setprio(1); _Pragma("unroll") for (int m = 0; m < 4; ++m) _Pragma("unroll") for (int n = 0; n < 2; ++n) _Pragma("unroll") for (int k = 0; k < 2; ++k) \
        acc[ai][bj][m][n] = __builtin_amdgcn_mfma_f32_16x16x32_bf16(Bt[n][k], At[m][k], acc[ai][bj][m][n], 0, 0, 0); __builtin_amdgcn_s_setprio(0); } while (0)
#define PG8_WAIT_V(n) asm volatile("s_waitcnt vmcnt(" #n ")" ::: "memory")
#define PG8_WAIT_L(n) asm volatile("s_waitcnt lgkmcnt(" #n ")" ::: "memory")
#define PG8_BAR __builtin_amdgcn_s_barrier()
#define PG8_SCHED __builtin_amdgcn_sched_barrier(0)
    Unit cur, nxt; int ui = 0;
    if (!S.next(0, cur)) return;
    f32x4 acc[2][2][4][2];
#pragma unroll
    for (int a = 0; a < 2; ++a)
#pragma unroll
        for (int b = 0; b < 2; ++b)
#pragma unroll
            for (int m = 0; m < 4; ++m)
#pragma unroll
                for (int n = 0; n < 2; ++n) acc[a][b][m][n] = (f32x4){0.f, 0.f, 0.f, 0.f};
    bf16x8 At[4][2], B0[2][2], B1[2][2];
    const char* cA = (const char*)g.A + (size_t)cur.pm * tstepA; const char* cB = (const char*)g.Bt + (size_t)cur.pn * tstep;
    S.a_ready(cur);
    if constexpr (SP2) {
        PG8_STAGE(PG8_SB(0, 0), cB, voffB); PG8_STAGE(PG8_SB(0, 1), cB + hstep, voffB); PG8_STAGE(PG8_SA(0, 0), cA, voffA); PG8_STAGE(PG8_SA(0, 1), cA + hstepA, voffA);
        if (wr == 1) PG8_BAR;
        PG8_WAIT_V(2); PG8_BAR;
        PG8_STAGE(PG8_SB(1, 0), cB + kstep, voffB); PG8_STAGE(PG8_SA(1, 0), cA + kstep, voffA); PG8_STAGE(PG8_SB(1, 1), cB + hstep + kstep, voffB);
        PG8_WAIT_V(6); PG8_BAR;
    } else {
        PG8_STAGE(PG8_SB(0, 0), cB, voffB); PG8_STAGE(PG8_SA(0, 0), cA, voffA); PG8_STAGE(PG8_SB(0, 1), cB + hstep, voffB); PG8_STAGE(PG8_SA(0, 1), cA + hstepA, voffA);
        if (wr == 1) PG8_BAR;
        PG8_WAIT_V(4); PG8_BAR;
        PG8_STAGE(PG8_SB(1, 0), cB + kstep, voffB); PG8_STAGE(PG8_SA(1, 0), cA + kstep, voffA); PG8_STAGE(PG8_SB(1, 1), cB + hstep + kstep, voffB);
        PG8_WAIT_V(6); PG8_BAR;
    }
    for (;;) {
        const bool has_next = S.next(ui + 1, nxt);
        const char* nA = has_next ? (const char*)g.A + (size_t)nxt.pm * tstepA : cA; const char* nB = has_next ? (const char*)g.Bt + (size_t)nxt.pn * tstep : cB;
        for (int t = 0; t < nt; t += 2) {
            const bool last = (t == nt - 2);
            const char* a1 = cA + (size_t)(t + 1) * kstep;
            const char* a2 = last ? nA : cA + (size_t)(t + 2) * kstep; const char* b2 = last ? nB : cB + (size_t)(t + 2) * kstep;
            const char* a3 = a2 + kstep; const char* b3 = b2 + kstep;
            if (last && has_next) S.a_ready(nxt);
            if constexpr (SP2) {
            PG8_LDB(B0, 0, 0); PG8_LDB(B1, 0, 1); PG8_SCHED; PG8_LDA(At, 0, 0); PG8_STAGE(PG8_SA(1, 1), a1 + hstepA, voffA);
            PG8_WAIT_V(8); PG8_WAIT_L(0); PG8_BAR; PG8_MMA(0, 0, At, B0); PG8_MMA(0, 1, At, B1); PG8_BAR; PG8_SCHED;
            PG8_LDA(At, 0, 1); PG8_STAGE(PG8_SB(0, 0), b2, voffB); PG8_STAGE(PG8_SB(0, 1), b2 + hstep, voffB); PG8_STAGE(PG8_SA(0, 0), a2, voffA);
            PG8_WAIT_V(8); PG8_WAIT_L(0); PG8_BAR; PG8_MMA(1, 0, At, B0); PG8_MMA(1, 1, At, B1); PG8_BAR; PG8_SCHED;
            PG8_LDB(B0, 1, 0); PG8_LDB(B1, 1, 1); PG8_SCHED; PG8_LDA(At, 1, 0); PG8_STAGE(PG8_SA(0, 1), a2 + hstepA, voffA);
            PG8_WAIT_V(8); PG8_WAIT_L(0); PG8_BAR; PG8_MMA(0, 0, At, B0); PG8_MMA(0, 1, At, B1); PG8_BAR; PG8_SCHED;
            PG8_LDA(At, 1, 1); PG8_STAGE(PG8_SB(1, 0), b3, voffB); PG8_STAGE(PG8_SB(1, 1), b3 + hstep, voffB); PG8_STAGE(PG8_SA(1, 0), a3, voffA);
            PG8_WAIT_V(8); PG8_WAIT_L(0); PG8_BAR; PG8_MMA(1, 0, At, B0); PG8_MMA(1, 1, At, B1); PG8_BAR; PG8_SCHED;
            } else {
            PG8_LDB(B0, 0, 0); PG8_SCHED; PG8_LDA(At, 0, 0); PG8_STAGE(PG8_SA(1, 1), a1 + hstepA, voffA);
            PG8_WAIT_L(8); PG8_BAR; PG8_WAIT_L(0); PG8_MMA(0, 0, At, B0); PG8_BAR; PG8_SCHED;
            PG8_LDB(B1, 0, 1); PG8_STAGE(PG8_SB(0, 0), b2, voffB);
            PG8_BAR; PG8_WAIT_L(0); PG8_MMA(0, 1, At, B1); PG8_BAR;
            PG8_LDA(At, 0, 1); PG8_STAGE(PG8_SA(0, 0), a2, voffA);
            PG8_BAR; PG8_WAIT_L(0); PG8_MMA(1, 0, At, B0); PG8_BAR; PG8_SCHED;
            PG8_STAGE(PG8_SB(0, 1), b2 + hstep, voffB);
            PG8_WAIT_V(6); PG8_BAR; PG8_MMA(1, 1, At, B1); PG8_BAR;
            PG8_LDB(B0, 1, 0); PG8_SCHED; PG8_LDA(At, 1, 0); PG8_STAGE(PG8_SA(0, 1), a2 + hstepA, voffA);
            PG8_WAIT_L(8); PG8_BAR; PG8_WAIT_L(0); PG8_MMA(0, 0, At, B0); PG8_BAR; PG8_SCHED;
            PG8_LDB(B1, 1, 1); PG8_STAGE(PG8_SB(1, 0), b3, voffB);
            PG8_BAR; PG8_WAIT_L(0); PG8_MMA(0, 1, At, B1); PG8_BAR;
            PG8_LDA(At, 1, 1); PG8_STAGE(PG8_SA(1, 0), a3, voffA);
            PG8_BAR; PG8_WAIT_L(0); PG8_MMA(1, 0, At, B0); PG8_BAR; PG8_SCHED;
            PG8_STAGE(PG8_SB(1, 1), b3 + hstep, voffB);
            PG8_WAIT_V(6); PG8_BAR; PG8_MMA(1, 1, At, B1); PG8_BAR;
            }
        }
        if constexpr (ALIGN_EPI) { if (wr == 0) PG8_BAR; }
        if constexpr (!Epi::AFTER_DRAIN) { E(acc, cur, wr, wc, fr, fq); S.done(cur); }
        if (!has_next) break;
#pragma unroll
        for (int a = 0; a < 2; ++a)
#pragma unroll
            for (int b = 0; b < 2; ++b)
#pragma unroll
                for (int m = 0; m < 4; ++m)
#pragma unroll
                    for (int n = 0; n < 2; ++n) acc[a][b][m][n] = (f32x4){0.f, 0.f, 0.f, 0.f};
        cur = nxt; cA = nA; cB = nB; ++ui;
        if constexpr (ALIGN_EPI) { if (wr == 1) PG8_BAR; }
    }
    PG8_WAIT_V(0);
    if constexpr (!ALIGN_EPI) { if (wr == 0) PG8_BAR; }
    PG8_BAR;
    if constexpr (Epi::AFTER_DRAIN) { E.fused(acc, cur, wr, wc, fr, fq, lds, wid, lane); S.done(cur); }
#undef PG8_SA
#undef PG8_SB
#undef PG8_STAGE
#undef PG8_LDA
#undef PG8_LDB
#undef PG8_MMA
#undef PG8_WAIT_V
#undef PG8_WAIT_L
#undef PG8_BAR
#undef PG8_SCHED
}
}


namespace att {
using bf16x8 = __attribute__((ext_vector_type(8))) short;
using s16x4  = __attribute__((ext_vector_type(4))) short;
using f32x16 = __attribute__((ext_vector_type(16))) float;
using u32x4  = __attribute__((ext_vector_type(4))) unsigned;
constexpr int QBLK = 32, KVBLK = 64, NW = 8;
constexpr float SCALE = 0.07216878364870322f, THR = 8.f;
constexpr int SHM_V = 16384, SHM_KN = 16384, SHM_KR = 8192;
constexpr int OFF_V = 0, OFF_KN = 2 * SHM_V, OFF_KR = OFF_KN + 2 * SHM_KN, OFF_WS = OFF_KR + 2 * SHM_KR, OFF_QR = OFF_WS + NW * 64 * 4, SHM_TOTAL = OFF_QR + NW * 4096;
#define KSWZ(row, colB) ((row) * 256 + ((colB) ^ (((row) & 7) << 4)))
#define RSWZ(row, ch) ((row) * 128 + ((((ch) ^ (((row) >> 1) & 7))) << 4))
#define SBAR() __builtin_amdgcn_sched_barrier(0)
__device__ __forceinline__ int crow(int r, int hi) { return (r & 3) + 8 * (r >> 2) + 4 * hi; }
__device__ __forceinline__ unsigned cvtpk(float lo, float hi) { unsigned r; asm volatile("v_cvt_pk_bf16_f32 %0, %1, %2" : "=v"(r) : "v"(lo), "v"(hi)); return r; }
__device__ __forceinline__ bf16x8 ld8(const bf16_t* p) { return *reinterpret_cast<const bf16x8*>(p); }

__device__ __forceinline__ void partialSM(f32x16& p0, f32x16& p1, float& m_reg, float& mn, float& alpha) {
  constexpr float C = SCALE * 1.4426950408889634f;
  float pmax = p0[0];
#pragma unroll
  for (int r = 1; r < 16; ++r) pmax = fmaxf(pmax, p0[r]);
#pragma unroll
  for (int r = 0; r < 16; ++r) pmax = fmaxf(pmax, p1[r]);
  { auto rr = __builtin_amdgcn_permlane32_swap(__float_as_uint(pmax), __float_as_uint(pmax), false, false);
    pmax = fmaxf(__uint_as_float(rr[0]), __uint_as_float(rr[1])); }
  if (__builtin_expect(__all(pmax - m_reg <= THR / SCALE), 1)) { mn = m_reg; alpha = 1.f; }
  else { mn = fmaxf(m_reg, pmax); alpha = __builtin_amdgcn_exp2f((m_reg - mn) * C); m_reg = mn; }
  const float mnC = -mn * C;
#pragma unroll
  for (int r = 0; r < 16; ++r) p0[r] = fmaf(p0[r], C, mnC);
#pragma unroll
  for (int r = 0; r < 16; ++r) p1[r] = fmaf(p1[r], C, mnC);
#pragma unroll
  for (int r = 0; r < 16; ++r) p0[r] = __builtin_amdgcn_exp2f(p0[r]);
}
__device__ __forceinline__ void finishSM(f32x16& p0, f32x16& p1, float alpha, float& l_reg, bf16x8& pa0, bf16x8& pa1, bf16x8& pa2, bf16x8& pa3) {
#pragma unroll
  for (int r = 0; r < 16; ++r) p1[r] = __builtin_amdgcn_exp2f(p1[r]);
  float ps = 0;
#pragma unroll
  for (int r = 0; r < 16; ++r) ps += p0[r];
#pragma unroll
  for (int r = 0; r < 16; ++r) ps += p1[r];
  { auto rr = __builtin_amdgcn_permlane32_swap(__float_as_uint(ps), __float_as_uint(ps), false, false);
    ps = __uint_as_float(rr[0]) + __uint_as_float(rr[1]); }
  l_reg = l_reg * alpha + ps;
#define PK4(P, BASE, OUT) do { unsigned a0 = cvtpk(P[BASE + 0], P[BASE + 1]), a1 = cvtpk(P[BASE + 2], P[BASE + 3]);   \
    unsigned b0 = cvtpk(P[BASE + 4], P[BASE + 5]), b1 = cvtpk(P[BASE + 6], P[BASE + 7]);                              \
    auto r0 = __builtin_amdgcn_permlane32_swap(a0, b0, false, false); auto r1 = __builtin_amdgcn_permlane32_swap(a1, b1, false, false); \
    u32x4 w = {r0[0], r1[0], r0[1], r1[1]}; OUT = *reinterpret_cast<bf16x8*>(&w); } while (0)
  PK4(p0, 0, pa0); PK4(p0, 8, pa1); PK4(p1, 0, pa2); PK4(p1, 8, pa3);
#undef PK4
}
__device__ __forceinline__ void qkt(f32x16& p0, f32x16& p1, const char* Kn, const char* Kr, const bf16x8* qr, const char* qrl, int r32, int hi) {
  p0 = f32x16{}; p1 = f32x16{};
#pragma unroll
  for (int d0 = 0; d0 < 8; ++d0) { const int cb = (d0 * 16 + hi * 8) * 2;
    const bf16x8 b0 = *reinterpret_cast<const bf16x8*>(Kn + KSWZ(r32, cb));
    const bf16x8 b1 = *reinterpret_cast<const bf16x8*>(Kn + KSWZ(32 + r32, cb));
    p0 = __builtin_amdgcn_mfma_f32_32x32x16_bf16(b0, qr[d0], p0, 0, 0, 0);
    p1 = __builtin_amdgcn_mfma_f32_32x32x16_bf16(b1, qr[d0], p1, 0, 0, 0); }
#pragma unroll
  for (int d0 = 0; d0 < 4; ++d0) { const int ch = d0 * 2 + hi;
    const bf16x8 b0 = *reinterpret_cast<const bf16x8*>(Kr + RSWZ(r32, ch));
    const bf16x8 b1 = *reinterpret_cast<const bf16x8*>(Kr + RSWZ(32 + r32, ch));
    const bf16x8 qv = *reinterpret_cast<const bf16x8*>(qrl + d0 * 1024);
    p0 = __builtin_amdgcn_mfma_f32_32x32x16_bf16(b0, qv, p0, 0, 0, 0);
    p1 = __builtin_amdgcn_mfma_f32_32x32x16_bf16(b1, qv, p1, 0, 0, 0); }
}
__device__ __forceinline__ int v_st(int k, int c) { const int kk = (k & ~0xC) | ((k & 4) << 1) | ((k & 8) >> 1); return ((kk >> 3) * 4 + (c >> 5)) * 512 + ((kk & 7) * 32 + (c & 31)) * 2; }
__device__ __forceinline__ int v_rd_base(int lane) { return ((lane & 3) << 3) | (((lane >> 2) & 3) << 6) | (((lane >> 4) & 1) << 5) | (((lane >> 5) & 1) << 8); }
constexpr int v_rd_off(int d0, int ks, int half) { return d0 * 512 + ks * 4096 + half * 2048; }
template <int OFF> __device__ __forceinline__ s16x4 tr_read(int vb) {
  s16x4 r; asm volatile("ds_read_b64_tr_b16 %0, %1 offset:%2" : "=&v"(r) : "v"(vb), "i"(OFF) : "memory"); return r;
}
template <int D0> __device__ __forceinline__ void pv_one(f32x16& od, int vb, bf16x8 pa0, bf16x8 pa1, bf16x8 pa2, bf16x8 pa3) {
  const s16x4 l0 = tr_read<v_rd_off(D0, 0, 0)>(vb), h0 = tr_read<v_rd_off(D0, 0, 1)>(vb), l1 = tr_read<v_rd_off(D0, 1, 0)>(vb), h1 = tr_read<v_rd_off(D0, 1, 1)>(vb);
  const s16x4 l2 = tr_read<v_rd_off(D0, 2, 0)>(vb), h2 = tr_read<v_rd_off(D0, 2, 1)>(vb), l3 = tr_read<v_rd_off(D0, 3, 0)>(vb), h3 = tr_read<v_rd_off(D0, 3, 1)>(vb);
  asm volatile("s_waitcnt lgkmcnt(0)" ::: "memory"); SBAR();
#define PK(L, H) (bf16x8){L[0], L[1], L[2], L[3], H[0], H[1], H[2], H[3]}
  od = __builtin_amdgcn_mfma_f32_32x32x16_bf16(pa0, PK(l0, h0), od, 0, 0, 0);
  od = __builtin_amdgcn_mfma_f32_32x32x16_bf16(pa1, PK(l1, h1), od, 0, 0, 0);
  od = __builtin_amdgcn_mfma_f32_32x32x16_bf16(pa2, PK(l2, h2), od, 0, 0, 0);
  od = __builtin_amdgcn_mfma_f32_32x32x16_bf16(pa3, PK(l3, h3), od, 0, 0, 0);
#undef PK
}
__device__ __forceinline__ void pv_d0(f32x16* o, int vb, bf16x8 pa0, bf16x8 pa1, bf16x8 pa2, bf16x8 pa3) {
  pv_one<0>(o[0], vb, pa0, pa1, pa2, pa3); pv_one<1>(o[1], vb, pa0, pa1, pa2, pa3); pv_one<2>(o[2], vb, pa0, pa1, pa2, pa3); pv_one<3>(o[3], vb, pa0, pa1, pa2, pa3);
}
__device__ __forceinline__ void attn_unit(const bf16_t* __restrict__ Qb, const bf16_t* __restrict__ Kh, const bf16_t* __restrict__ Krp, const bf16_t* __restrict__ Vh, int seq,
                                          bf16_t* __restrict__ Mo, const bf16_t* __restrict__ G, char* lds) {
  int tid_ = threadIdx.x; asm volatile("" : "+v"(tid_));
  const int tid = tid_, wid = tid >> 6, lane = tid & 63, r32 = lane & 31, hi = lane >> 5;
  char* V_lds = lds + OFF_V; char* KN_lds = lds + OFF_KN; char* KR_lds = lds + OFF_KR;
  float* ws = (float*)(lds + OFF_WS) + wid * 64; float* li_l = ws; float* al_l = ws + 32;
  float m_reg = -1e30f, l_reg = 0; f32x16 o[4] = {}; bf16x8 qr[8];
  const bf16_t* Qw = Qb + (long)(wid * QBLK + r32) * 192 + hi * 8;
  char* qrl = lds + OFF_QR + wid * 4096 + lane * 16;
#pragma unroll
  for (int d0 = 0; d0 < 8; ++d0) qr[d0] = ld8(Qw + d0 * 16);
#pragma unroll
  for (int d0 = 0; d0 < 4; ++d0) *reinterpret_cast<bf16x8*>(qrl + d0 * 1024) = ld8(Qw + (8 + d0) * 16);
  const int sr = tid >> 4, sc = (tid & 15) * 8, vst0 = v_st(sr, sc), vst1 = v_st(32 + sr, sc);
  const int rr_ = tid >> 3, rch = tid & 7;
  const int vb0 = (int)(uintptr_t)V_lds + v_rd_base(lane);
  bf16x8 vs0, vs1, ks0, ks1, kr0;
  const int vo0 = sr * 128 + sc, ko0 = sr * 192 + sc, kro = rr_ * 64 + rch * 8;
#define SLOAD(k0) do { const bf16_t* vt_ = Vh + (long)(k0) * 128; const bf16_t* kt_ = Kh + (long)(k0) * 192; \
    vs0 = ld8(vt_ + vo0); vs1 = ld8(vt_ + vo0 + 32 * 128); ks0 = ld8(kt_ + ko0); ks1 = ld8(kt_ + ko0 + 32 * 192); kr0 = ld8(Krp + (long)(k0) * 64 + kro); } while (0)
#define SWRITE(b) do { *(bf16x8*)(V_lds + (b) * SHM_V + vst0) = vs0; *(bf16x8*)(V_lds + (b) * SHM_V + vst1) = vs1; const int kc = sc * 2; \
    *(bf16x8*)(KN_lds + (b) * SHM_KN + KSWZ(sr, kc)) = ks0; *(bf16x8*)(KN_lds + (b) * SHM_KN + KSWZ(32 + sr, kc)) = ks1; \
    *(bf16x8*)(KR_lds + (b) * SHM_KR + RSWZ(rr_, rch)) = kr0; } while (0)
#define SWAIT() asm volatile("s_waitcnt vmcnt(0)" ::: "memory")
#define RESC(a) do { if (__any((a) < 1.f)) { if (hi == 0) al_l[r32] = (a); asm volatile("s_waitcnt lgkmcnt(0)" ::: "memory"); \
    _Pragma("unroll") for (int d = 0; d < 4; ++d) _Pragma("unroll") for (int r = 0; r < 16; ++r) o[d][r] *= al_l[crow(r, hi)]; } } while (0)
  f32x16 pA0, pA1, pB0, pB1; float mnA, mnB, alA, alB; bf16x8 pa0, pa1, pa2, pa3; const int NTL = seq / KVBLK;
  SLOAD(0); SWAIT(); SWRITE(0); __syncthreads();
  qkt(pA0, pA1, KN_lds, KR_lds, qr, qrl, r32, hi); partialSM(pA0, pA1, m_reg, mnA, alA);
  SLOAD(KVBLK);
  SWAIT(); SWRITE(1); __syncthreads();
  for (int j = 1; j + 1 < NTL; j += 2) {
    SBAR(); qkt(pB0, pB1, KN_lds + SHM_KN, KR_lds + SHM_KR, qr, qrl, r32, hi);
    finishSM(pA0, pA1, alA, l_reg, pa0, pa1, pa2, pa3); SBAR();
    SLOAD((j + 1) * KVBLK); SBAR();
    pv_d0(o, vb0, pa0, pa1, pa2, pa3); partialSM(pB0, pB1, m_reg, mnB, alB);
    __syncthreads(); SWAIT(); SWRITE(0);
    RESC(alB); __syncthreads();
    SBAR(); qkt(pA0, pA1, KN_lds, KR_lds, qr, qrl, r32, hi);
    finishSM(pB0, pB1, alB, l_reg, pa0, pa1, pa2, pa3); SBAR();
    SLOAD((j + 2) * KVBLK); SBAR();
    pv_d0(o, vb0 + SHM_V, pa0, pa1, pa2, pa3); partialSM(pA0, pA1, m_reg, mnA, alA);
    __syncthreads(); SWAIT(); SWRITE(1);
    RESC(alA); __syncthreads();
  }
  SBAR(); qkt(pB0, pB1, KN_lds + SHM_KN, KR_lds + SHM_KR, qr, qrl, r32, hi);
  finishSM(pA0, pA1, alA, l_reg, pa0, pa1, pa2, pa3); SBAR();
  pv_d0(o, vb0, pa0, pa1, pa2, pa3); partialSM(pB0, pB1, m_reg, mnB, alB);
  __syncthreads(); RESC(alB);
  finishSM(pB0, pB1, alB, l_reg, pa0, pa1, pa2, pa3); SBAR();
  pv_d0(o, vb0 + SHM_V, pa0, pa1, pa2, pa3);
  if (hi == 0) li_l[r32] = l_reg; asm volatile("s_waitcnt lgkmcnt(0)" ::: "memory");
  float rli[16];
#pragma unroll
  for (int r = 0; r < 16; ++r) rli[r] = __builtin_amdgcn_rcpf(li_l[crow(r, hi)]);
  __syncthreads();
  { bf16_t* stg = reinterpret_cast<bf16_t*>(lds) + wid * 4096;
#pragma unroll
    for (int r = 0; r < 16; ++r) { const int orow = crow(r, hi);
#pragma unroll
      for (int d0 = 0; d0 < 4; ++d0) stg[orow * 128 + d0 * 32 + r32] = f2bf(o[d0][r] * rli[r]); }
    asm volatile("s_waitcnt lgkmcnt(0)" ::: "memory");
#pragma unroll
    for (int i = 0; i < 8; ++i) { const int id = lane + 64 * i, row = id >> 4, ch = id & 15, grow = wid * QBLK + row;
      const u32x4 ov = *reinterpret_cast<const u32x4*>(stg + row * 128 + ch * 8);
      const u32x4 gv = *reinterpret_cast<const u32x4*>(G + (long)grow * NIN + ch * 8);
      const unsigned ow[4] = {ov.x, ov.y, ov.z, ov.w}, gw[4] = {gv.x, gv.y, gv.z, gv.w}; unsigned rw[4];
#pragma unroll
      for (int k = 0; k < 4; ++k) { const float g0 = __uint_as_float(gw[k] << 16), g1 = __uint_as_float(gw[k] & 0xffff0000u);
        const float y0 = __uint_as_float(ow[k] << 16) * (g0 / (1.f + __expf(-g0))), y1 = __uint_as_float(ow[k] & 0xffff0000u) * (g1 / (1.f + __expf(-g1)));
        rw[k] = cvtpk(y0, y1); }
      *reinterpret_cast<u32x4*>(Mo + (long)grow * DM + ch * 8) = (u32x4){rw[0], rw[1], rw[2], rw[3]}; } }
  __syncthreads();
#undef SLOAD
#undef SWRITE
#undef SWAIT
#undef RESC
}
#undef SBAR
}

__device__ void ph_attn_mfma(const Params& p, int l, int bid, int nb, char* lds) {
    const bf16_t* Q = WSP(bf16_t, WS_Q); const bf16_t* KB = WSP(bf16_t, WS_KB); const bf16_t* VB = WSP(bf16_t, WS_VB); const bf16_t* U = WSP(bf16_t, WS_U); bf16_t* MIX = WSP(bf16_t, WS_MIX);
    const int vcu = (nb % 8 == 0) ? (bid % 8) * (nb / 8) + bid / 8 : bid;
    const int nlat = NB * NH * (SEQ / 256), nctx = (l < DEPTH - 1) ? NB * NH : 0;
    for (int u = vcu; u < nlat + nctx; u += nb) {
        if (u < nlat) { const int bh = u >> 3, qb = u & 7, b = bh >> 3, h = bh & 7; const size_t hb = (size_t)bh * LK; const size_t rowbase = (size_t)b * SEQ + qb * 256;
            att::attn_unit(Q + (hb + qb * 256) * 192, KB + hb * 192, WSP(bf16_t, WS_KR) + (size_t)b * LK * 64, VB + hb * 128, LK, MIX + rowbase * DM + 512 + h * 128, U + rowbase * NIN + OFF_MLA_G + h * 128, lds); }
        else { const int bh = u - nlat, b = bh >> 3, h = bh & 7; const size_t hb = (size_t)bh * LK + SEQ; const size_t rowbase = (size_t)ROWS_L + b * CTXL;
            att::attn_unit(Q + hb * 192, KB + hb * 192, WSP(bf16_t, WS_KR) + ((size_t)b * LK + SEQ) * 64, VB + hb * 128, CTXL, MIX + rowbase * DM + 512 + h * 128, U + rowbase * NIN + OFF_MLA_G + h * 128, lds); }
    }
}


namespace hy {
using bf16x8 = __attribute__((ext_vector_type(8))) short;
using f32x16 = __attribute__((ext_vector_type(16))) float;
using u32x4 = __attribute__((ext_vector_type(4))) unsigned;
using u32x2 = __attribute__((ext_vector_type(2))) unsigned;
constexpr int PADB = 8, ROWB = 80;
constexpr int CPQ = 544, NCH = 520, CH0 = 260;
constexpr int OFF_RHO = 0, OFF_Z = 8 * CPQ * 16, OFF_X1 = OFF_Z + 80 * 4 * ROWB, OFF_X2 = OFF_X1 + 64 * 4 * ROWB, LDS_END = OFF_X2 + 64 * 4 * ROWB;
constexpr unsigned SQ = 0x0F9C9460u;
__device__ __forceinline__ int copy_base(int q) { return q * CPQ + (int)((SQ >> (4 * q)) & 15u); }
__device__ __forceinline__ unsigned pk2bf(float lo, float hi) { unsigned r; asm volatile("v_cvt_pk_bf16_f32 %0, %1, %2" : "=v"(r) : "v"(lo), "v"(hi)); return r; }
__device__ __forceinline__ float blo(unsigned w) { return __uint_as_float(w << 16); }
__device__ __forceinline__ float bhi(unsigned w) { return __uint_as_float(w & 0xffff0000u); }

struct RhoRegs { u32x4 g0, g1, h0, h1; };
__device__ __forceinline__ void rho_ld2(const bf16_t* __restrict__ RHOg, int nn, u32x4& g0, u32x4& g1) {
    const int e0 = 8 * nn - 32; g0 = (u32x4){0u, 0u, 0u, 0u}; g1 = g0;
    if (e0 >= 0 && e0 <= 4088) g0 = *reinterpret_cast<const u32x4*>(RHOg + e0);
    if (e0 + 8 >= 0 && e0 + 8 <= 4088) g1 = *reinterpret_cast<const u32x4*>(RHOg + e0 + 8);
}
__device__ __forceinline__ void rho_st2(char* lds, int nn, const u32x4& g0, const u32x4& g1) {
    const unsigned w[8] = {g0.x, g0.y, g0.z, g0.w, g1.x, g1.y, g1.z, g1.w};
#pragma unroll
    for (int q = 0; q < 8; ++q) {
        u32x4 o;
        if ((q & 1) == 0) { o.x = w[q / 2]; o.y = w[q / 2 + 1]; o.z = w[q / 2 + 2]; o.w = w[q / 2 + 3]; }
        else { const int a = (q - 1) / 2;
            o.x = __builtin_amdgcn_alignbit(w[a + 1], w[a], 16); o.y = __builtin_amdgcn_alignbit(w[a + 2], w[a + 1], 16);
            o.z = __builtin_amdgcn_alignbit(w[a + 3], w[a + 2], 16); o.w = __builtin_amdgcn_alignbit(w[a + 4], w[a + 3], 16); }
        *reinterpret_cast<u32x4*>(lds + OFF_RHO + (copy_base(q) + nn) * 16) = o;
    }
}
__device__ __forceinline__ void rho_load(const bf16_t* __restrict__ RHOg, int tid, RhoRegs& r) { rho_ld2(RHOg, tid, r.g0, r.g1); if (tid < NCH - NT) rho_ld2(RHOg, NT + tid, r.h0, r.h1); }
__device__ __forceinline__ void rho_store(char* lds, int tid, const RhoRegs& r) { rho_st2(lds, tid, r.g0, r.g1); if (tid < NCH - NT) rho_st2(lds, NT + tid, r.h0, r.h1); }
__device__ __forceinline__ f32x16 conv_tile(const char* lds, int I0, int lane) {
    const int i = lane & 31, h = lane >> 5, q = (8 - (i & 7)) & 7;
    const char* pa = lds + OFF_RHO + (copy_base(q) + CH0 + h - (i >> 3) - (q ? 1 : 0) - 4 * (I0 - 63)) * 16;
    const char* pb = lds + OFF_Z + ((63 + PADB) * 4 + i) * ROWB + 16 * h;
    f32x16 acc = {};
    bf16x8 a0[4], b0[4], a1[4], b1[4];
#define HY_LD(A, B, G) do { const int dd_ = 2 * (G); \
        A[0] = *reinterpret_cast<const bf16x8*>(pa - 64 * dd_); A[1] = *reinterpret_cast<const bf16x8*>(pa - 64 * dd_ + 32); A[2] = *reinterpret_cast<const bf16x8*>(pa - 64 * dd_ - 64); A[3] = *reinterpret_cast<const bf16x8*>(pa - 64 * dd_ - 32); \
        B[0] = *reinterpret_cast<const bf16x8*>(pb - 320 * dd_); B[1] = *reinterpret_cast<const bf16x8*>(pb - 320 * dd_ + 32); B[2] = *reinterpret_cast<const bf16x8*>(pb - 320 * dd_ - 320); B[3] = *reinterpret_cast<const bf16x8*>(pb - 320 * dd_ - 288); } while (0)
#define HY_MM(A, B) do { _Pragma("unroll") for (int k_ = 0; k_ < 4; ++k_) acc = __builtin_amdgcn_mfma_f32_32x32x16_bf16(A[k_], B[k_], acc, 0, 0, 0); } while (0)
    HY_LD(a0, b0, 0);
#pragma unroll 1
    for (int g = 0; g < 36; g += 2) {
        HY_LD(a1, b1, g + 1);
        __builtin_amdgcn_sched_barrier(0);
        HY_MM(a0, b0);
        __builtin_amdgcn_sched_barrier(0);
        HY_LD(a0, b0, g + 2 < 36 ? g + 2 : 35);
        __builtin_amdgcn_sched_barrier(0);
        HY_MM(a1, b1);
        __builtin_amdgcn_sched_barrier(0);
    }
#undef HY_LD
#undef HY_MM
    return acc;
}
__device__ __forceinline__ void load_sc16(const bf16_t* __restrict__ row, int t0, float w0, float w1, float w2, float bb, float (&out)[16]) {
    const u32x4 a = *reinterpret_cast<const u32x4*>(row), b = *reinterpret_cast<const u32x4*>(row + 8);
    float in[18];
    in[0] = t0 > 0 ? bf2f(row[-1]) : 0.f; in[17] = t0 + 16 < SEQ ? bf2f(row[16]) : 0.f;
    const unsigned ww[8] = {a.x, a.y, a.z, a.w, b.x, b.y, b.z, b.w};
#pragma unroll
    for (int k = 0; k < 8; ++k) { in[1 + 2 * k] = blo(ww[k]); in[2 + 2 * k] = bhi(ww[k]); }
#pragma unroll
    for (int j = 0; j < 16; ++j) out[j] = w0 * in[j] + w1 * in[j + 1] + w2 * in[j + 2] + bb;
}
__device__ __forceinline__ void st16(char* dst, const float (&v)[16]) {
    u32x4 a, b;
    a.x = pk2bf(v[0], v[1]); a.y = pk2bf(v[2], v[3]); a.z = pk2bf(v[4], v[5]); a.w = pk2bf(v[6], v[7]);
    b.x = pk2bf(v[8], v[9]); b.y = pk2bf(v[10], v[11]); b.z = pk2bf(v[12], v[13]); b.w = pk2bf(v[14], v[15]);
    *reinterpret_cast<u32x4*>(dst) = a; *reinterpret_cast<u32x4*>(dst + 16) = b;
}
__device__ __forceinline__ void hyena_unit(const Params& p, int l, int c, char* lds) {
    int tid_ = threadIdx.x; asm volatile("" : "+v"(tid_));
    const int tid = tid_, lane = tid & 63, wid = __builtin_amdgcn_readfirstlane(tid >> 6);
    const bf16_t* UT = WSP(bf16_t, WS_UT);
    const bf16_t* RH = WSP(bf16_t, WS_RHO) + (((size_t)l * 2) * 512 + c) * 4096;
    RhoRegs rr; rho_load(RH, tid, rr);
    { const int b = tid >> 7, t0 = (tid & 127) * 16; const size_t tok0 = (size_t)b * SEQ + t0;
      const float* cw = p.hy_conv_w + (size_t)l * 3 * 1536; const float* cb = p.hy_conv_b + l * 1536;
      const int J = t0 >> 5, po = (t0 & 31) * 2;
      float v[16];
      load_sc16(UT + (size_t)c * ROWS + tok0, t0, cw[c], cw[1536 + c], cw[3072 + c], cb[c], v);
      st16(lds + OFF_Z + ((J + PADB) * 4 + b) * ROWB + po, v);
      load_sc16(UT + (size_t)(512 + c) * ROWS + tok0, t0, cw[512 + c], cw[1536 + 512 + c], cw[3072 + 512 + c], cb[512 + c], v);
      st16(lds + OFF_X1 + (J * 4 + b) * ROWB + po, v);
      load_sc16(UT + (size_t)(1024 + c) * ROWS + tok0, t0, cw[1024 + c], cw[1536 + 1024 + c], cw[3072 + 1024 + c], cb[1024 + c], v);
      { const bf16_t* gr = UT + (size_t)(1536 + c) * ROWS + tok0; const u32x4 ga = *reinterpret_cast<const u32x4*>(gr), gb = *reinterpret_cast<const u32x4*>(gr + 8);
        const unsigned gw[8] = {ga.x, ga.y, ga.z, ga.w, gb.x, gb.y, gb.z, gb.w};
#pragma unroll
        for (int k = 0; k < 8; ++k) { const float g0 = blo(gw[k]), g1 = bhi(gw[k]); v[2 * k] *= g0 / (1.f + __expf(-g0)); v[2 * k + 1] *= g1 / (1.f + __expf(-g1)); } }
      st16(lds + OFF_X2 + (J * 4 + b) * ROWB + po, v);
      if (tid < 320) { const int rz = tid < 160 ? tid : (72 * 4 * 5 - 160) + tid;
          unsigned zz = 0u; asm volatile("" : "+v"(zz));
          *reinterpret_cast<u32x4*>(lds + OFF_Z + rz * 16) = (u32x4){zz, zz, zz, zz}; } }
    rho_store(lds, tid, rr);
    __syncthreads();
    rho_load(RH + (size_t)512 * 4096, tid, rr);
    const int I0 = 8 * wid, r = lane & 31, h = lane >> 5;
    f32x16 acc = conv_tile(lds, I0, lane);
    __syncthreads();
#pragma unroll
    for (int g = 0; g < 4; ++g) {
        const int off = (I0 * 4 + r) * ROWB + 16 * g + 8 * h;
        const u32x2 xv = *reinterpret_cast<const u32x2*>(lds + OFF_X1 + off);
        u32x2 o; o.x = pk2bf(acc[4 * g] * blo(xv.x), acc[4 * g + 1] * bhi(xv.x)); o.y = pk2bf(acc[4 * g + 2] * blo(xv.y), acc[4 * g + 3] * bhi(xv.y));
        *reinterpret_cast<u32x2*>(lds + OFF_Z + PADB * 4 * ROWB + off) = o;
    }
    rho_store(lds, tid, rr);
    __syncthreads();
    acc = conv_tile(lds, I0, lane);
#pragma unroll
    for (int g = 0; g < 4; ++g) {
        const int off = (I0 * 4 + r) * ROWB + 16 * g + 8 * h;
        const u32x2 xv = *reinterpret_cast<const u32x2*>(lds + OFF_X2 + off);
        u32x2 o; o.x = pk2bf(acc[4 * g] * blo(xv.x), acc[4 * g + 1] * bhi(xv.x)); o.y = pk2bf(acc[4 * g + 2] * blo(xv.y), acc[4 * g + 3] * bhi(xv.y));
        *reinterpret_cast<u32x2*>(lds + OFF_X1 + off) = o;
    }
    __syncthreads();
    bf16_t* HT = WSP(bf16_t, WS_HT) + (size_t)c * ROWS;
#pragma unroll
    for (int k = 0; k < 2; ++k) { const int id = tid + k * NT, b = id >> 8, J = (id >> 2) & 63, q4 = id & 3;
        *reinterpret_cast<u32x4*>(HT + (size_t)b * SEQ + 32 * J + 8 * q4) = *reinterpret_cast<const u32x4*>(lds + OFF_X1 + (J * 4 + b) * ROWB + q4 * 16); }
    __syncthreads();
}
}
static_assert(hy::LDS_END <= LDS_BYTES, "hyena LDS map");

__device__ void ph_hyena_mfma(const Params& p, int l, int bid, int nb, char* lds) {
    for (int c = bid; c < HYW; c += nb) hy::hyena_unit(p, l, c, lds);
}
__device__ void ph_transpose(const bf16_t* __restrict__ src, int spitch, bf16_t* __restrict__ dst, int dpitch, int R, int C, int bid, int nb, bf16_t* tile) {
    const int TX = otid();
    const int tr = R / 64, tc = C / 64;
    for (int t = bid; t < tr * tc; t += nb) {
        const int r0 = (t / tc) * 64, c0 = (t % tc) * 64;
        { const int rr = TX >> 3, cc = (TX & 7) * 8; *(uint4*)(tile + rr * 72 + cc) = *(const uint4*)(src + (size_t)(r0 + rr) * spitch + c0 + cc); }
        __syncthreads();
        { const int dr = TX >> 3, dc = (TX & 7) * 8; unsigned w[4];
#pragma unroll
          for (int k = 0; k < 4; ++k) w[k] = (unsigned)tile[(dc + 2 * k) * 72 + dr] | ((unsigned)tile[(dc + 2 * k + 1) * 72 + dr] << 16);
          *(uint4*)(dst + (size_t)(c0 + dr) * dpitch + r0 + dc) = make_uint4(w[0], w[1], w[2], w[3]); }
        __syncthreads();
    }
}

#define LAS __attribute__((address_space(3)))
typedef unsigned v4u __attribute__((ext_vector_type(4)));
__device__ __forceinline__ unsigned pk2(float lo, float hi) { return (unsigned)f2bf(lo) | ((unsigned)f2bf(hi) << 16); }
__device__ __forceinline__ void transpose_item(const float* W, int K, int N, bf16_t* WT, float* scr, int item, int lane, const float* gs = nullptr) {
    const int nblk = N / 32, kb = item / nblk, nb_ = item % nblk, k0 = 64 * kb, n0 = 32 * nb_;
#pragma unroll 32
    for (int i = 0; i < 32; ++i) { const int kk = 2 * i + (lane >> 5); scr[kk * 33 + (lane & 31)] = W[(size_t)(k0 + kk) * N + n0 + (lane & 31)] * (gs ? gs[k0 + kk] : 1.f); }
    asm volatile("s_waitcnt lgkmcnt(0)" ::: "memory");
    const int c = lane & 7;
#pragma unroll
    for (int j = 0; j < 4; ++j) { const int n = (lane >> 3) + 8 * j; const float* sp = scr + (8 * c) * 33 + n;
        v4u o; o.x = pk2(sp[0 * 33], sp[1 * 33]); o.y = pk2(sp[2 * 33], sp[3 * 33]); o.z = pk2(sp[4 * 33], sp[5 * 33]); o.w = pk2(sp[6 * 33], sp[7 * 33]);
        *(v4u*)(WT + (size_t)(n0 + n) * K + k0 + 8 * c) = o; }
    asm volatile("s_waitcnt lgkmcnt(0)" ::: "memory");
}
__device__ void ph_prologue(const Params& p, int bid, int nb, float* sm) {
    const int tid = otid(), lane = tid & 63, wid = tid >> 6;
    if (bid < DEPTH * 24) {
        float* sil = sm; float* part = sm + 5 * DM;
        for (int i = tid; i < 5 * DM; i += NT) { const int r = i >> 11, k = i & 2047; sil[i] = silu_f(r < 4 ? p.c[r * DM + k] : p.c_ctx[k]); }
        __syncthreads();
        for (int u = bid; u < DEPTH * 24; u += nb) {
            const int l = u / 24, n0 = (u % 24) * 256;
            const float* W = p.w_ada + (size_t)l * DM * 6144 + n0 + lane * 4;
            float4 a[5];
#pragma unroll
            for (int r = 0; r < 5; ++r) a[r] = make_float4(0.f, 0.f, 0.f, 0.f);
#pragma unroll 8
            for (int kk = 0; kk < 256; ++kk) { const int k = wid * 256 + kk; const float4 w = *(const float4*)(W + (size_t)k * 6144);
#pragma unroll
                for (int r = 0; r < 5; ++r) { const float sv = sil[r * DM + k]; a[r].x += sv * w.x; a[r].y += sv * w.y; a[r].z += sv * w.z; a[r].w += sv * w.w; } }
#pragma unroll
            for (int r = 0; r < 5; ++r) *(float4*)(part + (wid * 5 + r) * 256 + lane * 4) = a[r];
            __syncthreads();
            for (int i = tid; i < 5 * 256; i += NT) { const int r = i >> 8, c = i & 255; float sacc = p.b_ada[l * 6144 + n0 + c];
#pragma unroll
                for (int w = 0; w < 8; ++w) sacc += part[(w * 5 + r) * 256 + c];
                WSP(float, WS_MOD)[(size_t)(l * 5 + r) * 6144 + n0 + c] = sacc; }
            __syncthreads();
        }
    }
    __syncthreads();
    float* scr = sm + wid * (64 * 33 + 16);
    constexpr int I_IN = (DM / 64) * (NIN / 32), I_OUT = (DM / 64) * (DM / 32), I_UQ = (512 / 64) * (1536 / 32), I_UKV = (256 / 64) * (2048 / 32), I_W3 = 2048 / 32, I_ALL = I_IN + I_OUT + I_UQ + I_UKV + I_W3;
    unsigned* qctr = (unsigned*)(p.ws + WS_CTL) + 3584;
    for (;;) {
        unsigned itu = 0u; if (lane == 0) itu = atomicAdd(qctr, 1u);
        const int it0 = (int)__builtin_amdgcn_readfirstlane(itu) * 8; if (it0 >= DEPTH * I_ALL) break;
      for (int it = it0; it < it0 + 8 && it < DEPTH * I_ALL; ++it) {
        const int l = it / I_ALL; int r = it % I_ALL;
        if (r < I_IN) { transpose_item(p.w_in + (size_t)l * DM * NIN, DM, NIN, WSP(bf16_t, WS_WINT) + (size_t)l * NINP * DM, scr, r, lane); continue; } r -= I_IN;
        if (r < I_OUT) { transpose_item(p.w_out + (size_t)l * DM * DM, DM, DM, WSP(bf16_t, WS_WOUTT) + (size_t)l * DM * DM, scr, r, lane); continue; } r -= I_OUT;
        if (r < I_UQ) { transpose_item(p.w_uq + (size_t)l * 512 * 1536, 512, 1536, WSP(bf16_t, WS_WUQT) + (size_t)l * 1536 * 512, scr, r, lane, p.q_norm_g + l * 512); continue; } r -= I_UQ;
        if (r < I_UKV) { transpose_item(p.w_ukv + (size_t)l * 256 * 2048, 256, 2048, WSP(bf16_t, WS_WUKVT) + (size_t)l * 2048 * 256, scr, r, lane, p.kv_norm_g + l * 256); continue; } r -= I_UKV;
        transpose_item(p.hf_w3 + (size_t)l * 64 * 2048, 64, 2048, WSP(bf16_t, WS_W3T) + (size_t)l * 2048 * 64, scr, r, lane);
      }
    }
    { float* Ws = sm; float* Ps = sm + 64 * 129;
      const int kq = tid >> 5, jq = tid & 31;
      for (int u = bid; u < DEPTH * 4 * 32; u += nb) {
          const int l = u >> 7, g = (u >> 5) & 3, k0 = (u & 31) * 64;
          __syncthreads();
          for (int i = tid; i < 64 * 128; i += NT) { const int r = i >> 7, cc = i & 127; Ws[r * 129 + cc] = p.w_in[((size_t)l * DM + k0 + r) * NIN + OFF_POOL + g * 128 + cc]; }
          for (int i = tid; i < 128 * 128 / 4; i += NT) *(float4*)&Ps[i * 4] = *(const float4*)(p.w_pool + (size_t)(l * 4 + g) * 128 * 128 + (size_t)i * 4);
          __syncthreads();
          float acc[4][4];
#pragma unroll
          for (int i = 0; i < 4; ++i)
#pragma unroll
              for (int j = 0; j < 4; ++j) acc[i][j] = 0.f;
#pragma unroll 4
          for (int cc = 0; cc < 128; ++cc) { const float4 bv = *(const float4*)&Ps[cc * 128 + jq * 4]; const float bb[4] = {bv.x, bv.y, bv.z, bv.w};
#pragma unroll
              for (int i = 0; i < 4; ++i) { const float av = Ws[(kq * 4 + i) * 129 + cc];
#pragma unroll
                  for (int j = 0; j < 4; ++j) acc[i][j] += av * bb[j]; } }
#pragma unroll
          for (int i = 0; i < 4; ++i) *(float4*)(WSP(float, WS_WP) + ((size_t)l * DM + k0 + kq * 4 + i) * 512 + g * 128 + jq * 4) = make_float4(acc[i][0], acc[i][1], acc[i][2], acc[i][3]);
      }
      __syncthreads(); }
    for (int i = bid * NT + tid; i < SEQ * 32; i += nb * NT) {
        const int t = i >> 5, pr = i & 31; const float inv = expf(-(float)(pr & 15) * (9.210340371976184f / 16.f));
        const float ang = (float)(pr < 16 ? (t >> 6) : (t & 63)) * inv;
        WSP(float, WS_ROPE)[2 * i] = fcos(ang); WSP(float, WS_ROPE)[2 * i + 1] = fsin(ang);
    }
    for (size_t i = (size_t)bid * NT + tid; i < (size_t)DEPTH * (NINP - NIN) * DM / 8; i += (size_t)nb * NT) {
        const size_t per = (size_t)(NINP - NIN) * DM / 8; const int l = (int)(i / per); const size_t o = i % per;
        *(v4u*)(WSP(bf16_t, WS_WINT) + ((size_t)l * NINP + NIN) * DM + o * 8) = (v4u){0u, 0u, 0u, 0u};
    }
    __syncthreads();
}


namespace hyc {
constexpr int KPAD = 664, ZP = 260, SLOT_F = 2 * KPAD + 16 * ZP;
__device__ __forceinline__ void conv4(const float* __restrict__ kp, const float* __restrict__ zb, int t0, float (&acc)[4]) {
#pragma unroll
    for (int i = 0; i < 4; ++i) acc[i] = 0.f;
#pragma unroll 2
    for (int s0 = 0; s0 < CTXL; s0 += 8) {
        const int m0 = t0 - s0 + 257; const float* wp = kp + (m0 + (m0 >> 2));
        float w[11], zz[8];
#pragma unroll
        for (int j = 0; j < 11; ++j) w[j] = wp[j + (j >= 3 ? 1 : 0) + (j >= 7 ? 1 : 0)];
#pragma unroll
        for (int uu = 0; uu < 8; ++uu) zz[uu] = zb[s0 + uu];
#pragma unroll
        for (int uu = 0; uu < 8; ++uu)
#pragma unroll
            for (int i = 0; i < 4; ++i) acc[i] += zz[uu] * w[i - uu + 7];
    }
}
__device__ __forceinline__ void sc4(const bf16_t* __restrict__ row, int t0, float w0, float w1, float w2, float bb, float (&out)[4]) {
    const uint2 a = *reinterpret_cast<const uint2*>(row); float in[6];
    in[0] = t0 > 0 ? bf2f(row[-1]) : 0.f; in[5] = t0 + 4 < CTXL ? bf2f(row[4]) : 0.f;
    in[1] = __uint_as_float(a.x << 16); in[2] = __uint_as_float(a.x & 0xffff0000u); in[3] = __uint_as_float(a.y << 16); in[4] = __uint_as_float(a.y & 0xffff0000u);
#pragma unroll
    for (int j = 0; j < 4; ++j) out[j] = w0 * in[j] + w1 * in[j + 1] + w2 * in[j + 2] + bb;
}
__device__ __forceinline__ void unit(const Params& p, int l, int c0, float* sm) {
    int tid_ = threadIdx.x; asm volatile("" : "+v"(tid_));
    const int tid = tid_, slot = tid >> 8, b = (tid >> 6) & 3, tg = tid & 63, t0 = 4 * tg, c = c0 + slot;
    float* base = sm + slot * SLOT_F; float* kap = base; float* zb = base + 2 * KPAD + b * ZP; float* z2b = zb + 4 * ZP; float* x1b = zb + 8 * ZP; float* x2b = zb + 12 * ZP;
    const bf16_t* UT = WSP(bf16_t, WS_UT); const size_t tok0 = (size_t)ROWS_L + b * CTXL + t0;
    const float* cw = p.hy_conv_w + (size_t)l * 3 * 1536; const float* cb = p.hy_conv_b + l * 1536;
    float v[4];
    sc4(UT + (size_t)c * ROWS + tok0, t0, cw[c], cw[1536 + c], cw[3072 + c], cb[c], v);
#pragma unroll
    for (int i = 0; i < 4; ++i) zb[t0 + i] = v[i];
    sc4(UT + (size_t)(512 + c) * ROWS + tok0, t0, cw[512 + c], cw[1536 + 512 + c], cw[3072 + 512 + c], cb[512 + c], v);
#pragma unroll
    for (int i = 0; i < 4; ++i) x1b[t0 + i] = v[i];
    sc4(UT + (size_t)(1024 + c) * ROWS + tok0, t0, cw[1024 + c], cw[1536 + 1024 + c], cw[3072 + 1024 + c], cb[1024 + c], v);
    { const uint2 ga = *reinterpret_cast<const uint2*>(UT + (size_t)(1536 + c) * ROWS + tok0);
      const float g[4] = {__uint_as_float(ga.x << 16), __uint_as_float(ga.x & 0xffff0000u), __uint_as_float(ga.y << 16), __uint_as_float(ga.y & 0xffff0000u)};
#pragma unroll
      for (int i = 0; i < 4; ++i) x2b[t0 + i] = v[i] * (g[i] / (1.f + __expf(-g[i]))); }
    { const float* KC = WSP(float, WS_KC) + ((size_t)l * 2 * 512 + c) * 512;
#pragma unroll
      for (int k = 0; k < 4; ++k) { const int idx = (tid & 255) + 256 * k, o = idx >> 9, e = idx & 511, m = e + 8; kap[o * KPAD + m + (m >> 2)] = KC[(size_t)o * 512 * 512 + e]; } }
    __syncthreads();
    float acc[4];
    conv4(kap, zb, t0, acc);
#pragma unroll
    for (int i = 0; i < 4; ++i) z2b[t0 + i] = x1b[t0 + i] * acc[i];
    __syncthreads();
    conv4(kap + KPAD, z2b, t0, acc);
    uint2 o2; o2.x = (unsigned)f2bf(acc[0] * x2b[t0]) | ((unsigned)f2bf(acc[1] * x2b[t0 + 1]) << 16); o2.y = (unsigned)f2bf(acc[2] * x2b[t0 + 2]) | ((unsigned)f2bf(acc[3] * x2b[t0 + 3]) << 16);
    *reinterpret_cast<uint2*>(WSP(bf16_t, WS_HT) + (size_t)c * ROWS + tok0) = o2;
    __syncthreads();
}
}
__device__ void ph_hyena_ctx(const Params& p, int l, int bid, int nb, float* sm) {
    if (l == DEPTH - 1) return;
    for (int u = nb - 1 - bid; u < HYW / 2; u += nb) hyc::unit(p, l, 2 * u, sm);
}
__device__ void ph_kc(const Params& p, int bid, int nb) {
    const int TX = otid();
    const int lane = TX & 63, wid = TX >> 6;
    for (int idx = bid * 8 + wid; idx < DEPTH * 1024; idx += nb * 8) {
        const int l = idx >> 10, o = (idx >> 9) & 1, c = idx & 511, L = CTXL;
        const float* F = WSP(float, WS_FC) + (size_t)l * 2 * 2 * CTXL * 512;
        float a[4], bq[4], s = 0;
#pragma unroll
        for (int i = 0; i < 4; ++i) { const int pos = lane + 64 * i;
            a[i] = F[(((size_t)o * 2 + 0) * L + pos) * 512 + c]; bq[i] = F[(((size_t)o * 2 + 1) * L + pos) * 512 + c];
            s += a[i] * a[i]; if (pos >= 1) s += bq[i] * bq[i]; }
        s = wave_sum(s);
        const float sc = rsqrtf(s + EPS);
        float* KC = WSP(float, WS_KC) + (size_t)idx * 512;
#pragma unroll
        for (int i = 0; i < 4; ++i) { const int pos = lane + 64 * i;
            KC[256 + pos] = sc * a[i] + (pos == 0 ? p.hy_bias[(l * 2 + o) * 512 + c] : 0.f);
            if (pos >= 1) KC[256 - pos] = sc * bq[i]; else KC[0] = 0.f; }
    }
}

#define XB_TMO      128
#define XB_XCNT(j)  (256  + 64 * (j))
#define XB_XSUB(j)  (1280 + 64 * (j))
#define XB_XGEN(j)  (2304 + 64 * (j))
#define XB_TOP      3328
#define XB_TOPGEN   3392
#define XCD_BAR_WORDS 3456
#define XB_SPIN_CAP (1u << 18)
__device__ __forceinline__ unsigned xb_ld(unsigned* p)              { return __hip_atomic_load(p, __ATOMIC_RELAXED, __HIP_MEMORY_SCOPE_AGENT); }
__device__ __forceinline__ unsigned xb_add(unsigned* p, unsigned v) { return __hip_atomic_fetch_add(p, v, __ATOMIC_RELAXED, __HIP_MEMORY_SCOPE_AGENT); }
__device__ __forceinline__ unsigned xb_xcc_id() { return (unsigned)__builtin_amdgcn_s_getreg((3 << 11) | 20) & 0xFu; }
#define XB_SPIN(cond, bar) do { unsigned _sp = 0; while (cond) { __builtin_amdgcn_s_sleep(1); \
    if ((++_sp & 255u) == 0u) { if (xb_ld(&(bar)[XB_TMO])) break; if (_sp > XB_SPIN_CAP) { atomicAdd(&(bar)[XB_TMO], 1u); break; } } } } while (0)
struct XcdBarrier { unsigned* bar; unsigned x; volatile LAS unsigned* st; };
__device__ __forceinline__ XcdBarrier xcd_barrier_post(unsigned* bar, volatile LAS unsigned* st) {
    XcdBarrier b; b.bar = bar; b.x = xb_xcc_id(); b.st = st;
    if (threadIdx.x == 0) (void)xb_add(&bar[XB_XCNT(b.x)], 1u);
    return b;
}
__device__ __forceinline__ void xcd_barrier_complete(unsigned* bar, unsigned x, unsigned& nloc, unsigned& nx) {
    const unsigned G = gridDim.x * gridDim.y * gridDim.z;
    unsigned sum, cnt, mine, sp = 0u;
    for (;;) {
        sum = 0u; cnt = 0u; mine = 0u;
#pragma unroll
        for (unsigned j = 0; j < 16; ++j) { const unsigned c = xb_ld(&bar[XB_XCNT(j)]); sum += c; cnt += (c > 0u) ? 1u : 0u; mine = (j == x) ? c : mine; }
        if (sum == G) break;
        __builtin_amdgcn_s_sleep(1);
        if ((++sp & 255u) == 0u) { if (xb_ld(&bar[XB_TMO])) break; if (sp > XB_SPIN_CAP) { atomicAdd(&bar[XB_TMO], 1u); break; } }
    }
    nloc = mine > 0u ? mine : 1u; nx = cnt > 0u ? cnt : 1u;
}
__device__ __forceinline__ void xcd_barrier(const XcdBarrier& b) {
    asm volatile("s_waitcnt vmcnt(0)" ::: "memory");
    __syncthreads();
    if (threadIdx.x == 0) {
        unsigned* bar = b.bar;
        __builtin_amdgcn_s_waitcnt(0);
        unsigned nloc = b.st[0], nx = b.st[1];
        if (nloc == 0u) { xcd_barrier_complete(bar, b.x, nloc, nx); b.st[0] = nloc; b.st[1] = nx; }
        const unsigned old = xb_add(&bar[XB_XSUB(b.x)], 1u);
        const unsigned gen = old / nloc;
        if (old + 1u == (gen + 1u) * nloc) {
            __builtin_amdgcn_fence(__ATOMIC_RELEASE, "agent");
            asm volatile("s_waitcnt vmcnt(0)" ::: "memory");
            const unsigned og = xb_add(&bar[XB_TOP], 1u);
            const unsigned tg = og / nx;
            if (og + 1u == (tg + 1u) * nx) xb_add(&bar[XB_TOPGEN], 1u);
            else XB_SPIN(xb_ld(&bar[XB_TOPGEN]) == tg, bar);
            __builtin_amdgcn_fence(__ATOMIC_ACQUIRE, "agent");
            xb_add(&bar[XB_XGEN(b.x)], 1u);
            asm volatile("s_waitcnt vmcnt(0)" ::: "memory");
        } else {
            XB_SPIN(xb_ld(&bar[XB_XGEN(b.x)]) == gen, bar);
            __builtin_amdgcn_fence(__ATOMIC_ACQUIRE, "agent");
            asm volatile("s_waitcnt vmcnt(0)" ::: "memory");
        }
    }
    __syncthreads();
}

__device__ void ph_wp_transpose(const Params& p, int bid, int nb, float* sm) {
    const int tid = otid(), lane = tid & 63, wid = tid >> 6;
    float* scr = sm + wid * (64 * 33 + 16);
    constexpr int I_WP = (DM / 64) * (512 / 32);
    for (int it = bid * 8 + wid; it < DEPTH * I_WP; it += nb * 8) { const int l = it / I_WP, r = it % I_WP;
        transpose_item(WSP(float, WS_WP) + (size_t)l * DM * 512, DM, 512, WSP(bf16_t, WS_WINT) + ((size_t)l * NINP + OFF_POOL) * DM, scr, r, lane); }
    __syncthreads();
}
template <int HALF> __device__ __forceinline__ void pool_chunk(const bf16_t* __restrict__ Us, int t0, int L, float ps, bf16_t* __restrict__ Ms) {
    constexpr int NV = 16 + 2 * HALF - 1;
    float v[NV];
#pragma unroll
    for (int i = 0; i < NV; ++i) { const int sidx = t0 - HALF + i; v[i] = (sidx >= 0 && sidx < L) ? bf2f(Us[(size_t)sidx * NIN]) : 0.f; }
    float g[16];
#pragma unroll
    for (int tt = 0; tt < 16; ++tt) g[tt] = bf2f(Us[(size_t)(t0 + tt) * NIN + (OFF_POOL_G - OFF_POOL)]);
    float sum = 0.f;
#pragma unroll
    for (int i = 0; i < 2 * HALF; ++i) sum += v[i];
#pragma unroll
    for (int tt = 0; tt < 16; ++tt) { const int t = t0 + tt, lo = max(t - HALF, 0), hi = min(t + HALF, L);
        const float y = sum / (float)(hi - lo) - v[tt + HALF];
        Ms[(size_t)t * DM] = f2bf(y * ps * silu_f(g[tt]));
        if (tt < 15) sum += v[tt + 2 * HALF] - v[tt]; }
}
__device__ void ph_poolwin(const Params& p, int l, int bid, int nb) {
    const int TX = otid();
    const bf16_t* U = WSP(bf16_t, WS_U); bf16_t* MIX = WSP(bf16_t, WS_MIX);
    for (int idx = bid * NT + TX; idx < (ROWS / 16) * 512; idx += nb * NT) {
        const int j = idx & 511, row0 = (idx >> 9) * 16; const RowInfo r = rowinfo(row0);
        const bf16_t* Us = U + (size_t)(row0 - r.t) * NIN + OFF_POOL + j; bf16_t* Ms = MIX + (size_t)(row0 - r.t) * DM + 1536 + j;
        const float ps = p.pool_scale[l * 512 + j];
        switch (j >> 7) { case 0: pool_chunk<1>(Us, r.t, r.L, ps, Ms); break; case 1: pool_chunk<2>(Us, r.t, r.L, ps, Ms); break;
                          case 2: pool_chunk<4>(Us, r.t, r.L, ps, Ms); break; default: pool_chunk<8>(Us, r.t, r.L, ps, Ms); break; }
    }
}


__device__ void ph_gg(const Params& p, int bid, int nb) {
    const int TX = otid();
    for (int i = bid * NT + TX; i < DEPTH * 5 * DM; i += nb * NT) { const int k = i & 2047, lm = i >> 11, l = lm / 5;
        WSP(float, WS_GG)[i] = p.norm_g[l * DM + k] * (1.f + WSP(float, WS_MOD)[(size_t)lm * 6144 + 2048 + k]); }
}
__device__ void ph_bias(const Params& p, int bid, int nb, float* sm) {
    const int TX = otid();
    const int tid = TX, lane = tid & 63, wid = tid >> 6;
    for (int l = 0; l < DEPTH; ++l) {
        __syncthreads();
        for (int i = tid; i < 5 * DM; i += NT) sm[i] = WSP(float, WS_MOD)[(size_t)(l * 5 + (i >> 11)) * 6144 + (i & 2047)];
        __syncthreads();
        for (int n = bid * 8 + wid; n < NIN; n += nb * 8) {
            const bf16_t* wr_ = WSP(bf16_t, WS_WINT) + ((size_t)l * NINP + n) * DM;
            float a[5] = {0.f, 0.f, 0.f, 0.f, 0.f};
#pragma unroll
            for (int i = 0; i < 4; ++i) { const int k0 = (i * 64 + lane) * 8; const uint4 wv = *(const uint4*)(wr_ + k0);
                const unsigned ww[4] = {wv.x, wv.y, wv.z, wv.w};
#pragma unroll
                for (int r = 0; r < 5; ++r) { const float4 s0 = *(const float4*)&sm[r * DM + k0], s1 = *(const float4*)&sm[r * DM + k0 + 4];
                    a[r] += __uint_as_float(ww[0] << 16) * s0.x + __uint_as_float(ww[0] & 0xffff0000u) * s0.y + __uint_as_float(ww[1] << 16) * s0.z + __uint_as_float(ww[1] & 0xffff0000u) * s0.w
                          + __uint_as_float(ww[2] << 16) * s1.x + __uint_as_float(ww[2] & 0xffff0000u) * s1.y + __uint_as_float(ww[3] << 16) * s1.z + __uint_as_float(ww[3] & 0xffff0000u) * s1.w; } }
#pragma unroll
            for (int r = 0; r < 5; ++r) { const float t = wave_sum(a[r]); if (lane == 0) WSP(float, WS_BIAS)[(size_t)(l * 5 + r) * NINP + n] = t; }
        }
    }
    __syncthreads();
}
__device__ void ph_norm0(const Params& p, int bid, int nb) {
    const int TX = otid();
    const int lane = TX & 63, wid = TX >> 6;
    for (int row = bid * 8 + wid; row < ROWS; row += nb * 8) {
        const RowInfo r = rowinfo(row);
        const float* xr = xin_row(p, 0, row); const float* gg = WSP(float, WS_GG) + (size_t)r.mr * DM; bf16_t* xg = WSP(bf16_t, WS_HA) + (size_t)row * DM;
        float ss = 0.f;
#pragma unroll 2
        for (int j = 0; j < 8; ++j) { const int k = (j * 64 + lane) * 4; const float4 v = *(const float4*)(xr + k), g = *(const float4*)(gg + k);
            ss += v.x * v.x + v.y * v.y + v.z * v.z + v.w * v.w;
            uint2 w; w.x = (unsigned)f2bf(v.x * g.x) | ((unsigned)f2bf(v.y * g.y) << 16); w.y = (unsigned)f2bf(v.z * g.z) | ((unsigned)f2bf(v.w * g.w) << 16); *(uint2*)(xg + k) = w; }
        ss = wave_sum(ss);
        if (lane < 32) WSP(float, WS_XSS)[(size_t)row * 32 + lane] = lane == 0 ? ss : 0.f;
    }
}

enum { PH_ADALN = 0, PH_1, PH_2, PH_3, PH_4, PH_5, PH_6, PH_7, PH_FINAL, PH_PRO_B, PH_PRO_C };
__device__ __forceinline__ void run_phase(const Params& pin, int ph, int l, int bid, int nb, float* sm) {
    asm volatile("" : "+s"(bid), "+s"(nb), "+s"(l));
#if defined(__HIP_DEVICE_COMPILE__)
    const __attribute__((address_space(4))) Params* pk = (const __attribute__((address_space(4))) Params*)__builtin_amdgcn_kernarg_segment_ptr();
    asm volatile("" : "+s"(pk));
    const Params p = *pk; (void)pin;
#else
    const Params p = pin;
#endif
    switch (ph) {
    case PH_ADALN: ph_prologue(p, bid, nb, sm); ph_h2(p, bid, nb, sm); ph_filter_ctx(p, bid, nb, sm); break;
    case PH_PRO_B: ph_wp_transpose(p, bid, nb, sm); ph_rho_mfma(p, bid, nb, sm); ph_kc(p, bid, nb); ph_gg(p, bid, nb); break;
    case PH_PRO_C: ph_bias(p, bid, nb, sm); ph_norm0(p, bid, nb); break;
    case PH_1: break;
    case PH_2:
        { pg8::Gemm g{WSP(bf16_t, WS_HA), WSP(bf16_t, WS_WINT) + (size_t)l * NINP * DM, ROWS, NINP, DM, DM}; pg8::StaticOrder S; S.init(ROWS, NINP, nb, bid);
          pg8::EpiU E{WSP(bf16_t, WS_U), WSP(bf16_t, WS_UT), WSP(float, WS_RS), NIN, NIN, ROWS, WSP(float, WS_XSS), WSP(float, WS_BIAS) + (size_t)l * 5 * NINP, WSP(bf16_t, WS_KR), WSP(float, WS_ROPE)};
          pg8::gemm_phase<pg8::EpiU, pg8::StaticOrder, true, true>((PG8_LAS unsigned char*)sm, g, S, E); } break;
    case PH_3: break;
    case PH_4:
        { const int nq = nb >= 64 ? (nb * 27) / 64 : nb;
          if (nb < 64 || bid < nq) { pg8::Gemm g{WSP(bf16_t, WS_U) + OFF_Q, WSP(bf16_t, WS_WUQT) + (size_t)l * 1536 * 512, ROWS, 1536, 512, NIN}; pg8::StaticOrder S; S.init(ROWS, 1536, nq, bid);
              pg8::EpiQ E{WSP(bf16_t, WS_Q), WSP(float, WS_RS), WSP(float, WS_ROPE)};
              pg8::gemm_phase<pg8::EpiQ, pg8::StaticOrder, true, true>((PG8_LAS unsigned char*)sm, g, S, E); }
          if (nb < 64 || bid >= nq) { const int G2 = nb < 64 ? nb : nb - nq, c2 = nb < 64 ? bid : bid - nq;
              pg8::Gemm g{WSP(bf16_t, WS_U) + OFF_KV, WSP(bf16_t, WS_WUKVT) + (size_t)l * 2048 * 256, ROWS, 2048, 256, NIN}; pg8::StaticOrder S; S.init(ROWS, 2048, G2, c2);
              pg8::EpiKV E{WSP(bf16_t, WS_KB), WSP(bf16_t, WS_VB), WSP(float, WS_RS)};
              pg8::gemm_phase<pg8::EpiKV, pg8::StaticOrder, true, true>((PG8_LAS unsigned char*)sm, g, S, E); } }
        __syncthreads();
        ph_hyena_mfma(p, l, bid, nb, (char*)sm);
        ph_hyena_ctx(p, l, bid, nb, sm); break;
    case PH_5: break;
    case PH_6: { ph_attn_mfma(p, l, bid, nb, (char*)sm);
        const int vcu = (nb % 8 == 0) ? (bid % 8) * (nb / 8) + bid / 8 : bid; const bool split = (l < DEPTH - 1) && nb > 64;
        const int nwk = split ? 2 * (nb - 32) + 32 : nb, w0 = split ? (vcu >= 32 ? 2 * (vcu - 32) : 2 * (nb - 32) + vcu) : bid, nmine = split && vcu >= 32 ? 2 : 1;
        for (int k = 0; k < nmine; ++k) { ph_poolwin(p, l, w0 + k, nwk);
            ph_transpose(WSP(bf16_t, WS_HT), ROWS, WSP(bf16_t, WS_MIX), DM, 512, ROWS, w0 + k, nwk, (bf16_t*)sm); } } break;
    case PH_7: { const int Mrows = l == DEPTH - 1 ? ROWS_L : ROWS;
          pg8::Gemm g{WSP(bf16_t, WS_MIX), WSP(bf16_t, WS_WOUTT) + (size_t)l * DM * DM, Mrows, DM, DM, DM}; pg8::StaticOrder S; S.init(Mrows, DM, nb, bid);
          pg8::EpiResid E{l == 0 ? p.x : WSP(float, WS_XW), l == 0 ? p.ctx : WSP(float, WS_XW) + (size_t)ROWS_L * DM, WSP(float, WS_XW), WSP(float, WS_MOD) + (size_t)l * 5 * 6144 + 4096,
                          l == DEPTH - 1 ? (const float*)nullptr : WSP(float, WS_GG) + (size_t)(l + 1) * 5 * DM, WSP(bf16_t, WS_HA), WSP(float, WS_XSS)};
          pg8::gemm_phase<pg8::EpiResid, pg8::StaticOrder, true, true>((PG8_LAS unsigned char*)sm, g, S, E); } break;
    case PH_FINAL: ph_final(p, bid, nb); break;
    }
}

#if ONE_LAUNCH
__global__ void __launch_bounds__(NT, 2) mega_fwd(Params p) {
    extern __shared__ __attribute__((aligned(16))) unsigned char lds[];
    cg::grid_group grid = cg::this_grid();
    float* sm = (float*)lds; const int bid = blockIdx.x, nb = gridDim.x;
    if (threadIdx.x < 16) ((LAS unsigned*)(lds + LDS_BYTES - 64))[threadIdx.x] = 0u;
    __syncthreads();
    const XcdBarrier bar = xcd_barrier_post((unsigned*)(p.ws + WS_CTL), (volatile LAS unsigned*)(lds + LDS_BYTES - 64));
#define SEAM() xcd_barrier(bar)
#define RUNP(PH, K) do { int nrep_ = (REP_PH == (K)) ? 2 : 1; asm volatile("" : "+s"(nrep_)); _Pragma("unroll 1") for (int rep_ = 0; rep_ < nrep_; ++rep_) run_phase(p, PH, l, bid, nb, sm); } while (0)
    run_phase(p, PH_ADALN, 0, bid, nb, sm);
    if (gridDim.y == 0x7fffu) grid.sync();
    SEAM();
    run_phase(p, PH_PRO_B, 0, bid, nb, sm);
    SEAM();
    run_phase(p, PH_PRO_C, 0, bid, nb, sm);
#pragma unroll 1
    for (int l = 0; l < DEPTH; ++l) {
        SEAM(); RUNP(PH_2, 2);
        SEAM(); RUNP(PH_4, 4);
        SEAM(); RUNP(PH_6, 6);
        SEAM(); RUNP(PH_7, 7);
    }
    SEAM();
    run_phase(p, PH_FINAL, 0, bid, nb, sm);
#undef SEAM
}
#else
__global__ void __launch_bounds__(NT) k_phase(Params p, int ph, int l) {
    extern __shared__ __attribute__((aligned(16))) unsigned char lds[];
    run_phase(p, ph, l, blockIdx.x, gridDim.x, (float*)lds);
}
#endif

extern "C" void kernel_launch(void* const* d_in, const int* in_sizes, int n_in, void* d_out, int out_size, void* d_ws, size_t ws_size, hipStream_t stream) {
    if (n_in != 25 || ws_size < WS_END) { fprintf(stderr, "kernel_launch: bad inputs (n_in %d, ws %zu < %zu)\n", n_in, ws_size, (size_t)WS_END); return; }
    Params p{};
    const float** pp = (const float**)&p;
    for (int i = 0; i < 25; ++i) pp[i] = (const float*)d_in[i];
    p.out = (float*)d_out; p.ws = (unsigned char*)d_ws;
#if ONE_LAUNCH
    static int grid = 0;
    if (!grid) {
        int dev = 0, cus = 0, per_cu = 0;
        hipGetDevice(&dev); hipDeviceGetAttribute(&cus, hipDeviceAttributeMultiprocessorCount, dev);
        hipFuncSetAttribute((const void*)mega_fwd, hipFuncAttributeMaxDynamicSharedMemorySize, LDS_BYTES);
        hipOccupancyMaxActiveBlocksPerMultiprocessor(&per_cu, (const void*)mega_fwd, NT, LDS_BYTES);
        if (per_cu < 1) per_cu = 1;
        grid = cus * 1;
    }
    (void)hipMemsetAsync((char*)d_ws + WS_CTL, 0, CTL_BYTES, stream);
    void* args[] = {&p};
    hipError_t e = hipLaunchCooperativeKernel((const void*)mega_fwd, dim3(grid), dim3(NT), args, LDS_BYTES, stream);
    if (e != hipSuccess) fprintf(stderr, "cooperative launch failed: %s (grid %d)\n", hipGetErrorString(e), grid);
#else
    static int init = 0;
    if (!init) { hipFuncSetAttribute((const void*)k_phase, hipFuncAttributeMaxDynamicSharedMemorySize, LDS_BYTES); init = 1; }
    const int G = 1024;
    k_phase<<<G, NT, LDS_BYTES, stream>>>(p, PH_ADALN, 0);
    k_phase<<<G, NT, LDS_BYTES, stream>>>(p, PH_PRO_B, 0);
    for (int l = 0; l < DEPTH; ++l)
        for (int ph = PH_1; ph <= PH_7; ++ph) k_phase<<<G, NT, LDS_BYTES, stream>>>(p, ph, l);
    k_phase<<<G, NT, LDS_BYTES, stream>>>(p, PH_FINAL, 0);
#endif
}
```
